# Optimizing an MI355X kernel written in HIP

```python
import functools
import math
import jax
import jax.numpy as jnp
from jax import lax
import numpy as np

D_MODEL = 1024
BATCH = 1
SEQ = 16384
DEPTH = 1
DEC_BATCH = 16
DEC_SEQ = 16
PAST_LEN = 1024

CHUNK = 64
Q_BLOCK = 128
EPS = 1e-6
H_A = 16
HD_A = 64
W_A = H_A * HD_A
D_INNER = 2 * D_MODEL
SSD_HEADDIM = 64
SSD_HEADS = D_INNER // SSD_HEADDIM
SSD_STATE = 128
SSD_GROUPS = 4
SSD_CHUNK = CHUNK
CONV_W = 4
CONV_DIM = D_INNER + 2 * SSD_GROUPS * SSD_STATE
D_FF = 2816
N_MOD = 9
IN_SPLITS = (W_A, W_A, W_A, H_A, D_INNER, CONV_DIM, SSD_HEADS, D_MODEL, D_MODEL)
D_IN_PROJ = 3 * W_A + H_A + D_INNER + CONV_DIM + SSD_HEADS + 2 * D_MODEL

kernel_name = 'fox_ssd_macaron_stream_step'


def rmsnorm(x, g):
    xf = x.astype(jnp.float32)
    y = xf * lax.rsqrt(jnp.mean(xf * xf, axis=-1, keepdims=True) + EPS)
    return (y * g.astype(jnp.float32)).astype(x.dtype)


def modulate(h, shift, scale):
    return h * (1 + scale[:, None, :]) + shift[:, None, :]


def swiglu(h, w1, w3, w2):
    return (jax.nn.silu(h @ w1) * (h @ w3)) @ w2


def split_cols(x, sizes):
    out, start = [], 0
    for s in sizes:
        out.append(x[..., start:start + s])
        start += s
    return out


def fox_attend(q, k, v, f_q, f_k, q_pos, k_pos):
    s = jnp.einsum('bqhd,bkhd->bhqk', q, k).astype(jnp.float32) * (HD_A ** -0.5)
    s = s + jnp.swapaxes(f_q, 1, 2)[:, :, :, None] - jnp.swapaxes(f_k, 1, 2)[:, :, None, :]
    s = jnp.where(k_pos[None, :] <= q_pos[:, None], s, -jnp.inf)
    p = jax.nn.softmax(s, axis=-1)
    return jnp.einsum('bhqk,bkhd->bqhd', p.astype(v.dtype), v)


def fox_prompt(q, k, v, logf):
    bsz, seq = q.shape[:2]
    f_cum = jnp.cumsum(logf, axis=1)
    k_pos = jnp.arange(seq)

    def block(i):
        start = i * Q_BLOCK
        qb = lax.dynamic_slice_in_dim(q, start, Q_BLOCK, axis=1)
        fb = lax.dynamic_slice_in_dim(f_cum, start, Q_BLOCK, axis=1)
        return fox_attend(qb, k, v, fb, f_cum, start + jnp.arange(Q_BLOCK), k_pos)

    out = lax.map(block, jnp.arange(seq // Q_BLOCK))
    return jnp.moveaxis(out, 0, 1).reshape(bsz, seq, H_A, HD_A)


def fox_sample(q, k, v, logf, ck, cv, clogf):
    past, n = ck.shape[1], q.shape[1]
    f_past = jnp.cumsum(clogf.astype(jnp.float32), axis=1)
    f_new = f_past[:, -1:] + jnp.cumsum(logf, axis=1)
    kk = jnp.concatenate([ck.astype(k.dtype), k], axis=1)
    vv = jnp.concatenate([cv.astype(v.dtype), v], axis=1)
    f_all = jnp.concatenate([f_past, f_new], axis=1)
    return fox_attend(q, kk, vv, f_new, f_all, past + jnp.arange(n), jnp.arange(past + n))


def causal_conv(xbc, conv_state, w, b):
    seq = xbc.shape[1]
    full = jnp.concatenate([conv_state.astype(xbc.dtype), xbc], axis=1)
    out = b + full[:, 0:seq] * w[0]
    for i in range(1, CONV_W):
        out = out + full[:, i:i + seq] * w[i]
    return jax.nn.silu(out), full[:, -(CONV_W - 1):]


def ssd_scan(x, dt, a, b_in, c_in, h0):
    bsz, seq = x.shape[:2]
    q = min(SSD_CHUNK, seq)
    nc = seq // q
    hg = SSD_HEADS // SSD_GROUPS
    f32 = jnp.float32
    x = x.astype(f32).reshape(bsz, nc, q, SSD_GROUPS, hg, SSD_HEADDIM)
    dt = dt.astype(f32).reshape(bsz, nc, q, SSD_GROUPS, hg)
    b_in = b_in.astype(f32).reshape(bsz, nc, q, SSD_GROUPS, SSD_STATE)
    c_in = c_in.astype(f32).reshape(bsz, nc, q, SSD_GROUPS, SSD_STATE)
    acs = jnp.moveaxis(jnp.cumsum(dt * a.reshape(SSD_GROUPS, hg), axis=2), 2, -1)
    dt_t = jnp.moveaxis(dt, 2, -1)
    causal = jnp.tril(jnp.ones((q, q), dtype=bool))
    seg = acs[..., :, None] - acs[..., None, :]
    decay = jnp.exp(jnp.where(causal, seg, -jnp.inf))
    cb = jnp.einsum('bctgn,bcsgn->bcgts', c_in, b_in)
    w = cb[:, :, :, None] * decay * dt_t[..., None, :]
    y_diag = jnp.einsum('bcghts,bcsghp->bctghp', w, x)
    decay_end = jnp.exp(acs[..., -1:] - acs) * dt_t
    states = jnp.einsum('bcsgn,bcghs,bcsghp->bcghpn', b_in, decay_end, x)
    chunk_decay = jnp.exp(acs[..., -1])
    h_init = h0.astype(f32).reshape(bsz, SSD_GROUPS, hg, SSD_HEADDIM, SSD_STATE)

    def step(h, inp):
        s_c, d_c = inp
        return d_c[..., None, None] * h + s_c, h

    h_last, h_in = lax.scan(step, h_init, (jnp.moveaxis(states, 1, 0), jnp.moveaxis(chunk_decay, 1, 0)))
    h_in = jnp.moveaxis(h_in, 0, 1)
    y_off = jnp.einsum('bctgn,bcghpn,bcght->bctghp', c_in, h_in, jnp.exp(acs))
    y = (y_diag + y_off).reshape(bsz, seq, SSD_HEADS, SSD_HEADDIM)
    return y, h_last.reshape(bsz, SSD_HEADS, SSD_HEADDIM, SSD_STATE).astype(h0.dtype)


def ssd_branch(z, xbc, dt_raw, conv_state, ssm_state, prm):
    bsz, seq = z.shape[:2]
    f32 = jnp.float32
    xbc, new_conv = causal_conv(xbc, conv_state, prm['conv_w'], prm['conv_b'])
    xs, b_in, c_in = split_cols(xbc, (D_INNER, SSD_GROUPS * SSD_STATE, SSD_GROUPS * SSD_STATE))
    xs = xs.reshape(bsz, seq, SSD_HEADS, SSD_HEADDIM)
    dt = jax.nn.softplus(dt_raw.astype(f32) + prm['dt_bias'].astype(f32))
    a = -jnp.exp(prm['a_log'].astype(f32))
    y, new_ssm = ssd_scan(xs, dt, a,
                          b_in.reshape(bsz, seq, SSD_GROUPS, SSD_STATE),
                          c_in.reshape(bsz, seq, SSD_GROUPS, SSD_STATE), ssm_state)
    y = y + prm['d_skip'].astype(f32)[:, None] * xs.astype(f32)
    y = y.reshape(bsz, seq, D_INNER).astype(z.dtype)
    y = rmsnorm(y * jax.nn.silu(z), prm['g_ssd'])
    return y @ prm['w_s'], new_conv, new_ssm


def token_mixer(u, prm, fox_fn, conv_state, ssm_state):
    bsz, seq = u.shape[:2]
    q, k, v, f_logit, z, xbc, dt_raw, gate_a, gate_s = split_cols(u @ prm['w_in'], IN_SPLITS)
    q = q.reshape(bsz, seq, H_A, HD_A)
    k = k.reshape(bsz, seq, H_A, HD_A)
    v = v.reshape(bsz, seq, H_A, HD_A)
    logf = jax.nn.log_sigmoid(f_logit.astype(jnp.float32) + prm['b_f'].astype(jnp.float32))
    o_a = fox_fn(q, k, v, logf).reshape(bsz, seq, W_A) @ prm['w_a']
    o_s, new_conv, new_ssm = ssd_branch(z, xbc, dt_raw, conv_state, ssm_state, prm)
    merged = jax.nn.sigmoid(gate_a) * o_a + jax.nn.sigmoid(gate_s) * o_s
    return merged @ prm['w_out'], (k, v, logf, new_ssm, new_conv)


def trunk_layer(x, c, prm, fox_fn, conv_state, ssm_state):
    mod = jax.nn.silu(c) @ prm['w_ada'] + prm['b_ada']
    sh1, sc1, ga1, sh2, sc2, ga2, sh3, sc3, ga3 = jnp.split(mod, N_MOD, axis=-1)
    h = modulate(rmsnorm(x, prm['g_ffn1']), sh1, sc1)
    x = x + 0.5 * (1 + ga1)[:, None, :] * swiglu(h, prm['w1_ffn1'], prm['w3_ffn1'], prm['w2_ffn1'])
    u = modulate(rmsnorm(x, prm['g_mix']), sh2, sc2)
    m, new_state = token_mixer(u, prm, fox_fn, conv_state, ssm_state)
    x = x + (1 + ga2)[:, None, :] * m
    h = modulate(rmsnorm(x, prm['g_ffn2']), sh3, sc3)
    x = x + 0.5 * (1 + ga3)[:, None, :] * swiglu(h, prm['w1_ffn2'], prm['w3_ffn2'], prm['w2_ffn2'])
    return x, new_state


def setup_inputs(seed: int = 0) -> dict:
    key = jax.random.key(seed)
    ks = iter(jax.random.split(key, 48))
    L = DEPTH
    f32 = jnp.float32

    def nrm(shape, scale):
        return scale * jax.random.normal(next(ks), shape, f32)

    def unif(shape, lo, hi):
        return jax.random.uniform(next(ks), shape, f32, minval=lo, maxval=hi)

    dt0 = jnp.exp(unif((L, SSD_HEADS), math.log(1e-3), math.log(1e-1)))
    inputs = {
        'x_prompt': nrm((BATCH, SEQ, D_MODEL), 1.0),
        'x_sample': nrm((DEC_BATCH, DEC_SEQ, D_MODEL), 1.0),
        'c_prompt': nrm((BATCH, D_MODEL), 1.0),
        'c_sample': nrm((DEC_BATCH, D_MODEL), 1.0),
        'cache_k': nrm((L, DEC_BATCH, PAST_LEN, H_A, HD_A), 1.0),
        'cache_v': nrm((L, DEC_BATCH, PAST_LEN, H_A, HD_A), 1.0),
        'cache_logf': jax.nn.log_sigmoid(unif((L, DEC_BATCH, PAST_LEN, H_A), 1.0, 6.0)
                                         + nrm((L, DEC_BATCH, PAST_LEN, H_A), 1.0)),
        'state_ssm': nrm((L, DEC_BATCH, SSD_HEADS, SSD_HEADDIM, SSD_STATE), 0.5),
        'state_conv': nrm((L, DEC_BATCH, CONV_W - 1, CONV_DIM), 1.0),
        'w_ada': nrm((L, D_MODEL, N_MOD * D_MODEL), 0.3 * D_MODEL ** -0.5),
        'b_ada': nrm((L, N_MOD * D_MODEL), 0.01),
        'g_ffn1': 1.0 + nrm((L, D_MODEL), 0.01),
        'w1_ffn1': nrm((L, D_MODEL, D_FF), D_MODEL ** -0.5),
        'w3_ffn1': nrm((L, D_MODEL, D_FF), D_MODEL ** -0.5),
        'w2_ffn1': nrm((L, D_FF, D_MODEL), D_FF ** -0.5),
        'g_mix': 1.0 + nrm((L, D_MODEL), 0.01),
        'w_in': nrm((L, D_MODEL, D_IN_PROJ), D_MODEL ** -0.5),
        'b_f': unif((L, H_A), 1.0, 6.0),
        'conv_w': nrm((L, CONV_W, CONV_DIM), CONV_W ** -0.5),
        'conv_b': nrm((L, CONV_DIM), 0.01),
        'dt_bias': dt0 + jnp.log(-jnp.expm1(-dt0)),
        'a_log': jnp.log(unif((L, SSD_HEADS), 1.0, 16.0)),
        'd_skip': 1.0 + nrm((L, SSD_HEADS), 0.01),
        'g_ssd': 1.0 + nrm((L, D_INNER), 0.01),
        'w_a': nrm((L, W_A, D_MODEL), W_A ** -0.5),
        'w_s': nrm((L, D_INNER, D_MODEL), D_INNER ** -0.5),
        'w_out': nrm((L, D_MODEL, D_MODEL), D_MODEL ** -0.5),
        'g_ffn2': 1.0 + nrm((L, D_MODEL), 0.01),
        'w1_ffn2': nrm((L, D_MODEL, D_FF), D_MODEL ** -0.5),
        'w3_ffn2': nrm((L, D_MODEL, D_FF), D_MODEL ** -0.5),
        'w2_ffn2': nrm((L, D_FF, D_MODEL), D_FF ** -0.5),
        'g_final': 1.0 + nrm((D_MODEL,), 0.01),
    }
    return inputs


def reference(x_prompt, x_sample, c_prompt, c_sample, cache_k, cache_v, cache_logf, state_ssm, state_conv,
              w_ada, b_ada, g_ffn1, w1_ffn1, w3_ffn1, w2_ffn1, g_mix, w_in, b_f, conv_w, conv_b,
              dt_bias, a_log, d_skip, g_ssd, w_a, w_s, w_out, g_ffn2, w1_ffn2, w3_ffn2, w2_ffn2, g_final):
    bp = x_prompt.shape[0]
    xp, xs = x_prompt, x_sample
    kp_l, vp_l, lp_l, sp_l, cp_l = [], [], [], [], []
    ks_l, vs_l, ls_l, ss_l, cs_l = [], [], [], [], []
    for l in range(DEPTH):
        prm = {
            'w_ada': w_ada[l], 'b_ada': b_ada[l],
            'g_ffn1': g_ffn1[l], 'w1_ffn1': w1_ffn1[l], 'w3_ffn1': w3_ffn1[l], 'w2_ffn1': w2_ffn1[l],
            'g_mix': g_mix[l], 'w_in': w_in[l], 'b_f': b_f[l],
            'conv_w': conv_w[l], 'conv_b': conv_b[l], 'dt_bias': dt_bias[l], 'a_log': a_log[l],
            'd_skip': d_skip[l], 'g_ssd': g_ssd[l], 'w_a': w_a[l], 'w_s': w_s[l], 'w_out': w_out[l],
            'g_ffn2': g_ffn2[l], 'w1_ffn2': w1_ffn2[l], 'w3_ffn2': w3_ffn2[l], 'w2_ffn2': w2_ffn2[l],
        }
        zero_conv = jnp.zeros((bp, CONV_W - 1, CONV_DIM), x_prompt.dtype)
        zero_ssm = jnp.zeros((bp, SSD_HEADS, SSD_HEADDIM, SSD_STATE), jnp.float32)
        xp, (kp, vp, lp, sp, cp) = trunk_layer(xp, c_prompt, prm, fox_prompt, zero_conv, zero_ssm)
        fox_s = functools.partial(fox_sample, ck=cache_k[l], cv=cache_v[l], clogf=cache_logf[l])
        xs, (ks_, vs_, ls_, ss_, cs_) = trunk_layer(xs, c_sample, prm, fox_s, state_conv[l], state_ssm[l])
        kp_l.append(kp); vp_l.append(vp); lp_l.append(lp); sp_l.append(sp); cp_l.append(cp)
        ks_l.append(ks_); vs_l.append(vs_); ls_l.append(ls_); ss_l.append(ss_); cs_l.append(cs_)
    y_prompt = rmsnorm(xp, g_final)
    y_sample = rmsnorm(xs, g_final)
    k_prompt = jnp.stack(kp_l)
    v_prompt = jnp.stack(vp_l)
    logf_prompt = jnp.stack(lp_l)
    ssm_prompt = jnp.stack(sp_l)
    conv_prompt = jnp.stack(cp_l)
    k_sample = jnp.stack(ks_l)
    v_sample = jnp.stack(vs_l)
    logf_sample = jnp.stack(ls_l)
    ssm_sample = jnp.stack(ss_l)
    conv_sample = jnp.stack(cs_l)
    return (y_prompt, y_sample, k_prompt, v_prompt, logf_prompt, ssm_prompt, conv_prompt,
            k_sample, v_sample, logf_sample, ssm_sample, conv_sample)
```

```cpp
#include <hip/hip_runtime.h>
#include <cstdio>
#include <cstdint>
namespace pg8 {
#define PG8_LAS __attribute__((address_space(3)))
typedef unsigned short bf16_t;
typedef short bf16x8 __attribute__((ext_vector_type(8)));
typedef float f32x4 __attribute__((ext_vector_type(4)));
typedef unsigned u32x4 __attribute__((ext_vector_type(4)));
constexpr int BM = 256, BK = 64, HALF = 128, HTB = HALF * BK * 2  , STAGE_BYTES = 8 * HTB, NXCD = 8, WGM = 8;

__host__ __device__ __forceinline__ int lds_byte(int r, int c) { const int st = (r >> 4) * 2 + (c >> 5), rr = r & 15, cc = c & 31, ob = rr * 64 + cc * 2; return st * 1024 + (ob ^ (((ob >> 9) & 1) << 5)); }
__host__ __device__ __forceinline__ void stage_rc(int b, int& R, int& C) { const int st = b / 1024, sb = b % 1024, swz = sb ^ (((sb >> 9) & 1) << 5); R = (st >> 1) * 16 + swz / 64; C = (st & 1) * 32 + (swz % 64) / 2; }
__host__ __device__ __forceinline__ int perm32(int rho) { const int n = rho >> 4, i = rho & 15; return 8 * (i >> 2) + 4 * n + (i & 3); }

struct Unit { int pm, pn; };
struct Gemm { const bf16_t* A; const bf16_t* Bt; int M, N, K, lda; };

struct StaticOrder {
    int nM, nN, nwg, G, c;
    __host__ __device__ void init(int M, int N, int G_, int c_) { nM = M / BM; nN = N / BM; nwg = nM * nN; G = G_; c = c_; }
    __host__ __device__ bool next(int i, Unit& u) const {
        const long L = (long)i * G + c; if (L >= nwg) return false;
        int wgid = (int)L; { const int q = nwg / NXCD, r = nwg % NXCD, xcd = wgid % NXCD, off = wgid / NXCD; wgid = (xcd < r ? xcd * (q + 1) : r * (q + 1) + (xcd - r) * q) + off; }
        const int nig = WGM * nN, gid = wgid / nig, fm = gid * WGM, gsz = (nM - fm) < WGM ? (nM - fm) : WGM;
        u.pm = fm + ((wgid % nig) % gsz); u.pn = (wgid % nig) / gsz; return true;
    }
    __device__ __forceinline__ void a_ready(const Unit&) const {}
    __device__ __forceinline__ void done(const Unit&) const {}
};


typedef float f32x2 __attribute__((ext_vector_type(2))); typedef __bf16 bf16x2v __attribute__((ext_vector_type(2)));
__device__ __forceinline__ unsigned cvt_pk_bf16(float lo, float hi) { f32x2 v = {lo, hi}; return __builtin_bit_cast(unsigned, __builtin_convertvector(v, bf16x2v)); }
constexpr int MP = 16384, MS = 256, MT = MP + MS, DM_ = 1024, NMODC = 9 * 1024;
__device__ __forceinline__ int bidx(int m) { return m < MP ? 0 : 1 + ((m - MP) >> 4); }
__device__ __forceinline__ float sigm(float x) { return __builtin_amdgcn_rcpf(1.f + __builtin_amdgcn_exp2f(-1.4426950408889634f * x)); }
__device__ __forceinline__ float silu(float x) { return x * sigm(x); }
__device__ __forceinline__ float sigm_c(float x, float c) { return __builtin_amdgcn_rcpf(1.f + __builtin_amdgcn_exp2f(c * x)); }
__device__ __forceinline__ float silu_c(float x, float c) { return x * sigm_c(x, c); }
__device__ __forceinline__ float bf2f(unsigned short b) { return __uint_as_float(((unsigned)b) << 16); }
__device__ __forceinline__ float bflo(unsigned w) { return __uint_as_float(w << 16); }
__device__ __forceinline__ float bfhi(unsigned w) { return __uint_as_float(w & 0xffff0000u); }
__device__ __forceinline__ int lane_now() { int l; asm volatile("v_mbcnt_lo_u32_b32 %0, -1, 0\n\tv_mbcnt_hi_u32_b32 %0, -1, %0" : "=v"(l)); return l; }
__device__ __forceinline__ float xor_lane(float v, int ln, int mask) { return __int_as_float(__builtin_amdgcn_ds_bpermute((ln ^ mask) << 2, __float_as_int(v))); }
__device__ __forceinline__ float softplusf_(float x) { return fmaxf(x, 0.f) + log1pf(__expf(-fabsf(x))); }

struct EpiSwiGLU {
    static constexpr bool PERM = true, AFTER_DRAIN = false;
    bf16_t* O; int ldc;
    __device__ __forceinline__ void operator()(const f32x4 (&acc)[2][2][4][2], const Unit& u, int wr, int wc, int fr_in, int fq_in) const {
        const int ln_ = lane_now(); const int fr = ln_ & 15, fq = ln_ >> 4; (void)fr_in; (void)fq_in;
        const int row0 = u.pm * BM + wr * 64 + fr, col0 = u.pn * HALF + wc * 32 + 8 * fq;
#pragma unroll
        for (int ai = 0; ai < 2; ++ai)
#pragma unroll
            for (int m = 0; m < 4; ++m) {
                bf16_t* rowp = O + (size_t)(row0 + ai * HALF + m * 16) * ldc + col0;
                const f32x4 a0 = acc[ai][0][m][0], a1 = acc[ai][0][m][1], g0 = acc[ai][1][m][0], g1 = acc[ai][1][m][1];
                u32x4 w;
                w.x = cvt_pk_bf16(silu(a0[0]) * g0[0], silu(a0[1]) * g0[1]); w.y = cvt_pk_bf16(silu(a0[2]) * g0[2], silu(a0[3]) * g0[3]);
                w.z = cvt_pk_bf16(silu(a1[0]) * g1[0], silu(a1[1]) * g1[1]); w.w = cvt_pk_bf16(silu(a1[2]) * g1[2], silu(a1[3]) * g1[3]);
                *(u32x4*)rowp = w;
                asm volatile("" ::: "memory"); __builtin_amdgcn_sched_barrier(0);
            }
    }
};
struct EpiResGate {
    static constexpr bool PERM = false, AFTER_DRAIN = false;
    const float* xp; const float* xs; float* out; const float* mod; int chunk; float gsc;
    __device__ __forceinline__ void operator()(const f32x4 (&acc)[2][2][4][2], const Unit& u, int wr, int wc, int fr_in, int fq_in) const {
        const int ln_ = lane_now(); const int fr = ln_ & 15, fq = ln_ >> 4; (void)fr_in; (void)fq_in;
        const int col0 = u.pn * BM + wc * 32 + 4 * fq;
#pragma unroll
        for (int ai = 0; ai < 2; ++ai)
#pragma unroll
            for (int m = 0; m < 4; ++m) {
                const int row = u.pm * BM + ai * HALF + wr * 64 + m * 16 + fr;
                const float* gp = mod + (size_t)bidx(row) * NMODC + chunk * 1024;
                const float* bp = row < MP ? xp + (size_t)row * DM_ : xs + (size_t)(row - MP) * DM_;
                float* op = out + (size_t)row * DM_;
#pragma unroll
                for (int bj = 0; bj < 2; ++bj)
#pragma unroll
                    for (int n = 0; n < 2; ++n) {
                        const int c = col0 + bj * HALF + n * 16;
                        const f32x4 g = *(const f32x4*)(gp + c), bs = *(const f32x4*)(bp + c);
                        *(f32x4*)(op + c) = bs + (g + 1.0f) * gsc * acc[ai][bj][m][n];
                    }
                asm volatile("" ::: "memory"); __builtin_amdgcn_sched_barrier(0);
            }
    }
};
struct EpiI1 {
    static constexpr bool PERM = true, AFTER_DRAIN = false;
    bf16_t *Q, *Kb, *Vb, *XBC; float* dout; float* DT; const float *b_f, *dt_bias; float c2;
    size_t o_kp, o_vp, o_lp, o_cp, o_ks, o_vs, o_ls, o_cs;
    __device__ __forceinline__ void operator()(const f32x4 (&acc)[2][2][4][2], const Unit& u, int wr, int wc, int fr_in, int fq_in) const {
        const int ln_ = lane_now(); const int fr = ln_ & 15, fq = ln_ >> 4; (void)fr_in; (void)fq_in;
        const int pn = u.pn, row0 = u.pm * BM + wr * 64 + fr, cl = wc * 32 + 8 * fq;
        if (pn < 12) {
            const int t = pn >> 2, cb = (pn & 3) * 256;
#pragma unroll
            for (int ai = 0; ai < 2; ++ai)
#pragma unroll
                for (int m = 0; m < 4; ++m) {
                    const int row = row0 + ai * HALF + m * 16;
#pragma unroll
                    for (int bj = 0; bj < 2; ++bj) {
                        const int c = cb + bj * HALF + cl;
                        f32x4 v0 = acc[ai][bj][m][0], v1 = acc[ai][bj][m][1];
                        if (t == 0) { v0 = v0 * c2; v1 = v1 * c2; }
                        u32x4 w; w.x = cvt_pk_bf16(v0[0], v0[1]); w.y = cvt_pk_bf16(v0[2], v0[3]); w.z = cvt_pk_bf16(v1[0], v1[1]); w.w = cvt_pk_bf16(v1[2], v1[3]);
                        bf16_t* dst = (t == 0 ? Q : (t == 1 ? Kb : Vb)) + (size_t)row * DM_ + c;
                        *(u32x4*)dst = w;
                        if (t != 0) {
                            float* fo = dout + (row < MP ? (t == 1 ? o_kp : o_vp) + (size_t)row * DM_ : (t == 1 ? o_ks : o_vs) + (size_t)(row - MP) * DM_) + c;
                            *(f32x4*)fo = v0; *(f32x4*)(fo + 4) = v1;
                        }
                    }
                    asm volatile("" ::: "memory"); __builtin_amdgcn_sched_barrier(0);
                }
        } else if (pn < 24) {
            const int cb = (pn - 12) * 256;
#pragma unroll
            for (int ai = 0; ai < 2; ++ai)
#pragma unroll
                for (int m = 0; m < 4; ++m) {
                    const int row = row0 + ai * HALF + m * 16;
#pragma unroll
                    for (int bj = 0; bj < 2; ++bj) {
                        const int c = cb + bj * HALF + cl;
                        const f32x4 v0 = acc[ai][bj][m][0], v1 = acc[ai][bj][m][1];
                        u32x4 w; w.x = cvt_pk_bf16(v0[0], v0[1]); w.y = cvt_pk_bf16(v0[2], v0[3]); w.z = cvt_pk_bf16(v1[0], v1[1]); w.w = cvt_pk_bf16(v1[2], v1[3]);
                        *(u32x4*)(XBC + (size_t)row * 3072 + c) = w;
                        float* fo = nullptr;
                        if (row >= MP - 3 && row < MP) fo = dout + o_cp + (size_t)(row - (MP - 3)) * 3072 + c;
                        else if (row >= MP && ((row - MP) & 15) >= 13) fo = dout + o_cs + (size_t)((row - MP) >> 4) * 9216 + (size_t)(((row - MP) & 15) - 13) * 3072 + c;
                        if (fo) { *(f32x4*)fo = v0; *(f32x4*)(fo + 4) = v1; }
                    }
                    asm volatile("" ::: "memory"); __builtin_amdgcn_sched_barrier(0);
                }
        } else {
            if (cl < 48) {
#pragma unroll
                for (int ai = 0; ai < 2; ++ai)
#pragma unroll
                    for (int m = 0; m < 4; ++m) {
                        const int row = row0 + ai * HALF + m * 16;
#pragma unroll
                        for (int n = 0; n < 2; ++n) {
                            const f32x4 v = acc[ai][0][m][n];
#pragma unroll
                            for (int i = 0; i < 4; ++i) {
                                const int c = cl + 4 * n + i;
                                if (c < 16) { const float lf = -softplusf_(-(v[i] + b_f[c])); dout[(row < MP ? o_lp + (size_t)row * 16 : o_ls + (size_t)(row - MP) * 16) + c] = lf; }
                                else DT[(size_t)row * 32 + (c - 16)] = softplusf_(v[i] + dt_bias[c - 16]);
                            }
                        }
                    }
            }
        }
    }
};
struct EpiI2 {
    static constexpr bool PERM = true, AFTER_DRAIN = false;
    bf16_t* Y; bf16_t* GATE; float* SSQ;
    __device__ __forceinline__ void operator()(const f32x4 (&acc)[2][2][4][2], const Unit& u, int wr, int wc, int fr_in, int fq_in) const {
        const int ln_ = lane_now(); const int fr = ln_ & 15, fq = ln_ >> 4; (void)fr_in; (void)fq_in;
        const int pn = u.pn, row0 = u.pm * BM + wr * 64 + fr, cl = wc * 32 + 8 * fq;
        if (pn < 8) {
            float nl2 = -1.4426950408889634f; asm volatile("" : "+v"(nl2));
#pragma unroll
            for (int ai = 0; ai < 2; ++ai)
#pragma unroll
                for (int m = 0; m < 4; ++m) {
                    const int row = row0 + ai * HALF + m * 16; float ss = 0.f;
#pragma unroll
                    for (int bj = 0; bj < 2; ++bj) {
                        bf16_t* yp = Y + (size_t)row * 3072 + pn * 256 + bj * HALF + cl;
                        const u32x4 yv = *(const u32x4*)yp; const f32x4 z0 = acc[ai][bj][m][0], z1 = acc[ai][bj][m][1];
                        const float o0 = bflo(yv.x) * silu_c(z0[0], nl2), o1 = bfhi(yv.x) * silu_c(z0[1], nl2), o2 = bflo(yv.y) * silu_c(z0[2], nl2), o3 = bfhi(yv.y) * silu_c(z0[3], nl2);
                        const float o4 = bflo(yv.z) * silu_c(z1[0], nl2), o5 = bfhi(yv.z) * silu_c(z1[1], nl2), o6 = bflo(yv.w) * silu_c(z1[2], nl2), o7 = bfhi(yv.w) * silu_c(z1[3], nl2);
                        ss += (o0 * o0 + o1 * o1) + (o2 * o2 + o3 * o3) + (o4 * o4 + o5 * o5) + (o6 * o6 + o7 * o7);
                        u32x4 w; w.x = cvt_pk_bf16(o0, o1); w.y = cvt_pk_bf16(o2, o3); w.z = cvt_pk_bf16(o4, o5); w.w = cvt_pk_bf16(o6, o7);
                        *(u32x4*)yp = w;
                    }
                    ss += xor_lane(ss, ln_, 16); ss += xor_lane(ss, ln_, 32);
                    if (fq == 0) SSQ[(size_t)row * 32 + pn * 4 + wc] = ss;
                    asm volatile("" ::: "memory"); __builtin_amdgcn_sched_barrier(0);
                }
        } else {
            float nl2 = -1.4426950408889634f; asm volatile("" : "+v"(nl2));
            const int cb = (pn - 8) * 256;
#pragma unroll
            for (int ai = 0; ai < 2; ++ai)
#pragma unroll
                for (int m = 0; m < 4; ++m) {
                    const int row = row0 + ai * HALF + m * 16;
#pragma unroll
                    for (int bj = 0; bj < 2; ++bj) {
                        const f32x4 v0 = acc[ai][bj][m][0], v1 = acc[ai][bj][m][1];
                        u32x4 w; w.x = cvt_pk_bf16(sigm_c(v0[0], nl2), sigm_c(v0[1], nl2)); w.y = cvt_pk_bf16(sigm_c(v0[2], nl2), sigm_c(v0[3], nl2)); w.z = cvt_pk_bf16(sigm_c(v1[0], nl2), sigm_c(v1[1], nl2)); w.w = cvt_pk_bf16(sigm_c(v1[2], nl2), sigm_c(v1[3], nl2));
                        *(u32x4*)(GATE + (size_t)row * 2048 + cb + bj * HALF + cl) = w;
                    }
                    asm volatile("" ::: "memory"); __builtin_amdgcn_sched_barrier(0);
                }
        }
    }
};
struct EpiOA {
    static constexpr bool PERM = true, AFTER_DRAIN = false;
    bf16_t* MA; const bf16_t* GATE;
    __device__ __forceinline__ void operator()(const f32x4 (&acc)[2][2][4][2], const Unit& u, int wr, int wc, int fr_in, int fq_in) const {
        const int ln_ = lane_now(); const int fr = ln_ & 15, fq = ln_ >> 4; (void)fr_in; (void)fq_in;
        const int row0 = u.pm * BM + wr * 64 + fr, col0 = u.pn * BM + wc * 32 + 8 * fq;
#pragma unroll
        for (int ai = 0; ai < 2; ++ai)
#pragma unroll
            for (int m = 0; m < 4; ++m) {
                const int row = row0 + ai * HALF + m * 16;
#pragma unroll
                for (int bj = 0; bj < 2; ++bj) {
                    const int c = col0 + bj * HALF;
                    const u32x4 g = *(const u32x4*)(GATE + (size_t)row * 2048 + c); const f32x4 v0 = acc[ai][bj][m][0], v1 = acc[ai][bj][m][1];
                    u32x4 w; w.x = cvt_pk_bf16(bflo(g.x) * v0[0], bfhi(g.x) * v0[1]); w.y = cvt_pk_bf16(bflo(g.y) * v0[2], bfhi(g.y) * v0[3]);
                    w.z = cvt_pk_bf16(bflo(g.z) * v1[0], bfhi(g.z) * v1[1]); w.w = cvt_pk_bf16(bflo(g.w) * v1[2], bfhi(g.w) * v1[3]);
                    *(u32x4*)(MA + (size_t)row * DM_ + c) = w;
                }
                asm volatile("" ::: "memory"); __builtin_amdgcn_sched_barrier(0);
            }
    }
};
struct EpiOS {
    static constexpr bool PERM = true, AFTER_DRAIN = false;
    bf16_t* MERGED; const bf16_t* MA; const bf16_t* GATE; const float* SSQ; float eps;
    __device__ __forceinline__ void operator()(const f32x4 (&acc)[2][2][4][2], const Unit& u, int wr, int wc, int fr_in, int fq_in) const {
        const int ln_ = lane_now(); const int fr = ln_ & 15, fq = ln_ >> 4; (void)fr_in; (void)fq_in;
        const int row0 = u.pm * BM + wr * 64 + fr, col0 = u.pn * BM + wc * 32 + 8 * fq;
#pragma unroll
        for (int ai = 0; ai < 2; ++ai)
#pragma unroll
            for (int m = 0; m < 4; ++m) {
                const int row = row0 + ai * HALF + m * 16;
                const f32x4* sp = (const f32x4*)(SSQ + (size_t)row * 32); f32x4 s4 = sp[0];
#pragma unroll
                for (int i = 1; i < 8; ++i) s4 = s4 + sp[i];
                const float rstd = __builtin_amdgcn_rsqf(((s4[0] + s4[1]) + (s4[2] + s4[3])) * (1.0f / 2048.0f) + eps);
#pragma unroll
                for (int bj = 0; bj < 2; ++bj) {
                    const int c = col0 + bj * HALF;
                    const u32x4 g = *(const u32x4*)(GATE + (size_t)row * 2048 + 1024 + c), a = *(const u32x4*)(MA + (size_t)row * DM_ + c);
                    const f32x4 v0 = acc[ai][bj][m][0] * rstd, v1 = acc[ai][bj][m][1] * rstd;
                    u32x4 w; w.x = cvt_pk_bf16(bflo(a.x) + bflo(g.x) * v0[0], bfhi(a.x) + bfhi(g.x) * v0[1]); w.y = cvt_pk_bf16(bflo(a.y) + bflo(g.y) * v0[2], bfhi(a.y) + bfhi(g.y) * v0[3]);
                    w.z = cvt_pk_bf16(bflo(a.z) + bflo(g.z) * v1[0], bfhi(a.z) + bfhi(g.z) * v1[1]); w.w = cvt_pk_bf16(bflo(a.w) + bflo(g.w) * v1[2], bfhi(a.w) + bfhi(g.w) * v1[3]);
                    *(u32x4*)(MERGED + (size_t)row * DM_ + c) = w;
                }
                asm volatile("" ::: "memory"); __builtin_amdgcn_sched_barrier(0);
            }
    }
};
template <class Epi, class Sched, bool ALIGN_EPI = false, bool SP2 = false>
__device__ __forceinline__ void gemm_phase(PG8_LAS unsigned char* lds, const Gemm g, const Sched& S, const Epi& E, int wid_in) {
    const int wid = wid_in, lane = lane_now(), tid = wid * 64 + lane, wr = wid >> 2, wc = wid & 3, fr = lane & 15, fq = lane >> 4;
    const int K = g.K, nt = K / BK;
    unsigned voffA[2], voffB[2];
#pragma unroll
    for (int i = 0; i < 2; ++i) { int R, C; stage_rc(tid * 16 + i * 8192, R, C); const int Rb = Epi::PERM ? ((R & ~31) + perm32(R & 31)) : R;
        voffA[i] = (unsigned)(R * g.lda + C) * 2u; voffB[i] = (unsigned)(Rb * K + C) * 2u; }
    const size_t kstep = (size_t)(BK * 2);
    const size_t hstepA = (size_t)HALF * g.lda * 2, hstepB = (size_t)HALF * K * 2;
    const size_t tstepA = 2 * hstepA, tstepB = 2 * hstepB;
    const unsigned ldsw = (unsigned)wid * 1024u;
    const int aoff = lds_byte(wr * 64 + fr, fq * 8), boff = lds_byte(wc * 32 + fr, fq * 8);
#define PG8_SA(b, h) (((b) * 2 + (h)) * HTB)
#define PG8_SB(b, h) ((4 + (b) * 2 + (h)) * HTB)
#define PG8_STAGE(bufoff, gbase, voff) do { _Pragma("unroll") for (int _i = 0; _i < 2; ++_i) \
        __builtin_amdgcn_global_load_lds((const unsigned*)((const char*)(gbase) + (voff)[_i]), (PG8_LAS unsigned*)(lds + (bufoff) + ldsw + _i * 8192), 16, 0, 0); } while (0)
#define PG8_LDA(dst, b, h) do { _Pragma("unroll") for (int m = 0; m < 4; ++m) _Pragma("unroll") for (int k = 0; k < 2; ++k) dst[m][k] = *(const PG8_LAS bf16x8*)(lds + PG8_SA(b, h) + aoff + m * 2048 + k * 1024); } while (0)
#define PG8_LDB(dst, b, h) do { _Pragma("unroll") for (int n = 0; n < 2; ++n) _Pragma("unroll") for (int k = 0; k < 2; ++k) dst[n][k] = *(const PG8_LAS bf16x8*)(lds + PG8_SB(b, h) + boff + n * 2048 + k * 1024); } while (0)
#define PG8_MMA(ai, bj, At, Bt) do { __builtin_amdgcn_s_setprio(1); _Pragma("unroll") for (int m = 0; m < 4; ++m) _Pragma("unroll") for (int n = 0; n < 2; ++n) _Pragma("unroll") for (int k = 0; k < 2; ++k) \
        acc[ai][bj][m][n] = __builtin_amdgcn_mfma_f32_16x16x32_bf16(Bt[n][k], At[m][k], acc[ai][bj][m][n], 0, 0, 0); __builtin_amdgcn_s_setprio(0); } while (0)
#define PG8_WAIT_V(n) asm volatile("s_waitcnt vmcnt(" #n ")" ::: "memory")
#define PG8_WAIT_L(n) asm volatile("s_waitcnt lgkmcnt(" #n ")" ::: "memory")
#define PG8_BAR __builtin_amdgcn_s_barrier()
#define PG8_SCHED __builtin_amdgcn_sched_barrier(0)
    Unit cur, nxt; int ui = 0;
    if (!S.next(0, cur)) return;
    f32x4 acc[2][2][4][2];
#pragma unroll
    for (int a = 0; a < 2; ++a)
#pragma unroll
        for (int b = 0; b < 2; ++b)
#pragma unroll
            for (int m = 0; m < 4; ++m)
#pragma unroll
                for (int n = 0; n < 2; ++n) acc[a][b][m][n] = (f32x4){0.f, 0.f, 0.f, 0.f};
    bf16x8 At[4][2], B0[2][2], B1[2][2];
    const char* cA = (const char*)g.A + (size_t)cur.pm * tstepA; const char* cB = (const char*)g.Bt + (size_t)cur.pn * tstepB;
    S.a_ready(cur);
    if constexpr (SP2) {
        PG8_STAGE(PG8_SB(0, 0), cB, voffB); PG8_STAGE(PG8_SB(0, 1), cB + hstepB, voffB); PG8_STAGE(PG8_SA(0, 0), cA, voffA); PG8_STAGE(PG8_SA(0, 1), cA + hstepA, voffA);
        if (wr == 1) PG8_BAR;
        PG8_WAIT_V(2); PG8_BAR;
        PG8_STAGE(PG8_SB(1, 0), cB + kstep, voffB); PG8_STAGE(PG8_SA(1, 0), cA + kstep, voffA); PG8_STAGE(PG8_SB(1, 1), cB + hstepB + kstep, voffB);
        PG8_WAIT_V(6); PG8_BAR;
    } else {
        PG8_STAGE(PG8_SB(0, 0), cB, voffB); PG8_STAGE(PG8_SA(0, 0), cA, voffA); PG8_STAGE(PG8_SB(0, 1), cB + hstepB, voffB); PG8_STAGE(PG8_SA(0, 1), cA + hstepA, voffA);
        if (wr == 1) PG8_BAR;
        PG8_WAIT_V(4); PG8_BAR;
        PG8_STAGE(PG8_SB(1, 0), cB + kstep, voffB); PG8_STAGE(PG8_SA(1, 0), cA + kstep, voffA); PG8_STAGE(PG8_SB(1, 1), cB + hstepB + kstep, voffB);
        PG8_WAIT_V(6); PG8_BAR;
    }
    for (;;) {
        const bool has_next = S.next(ui + 1, nxt);
        const char* nA = has_next ? (const char*)g.A + (size_t)nxt.pm * tstepA : cA; const char* nB = has_next ? (const char*)g.Bt + (size_t)nxt.pn * tstepB : cB;
        for (int t = 0; t < nt; t += 2) {
            const bool last = (t == nt - 2);
            const char* a1 = cA + (size_t)(t + 1) * kstep;
            const char* a2 = last ? nA : cA + (size_t)(t + 2) * kstep; const char* b2 = last ? nB : cB + (size_t)(t + 2) * kstep;
            const char* a3 = a2 + kstep; const char* b3 = b2 + kstep;
            if (last && has_next) S.a_ready(nxt);
            if constexpr (SP2) {
            PG8_LDB(B0, 0, 0); PG8_LDB(B1, 0, 1); PG8_SCHED; PG8_LDA(At, 0, 0); PG8_STAGE(PG8_SA(1, 1), a1 + hstepA, voffA);
            PG8_WAIT_V(8); PG8_WAIT_L(0); PG8_BAR; PG8_MMA(0, 0, At, B0); PG8_MMA(0, 1, At, B1); PG8_BAR; PG8_SCHED;
            PG8_LDA(At, 0, 1); PG8_STAGE(PG8_SB(0, 0), b2, voffB); PG8_STAGE(PG8_SB(0, 1), b2 + hstepB, voffB); PG8_STAGE(PG8_SA(0, 0), a2, voffA);
            PG8_WAIT_V(8); PG8_WAIT_L(0); PG8_BAR; PG8_MMA(1, 0, At, B0); PG8_MMA(1, 1, At, B1); PG8_BAR; PG8_SCHED;
            PG8_LDB(B0, 1, 0); PG8_LDB(B1, 1, 1); PG8_SCHED; PG8_LDA(At, 1, 0); PG8_STAGE(PG8_SA(0, 1), a2 + hstepA, voffA);
            PG8_WAIT_V(8); PG8_WAIT_L(0); PG8_BAR; PG8_MMA(0, 0, At, B0); PG8_MMA(0, 1, At, B1); PG8_BAR; PG8_SCHED;
            PG8_LDA(At, 1, 1); PG8_STAGE(PG8_SB(1, 0), b3, voffB); PG8_STAGE(PG8_SB(1, 1), b3 + hstepB, voffB); PG8_STAGE(PG8_SA(1, 0), a3, voffA);
            PG8_WAIT_V(8); PG8_WAIT_L(0); PG8_BAR; PG8_MMA(1, 0, At, B0); PG8_MMA(1, 1, At, B1); PG8_BAR; PG8_SCHED;
            } else {
            PG8_LDB(B0, 0, 0); PG8_SCHED; PG8_LDA(At, 0, 0); PG8_STAGE(PG8_SA(1, 1), a1 + hstepA, voffA);
            PG8_WAIT_L(8); PG8_BAR; PG8_WAIT_L(0); PG8_MMA(0, 0, At, B0); PG8_BAR; PG8_SCHED;
            PG8_LDB(B1, 0, 1); PG8_STAGE(PG8_SB(0, 0), b2, voffB);
            PG8_BAR; PG8_WAIT_L(0); PG8_MMA(0, 1, At, B1); PG8_BAR;
            PG8_LDA(At, 0, 1); PG8_STAGE(PG8_SA(0, 0), a2, voffA);
            PG8_BAR; PG8_WAIT_L(0); PG8_MMA(1, 0, At, B0); PG8_BAR; PG8_SCHED;
            PG8_STAGE(PG8_SB(0, 1), b2 + hstepB, voffB);
            PG8_WAIT_V(6); PG8_BAR; PG8_MMA(1, 1, At, B1); PG8_BAR;
            PG8_LDB(B0, 1, 0); PG8_SCHED; PG8_LDA(At, 1, 0); PG8_STAGE(PG8_SA(0, 1), a2 + hstepA, voffA);
            PG8_WAIT_L(8); PG8_BAR; PG8_WAIT_L(0); PG8_MMA(0, 0, At, B0); PG8_BAR; PG8_SCHED;
            PG8_LDB(B1, 1, 1); PG8_STAGE(PG8_SB(1, 0), b3, voffB);
            PG8_BAR; PG8_WAIT_L(0); PG8_MMA(0, 1, At, B1); PG8_BAR;
            PG8_LDA(At, 1, 1); PG8_STAGE(PG8_SA(1, 0), a3, voffA);
            PG8_BAR; PG8_WAIT_L(0); PG8_MMA(1, 0, At, B0); PG8_BAR; PG8_SCHED;
            PG8_STAGE(PG8_SB(1, 1), b3 + hstepB, voffB);
            PG8_WAIT_V(6); PG8_BAR; PG8_MMA(1, 1, At, B1); PG8_BAR;
            }
        }
        if constexpr (ALIGN_EPI) { if (wr == 0) PG8_BAR; }
        if constexpr (!Epi::AFTER_DRAIN) { E(acc, cur, wr, wc, fr, fq); S.done(cur); }
        if (!has_next) break;
#pragma unroll
        for (int a = 0; a < 2; ++a)
#pragma unroll
            for (int b = 0; b < 2; ++b)
#pragma unroll
                for (int m = 0; m < 4; ++m)
#pragma unroll
                    for (int n = 0; n < 2; ++n) acc[a][b][m][n] = (f32x4){0.f, 0.f, 0.f, 0.f};
        cur = nxt; cA = nA; cB = nB; ++ui;
        if constexpr (ALIGN_EPI) { if (wr == 1) PG8_BAR; }
    }
    PG8_WAIT_V(0);
    if constexpr (!ALIGN_EPI) { if (wr == 0) PG8_BAR; }
    PG8_BAR;
    if constexpr (Epi::AFTER_DRAIN) { E.fused(acc, cur, wr, wc, fr, fq, lds, wid, lane); S.done(cur); }
#undef PG8_SA
#undef PG8_SB
#undef PG8_STAGE
#undef PG8_LDA
#undef PG8_LDB
#undef PG8_MMA
#undef PG8_WAIT_V
#undef PG8_WAIT_L
#undef PG8_BAR
#undef PG8_SCHED
}
}

#ifndef PG8_SP2
#define PG8_SP2 true
#endif
#ifndef PG8_ALIGN
#define PG8_ALIGN true
#endif
#include <hip/hip_bf16.h>
#include <cmath>
namespace attn_body {
using bf16=__hip_bfloat16;
using bf16x8=__attribute__((ext_vector_type(8)))short;
using s16x4=__attribute__((ext_vector_type(4)))short;
using f32x16=__attribute__((ext_vector_type(16)))float;
using u32x4=__attribute__((ext_vector_type(4)))unsigned;
constexpr int BATCH=1,NHEAD=16,SEQ=16384,D=64,DM=NHEAD*D;
constexpr int NW=8,QBLK=32,QB=QBLK*NW,KVBLK=64,NQB=SEQ/QB;
constexpr int ATTN_PITCH=DM, ATTN_UNIT_ROWS=QB;
__device__ __forceinline__ int crow(int r,int hi){return (r&3)+8*(r>>2)+4*hi;}
#define SBAR() __builtin_amdgcn_sched_barrier(0)
__device__ __forceinline__ void cmask(f32x16&p0,f32x16&p1,int jb,int qrel,int hi){
  const float NEG=-INFINITY; int kb=64*jb+4*hi;
  #pragma unroll
  for(int r=0;r<16;++r){int kv=kb+(r&3)+8*(r>>2); if(kv>qrel)p0[r]=NEG; if(kv+32>qrel)p1[r]=NEG;}
}

constexpr int NSLOT=3, SLOTB=8192;
constexpr int LDS_K=0, LDS_V=NSLOT*SLOTB, LDS_WS=2*NSLOT*SLOTB, LDS_OST=LDS_WS+NW*64*4, LDS_BYTES=LDS_OST+NW*4096;
constexpr float C2=0.125f*1.4426950408889634f;
__device__ __forceinline__ void glds16(const void*gsrc,unsigned lds_dst){unsigned keep;
  asm volatile("s_mov_b32 %0, m0\n\ts_mov_b32 m0, %2\n\ts_nop 0\n\tglobal_load_lds_dwordx4 %1, off\n\ts_mov_b32 m0, %0":"=&s"(keep):"v"(gsrc),"s"(lds_dst):"memory");}
__device__ __forceinline__ float max3f(float a,float b,float c){float r;asm("v_max3_f32 %0, %1, %2, %3":"=v"(r):"v"(a),"v"(b),"v"(c));return r;}
__device__ __forceinline__ float max2f(float a,float b){float r;asm("v_max_f32_e32 %0, %1, %2":"=v"(r):"v"(a),"v"(b));return r;}
__device__ __forceinline__ float fadd_s(float a,float b){float r;asm("v_add_f32_e32 %0, %1, %2":"=v"(r):"v"(a),"v"(b));return r;}
__device__ __forceinline__ float fsub_s(float a,float b){float r;asm("v_sub_f32_e32 %0, %1, %2":"=v"(r):"v"(a),"v"(b));return r;}
typedef float f32x2_t __attribute__((ext_vector_type(2))); typedef float f32x4_t __attribute__((ext_vector_type(4))); typedef __bf16 bf16x2_t __attribute__((ext_vector_type(2)));
__device__ __forceinline__ unsigned cvtpk_s(float lo,float hi){f32x2_t v={lo,hi};bf16x2_t b=__builtin_convertvector(v,bf16x2_t);return __builtin_bit_cast(unsigned,b);}
#define WAIT_BAR(N) asm volatile("s_waitcnt vmcnt(" #N ") lgkmcnt(0)\n\ts_barrier":::"memory")

__device__ __forceinline__ void qkt(f32x16&p0,f32x16&p1,const char*Kslot,const bf16x8*qr,int r32,int hi){
  const char*kb=Kslot+hi*1024+r32*16;
  #pragma unroll
  for(int d0=0;d0<4;++d0){
    const bf16x8 b0=*reinterpret_cast<const bf16x8*>(kb+d0*2048);
    const bf16x8 b1=*reinterpret_cast<const bf16x8*>(kb+d0*2048+512);
    p0=__builtin_amdgcn_mfma_f32_32x32x16_bf16(b0,qr[d0],p0,0,0,0);p1=__builtin_amdgcn_mfma_f32_32x32x16_bf16(b1,qr[d0],p1,0,0,0);}
}
typedef __attribute__((address_space(3))) const char* lds_cptr;
typedef short v4i16_t __attribute__((ext_vector_type(4)));
__device__ __forceinline__ void kload8(bf16x8*kf,lds_cptr kp){
  kf[0]=*(const __attribute__((address_space(3))) bf16x8*)(kp);      kf[1]=*(const __attribute__((address_space(3))) bf16x8*)(kp+512);
  kf[2]=*(const __attribute__((address_space(3))) bf16x8*)(kp+2048); kf[3]=*(const __attribute__((address_space(3))) bf16x8*)(kp+2560);
  kf[4]=*(const __attribute__((address_space(3))) bf16x8*)(kp+4096); kf[5]=*(const __attribute__((address_space(3))) bf16x8*)(kp+4608);
  kf[6]=*(const __attribute__((address_space(3))) bf16x8*)(kp+6144); kf[7]=*(const __attribute__((address_space(3))) bf16x8*)(kp+6656);
}
__device__ __forceinline__ void kload2(bf16x8*kf,lds_cptr kp,int j){ kf[2*j]=*(const __attribute__((address_space(3))) bf16x8*)(kp+j*2048); kf[2*j+1]=*(const __attribute__((address_space(3))) bf16x8*)(kp+j*2048+512); }
__device__ __forceinline__ s16x4 vtr(lds_cptr p){ return __builtin_bit_cast(s16x4,__builtin_amdgcn_ds_read_tr16_b64_v4i16((__attribute__((address_space(3))) v4i16_t*)p)); }
__device__ __forceinline__ float rowmax(const f32x16&p0,const f32x16&p1){
  float a=max3f(p0[0],p0[1],p1[0]),b=max3f(p0[2],p0[3],p1[1]);a=max3f(a,p1[2],p1[3]);
  #pragma unroll
  for(int r=4;r<16;r+=4){a=max3f(a,p0[r],p0[r+1]);b=max3f(b,p0[r+2],p0[r+3]);a=max3f(a,p1[r],p1[r+1]);b=max3f(b,p1[r+2],p1[r+3]);}
  const float m=max2f(a,b);
  auto rr=__builtin_amdgcn_permlane32_swap(__float_as_uint(m),__float_as_uint(m),false,false);
  return max2f(__uint_as_float(rr[0]),__uint_as_float(rr[1]));
}
__device__ __forceinline__ void pv(f32x16*o,int vb,bf16x8 pa0,bf16x8 pa1,bf16x8 pa2,bf16x8 pa3){
  #pragma unroll
  for(int d0=0;d0<2;++d0){s16x4 lo[4],hi[4];
    #pragma unroll
    for(int ks=0;ks<4;++ks){
      asm volatile("ds_read_b64_tr_b16 %0,%1 offset:%c2":"=&v"(lo[ks]):"v"(vb),"i"(d0*4096+ks*1024):"memory");
      asm volatile("ds_read_b64_tr_b16 %0,%1 offset:%c2":"=&v"(hi[ks]):"v"(vb),"i"(d0*4096+ks*1024+512):"memory");}
    asm volatile("s_waitcnt lgkmcnt(0)":::"memory");SBAR();
    #define PK(k) (bf16x8){lo[k][0],lo[k][1],lo[k][2],lo[k][3],hi[k][0],hi[k][1],hi[k][2],hi[k][3]}
    o[d0]=__builtin_amdgcn_mfma_f32_32x32x16_bf16(pa0,PK(0),o[d0],0,0,0);
    o[d0]=__builtin_amdgcn_mfma_f32_32x32x16_bf16(pa1,PK(1),o[d0],0,0,0);
    o[d0]=__builtin_amdgcn_mfma_f32_32x32x16_bf16(pa2,PK(2),o[d0],0,0,0);
    o[d0]=__builtin_amdgcn_mfma_f32_32x32x16_bf16(pa3,PK(3),o[d0],0,0,0);
    #undef PK
  }
}

#ifndef ATTN_STORE16
#define ATTN_STORE16(p,v) (*(u32x4*)(p)=(v))
#endif
template<int THRL> __device__ __forceinline__ void attn_unit(int b,int h,int qb,const bf16*Q,const bf16*__restrict__ K,const bf16*__restrict__ V,bf16*O,const float*__restrict__ F2h,char*shm,int wid_in){
  const int wid=wid_in,lane=pg8::lane_now(),tid=wid*64+lane,r32=lane&31,hi=lane>>5; (void)tid;
  const long rowbase=(long)b*SEQ; const int q0=qb*QB;
  const bf16*Qw=Q+(rowbase+q0+wid*QBLK)*DM+h*D;
  const bf16*Kh=K+rowbase*DM+h*D,*Vh=V+rowbase*DM+h*D;
  const unsigned lds0=(unsigned)(uintptr_t)shm;
  float*wsf=(float*)(shm+LDS_WS)+wid*64;
  const bf16*ksrc=Kh+(long)lane*DM+wid*8;
  const bf16*vsrc=Vh+(long)(16*(wid&3)+(lane>>2))*DM+(wid>>2)*32+(lane&3)*8;
  const unsigned kdst=lds0+LDS_K+wid*1024, vdst=lds0+LDS_V+wid*1024;
  #define DMA_K(t,slot) glds16(ksrc+(long)(t)*KVBLK*DM,(unsigned)__builtin_amdgcn_readfirstlane(kdst+(slot)))
  #define DMA_V(t,slot) glds16(vsrc+(long)(t)*KVBLK*DM,(unsigned)__builtin_amdgcn_readfirstlane(vdst+(slot)))
  const int vb0=(int)(lds0+LDS_V)+((lane>>4)&1)*32+(lane&3)*8+(4*hi+((lane&15)>>2))*64;
  const char*Kbase=shm+LDS_K; bf16x8 kf[8];
  const lds_cptr shm3=(lds_cptr)shm; const lds_cptr kp0=shm3+LDS_K+hi*1024+r32*16; const lds_cptr vp0=shm3+LDS_V+((lane>>4)&1)*32+(lane&3)*8+(4*hi+((lane&15)>>2))*64;
  const int NT=(q0+QB)/KVBLK;
  DMA_K(0,0);DMA_V(0,0);DMA_K(1,SLOTB);
  bf16x8 qr[4];
  #pragma unroll
  for(int d0=0;d0<4;++d0)qr[d0]=*reinterpret_cast<const bf16x8*>(&Qw[(long)r32*DM+d0*16+hi*8]);
  float mhat=0.f,l_reg=0.f;f32x16 o[2];o[0]=f32x16{};o[1]=f32x16{};
  const int qrel=wid*QBLK+r32;
  const float Gq=F2h[q0+qrel];
  float negs=Gq;
  #define CINIT(C0_,C1_,tt) do{ const f32x4_t*fp_=reinterpret_cast<const f32x4_t*>(F2h+64*(tt)+4*hi); \
    _Pragma("unroll") for(int j_=0;j_<4;++j_){ const f32x4_t a_=fp_[2*j_], b_=fp_[8+2*j_]; \
      C0_[4*j_]=negs-a_[0];C0_[4*j_+1]=negs-a_[1];C0_[4*j_+2]=negs-a_[2];C0_[4*j_+3]=negs-a_[3]; \
      C1_[4*j_]=negs-b_[0];C1_[4*j_+1]=negs-b_[1];C1_[4*j_+2]=negs-b_[2];C1_[4*j_+3]=negs-b_[3]; } }while(0)
  #define CMASK(P0,P1,t) do{int jb_=(t)-(NT-4); if(jb_>=0)cmask(P0,P1,jb_,qrel,hi);}while(0)
  bool resc=false;
  #define START(P0,P1) do{ const float rm=rowmax(P0,P1); resc=false; \
    { const float dl=rm; mhat=fadd_s(mhat,dl); \
      _Pragma("unroll") for(int r=0;r<16;++r){P0[r]=fsub_s(P0[r],dl);P1[r]=fsub_s(P1[r],dl);} \
      negs=Gq-mhat; } \
    _Pragma("unroll") for(int r=0;r<16;++r)P0[r]=__builtin_amdgcn_exp2f(P0[r]); }while(0)
  #define RESC() do{ if(resc){ asm volatile("s_waitcnt lgkmcnt(0)":::"memory"); \
      _Pragma("unroll") for(int d_=0;d_<2;++d_) _Pragma("unroll") for(int r=0;r<16;++r)o[d_][r]*=wsf[crow(r,hi)]; } }while(0)
  f32x16 pA0,pA1,pB0,pB1;
  int sl_prev=0,sl_cur=0,sl_next=SLOTB;
  #define ROT() do{sl_prev=sl_cur;sl_cur=sl_next;sl_next=(sl_next==(NSLOT-1)*SLOTB)?0:sl_next+SLOTB;}while(0)
  DMA_K(2,2*SLOTB);
  WAIT_BAR(3);
  CINIT(pA0,pA1,0); qkt(pA0,pA1,Kbase,qr,r32,hi);asm volatile("s_nop 15\n\ts_nop 7":"+v"(pA0),"+v"(pA1));CMASK(pA0,pA1,0);
  START(pA0,pA1);
  _Pragma("unroll") for(int r=0;r<16;++r)pA1[r]=__builtin_amdgcn_exp2f(pA1[r]);
  WAIT_BAR(0);
  DMA_K(3,0);DMA_V(1,SLOTB);
  ROT();
  kload8(kf,kp0+sl_cur);
  WAIT_BAR(2);
  s16x4 vlo[8],vhi[8]; u32x4 pw0,pw1,pw2,pw3;
  #define PKW(P,B) cvtpk_s(P[B],P[B+1])
  #define PAF(k) __builtin_bit_cast(bf16x8,pw##k)
  #define VFR(i) (bf16x8){vlo[i][0],vlo[i][1],vlo[i][2],vlo[i][3],vhi[i][0],vhi[i][1],vhi[i][2],vhi[i][3]}
  #define PIN(x) asm volatile("":"+v"(x))
  #define MX3(a,b,c) __builtin_fmaxf(__builtin_fmaxf((a),(b)),(c))
  #define GAPA(MF,A0,A1,A2,A3,W0,W1,PW) do{ MF; sacc+=A0; sacc+=A1; sacc+=A2; sacc+=A3; PIN(sacc); W0; W1; PIN(PW); SBAR(); }while(0)
  #define EX(v) __builtin_amdgcn_exp2f(v)
  #define GAPB(MF,X,B) do{ MF; X[B]=EX(X[B]); X[B+1]=EX(X[B+1]); X[B+2]=EX(X[B+2]); X[B+3]=EX(X[B+3]); PIN(X); SBAR(); }while(0)
  #define VRD(i) do{ vlo[i]=vtr(vp_+(((i)>>2)*4096+((i)&3)*1024)); vhi[i]=vtr(vp_+(((i)>>2)*4096+((i)&3)*1024+512)); }while(0)
  #define KRD(G,j) do{ if(G){ kload2(kf,kp0+sl_next,j); SBAR(); } }while(0)
  #define STEP(C0,C1,P0,P1,t,GK,GV,GL) do{ SBAR(); \
    CINIT(C0,C1,t); \
    const lds_cptr vp_=vp0+sl_prev; \
    VRD(0); SBAR(); float sacc=(P0[0]+P0[1]); \
    GAPA(C0=__builtin_amdgcn_mfma_f32_32x32x16_bf16(kf[0],qr[0],C0,0,0,0), P0[2],P0[3],P0[4],P0[5],     pw0[0]=PKW(P0,0), pw0[1]=PKW(P0,2), pw0); \
    VRD(4); SBAR(); GAPA(C1=__builtin_amdgcn_mfma_f32_32x32x16_bf16(kf[1],qr[0],C1,0,0,0), P0[6],P0[7],P0[8],P0[9],     pw0[2]=PKW(P0,4), pw0[3]=PKW(P0,6), pw0); \
    VRD(1); SBAR(); GAPA(C0=__builtin_amdgcn_mfma_f32_32x32x16_bf16(kf[2],qr[1],C0,0,0,0),   P0[10],P0[11],P0[12],P0[13], pw1[0]=PKW(P0,8), pw1[1]=PKW(P0,10), pw1); \
    VRD(5); SBAR(); GAPA(C1=__builtin_amdgcn_mfma_f32_32x32x16_bf16(kf[3],qr[1],C1,0,0,0),   P0[14],P0[15],P1[0],P1[1],   pw1[2]=PKW(P0,12),pw1[3]=PKW(P0,14), pw1); \
    VRD(2); SBAR(); GAPA(C0=__builtin_amdgcn_mfma_f32_32x32x16_bf16(kf[4],qr[2],C0,0,0,0),   P1[2],P1[3],P1[4],P1[5],     pw2[0]=PKW(P1,0), pw2[1]=PKW(P1,2), pw2); \
    VRD(6); SBAR(); GAPA(C1=__builtin_amdgcn_mfma_f32_32x32x16_bf16(kf[5],qr[2],C1,0,0,0),   P1[6],P1[7],P1[8],P1[9],     pw2[2]=PKW(P1,4), pw2[3]=PKW(P1,6), pw2); \
    VRD(3); SBAR(); GAPA(C0=__builtin_amdgcn_mfma_f32_32x32x16_bf16(kf[6],qr[3],C0,0,0,0),   P1[10],P1[11],P1[12],P1[13], pw3[0]=PKW(P1,8), pw3[1]=PKW(P1,10), pw3); \
    VRD(7); SBAR(); GAPA(C1=__builtin_amdgcn_mfma_f32_32x32x16_bf16(kf[7],qr[3],C1,0,0,0),   P1[14],P1[15],0.f,0.f,       pw3[2]=PKW(P1,12),pw3[3]=PKW(P1,14), pw3); \
    l_reg+=sacc; \
    if(GK){DMA_K((t)+3,sl_cur);} if(GV){DMA_V((t)+1,sl_next);} \
    CMASK(C0,C1,t); \
    { float a=MX3(C0[0],C0[1],C1[0]),b=MX3(C0[2],C0[3],C1[1]); a=MX3(a,C1[2],C1[3]); \
      _Pragma("unroll") for(int r=4;r<16;r+=4){a=MX3(a,C0[r],C0[r+1]);b=MX3(b,C0[r+2],C0[r+3]);a=MX3(a,C1[r],C1[r+1]);b=MX3(b,C1[r+2],C1[r+3]);} \
      float rm=__builtin_fmaxf(a,b); { auto rr=__builtin_amdgcn_permlane32_swap(__float_as_uint(rm),__float_as_uint(rm),false,false); rm=__builtin_fmaxf(__uint_as_float(rr[0]),__uint_as_float(rr[1])); } \
      resc=false; \
      if(__builtin_expect(__any(rm>(float)THRL),0)){ const float dl=__builtin_fmaxf(rm,0.f); mhat+=dl; \
        _Pragma("unroll") for(int r=0;r<16;++r){C0[r]-=dl;C1[r]-=dl;} \
        negs=Gq-mhat; \
        const float f=__builtin_amdgcn_exp2f(-dl); l_reg*=f; if(hi==0)wsf[r32]=f; resc=true; } } \
    SBAR(); \
    GAPB(o[0]=__builtin_amdgcn_mfma_f32_32x32x16_bf16(PAF(0),VFR(0),o[0],0,0,0), C0,0); \
    GAPB(o[1]=__builtin_amdgcn_mfma_f32_32x32x16_bf16(PAF(0),VFR(4),o[1],0,0,0), C0,4); \
    KRD(GL,0); GAPB(o[0]=__builtin_amdgcn_mfma_f32_32x32x16_bf16(PAF(1),VFR(1),o[0],0,0,0), C0,8); \
    KRD(GL,1); GAPB(o[1]=__builtin_amdgcn_mfma_f32_32x32x16_bf16(PAF(1),VFR(5),o[1],0,0,0), C0,12); \
    KRD(GL,2); GAPB(o[0]=__builtin_amdgcn_mfma_f32_32x32x16_bf16(PAF(2),VFR(2),o[0],0,0,0), C1,0); \
    KRD(GL,3); GAPB(o[1]=__builtin_amdgcn_mfma_f32_32x32x16_bf16(PAF(2),VFR(6),o[1],0,0,0), C1,4); \
    GAPB(o[0]=__builtin_amdgcn_mfma_f32_32x32x16_bf16(PAF(3),VFR(3),o[0],0,0,0), C1,8); \
    GAPB(o[1]=__builtin_amdgcn_mfma_f32_32x32x16_bf16(PAF(3),VFR(7),o[1],0,0,0), C1,12); \
    }while(0)
  int t=1;
  #undef CMASK
  #define CMASK(P0,P1,t) do{}while(0)
  for(;t+5<NT;t+=2){
    STEP(pB0,pB1,pA0,pA1,t,true,true,true);     WAIT_BAR(2); RESC(); ROT();
    STEP(pA0,pA1,pB0,pB1,t+1,true,true,true);   WAIT_BAR(2); RESC(); ROT();
  }
  #undef CMASK
  #define CMASK(P0,P1,t) do{int jb_=(t)-(NT-4); if(jb_>=0)cmask(P0,P1,jb_,qrel,hi);}while(0)
  #define ENDW(tt) do{ if((tt)+3<NT){WAIT_BAR(2);} else if((tt)+2<NT){WAIT_BAR(1);} else {WAIT_BAR(0);} }while(0)
  for(;t+1<NT;t+=2){
    STEP(pB0,pB1,pA0,pA1,t,(t+3<NT),(t+1<NT),(t+1<NT));       ENDW(t);   RESC(); ROT();
    STEP(pA0,pA1,pB0,pB1,t+1,(t+4<NT),(t+2<NT),(t+2<NT));     ENDW(t+1); RESC(); ROT();
  }
  STEP(pB0,pB1,pA0,pA1,NT-1,false,false,false); RESC();
  { float sacc=pB0[0]+pB0[1]; _Pragma("unroll") for(int r=2;r<16;++r)sacc+=pB0[r]; _Pragma("unroll") for(int r=0;r<16;++r)sacc+=pB1[r]; l_reg+=sacc;
    pw0=(u32x4){PKW(pB0,0),PKW(pB0,2),PKW(pB0,4),PKW(pB0,6)};pw1=(u32x4){PKW(pB0,8),PKW(pB0,10),PKW(pB0,12),PKW(pB0,14)};pw2=(u32x4){PKW(pB1,0),PKW(pB1,2),PKW(pB1,4),PKW(pB1,6)};pw3=(u32x4){PKW(pB1,8),PKW(pB1,10),PKW(pB1,12),PKW(pB1,14)};
    SBAR(); pv(o,vb0+sl_cur,PAF(0),PAF(1),PAF(2),PAF(3)); }
  #undef PKW
  #undef PAF
  #undef VFR
  #undef PIN
  #undef MX3
  #undef GAPA
  #undef GAPB
  #undef EX
  #undef VRD
  #undef KRD
  #undef STEP
  #undef ENDW
  {auto rr=__builtin_amdgcn_permlane32_swap(__float_as_uint(l_reg),__float_as_uint(l_reg),false,false);l_reg=__uint_as_float(rr[0])+__uint_as_float(rr[1]);}
  if(hi==0)wsf[32+r32]=l_reg;asm volatile("s_waitcnt lgkmcnt(0)":::"memory");
  float rli[16];
  #pragma unroll
  for(int r=0;r<16;++r)rli[r]=__builtin_amdgcn_rcpf(wsf[32+crow(r,hi)]);
  bf16*Ow=O+(rowbase+q0+wid*QBLK)*DM+h*D;
  { bf16*stg=(bf16*)(shm+LDS_OST)+wid*2048;
    #pragma unroll
    for(int r=0;r<16;++r){const int orow=crow(r,hi);
      #pragma unroll
      for(int d0=0;d0<2;++d0)stg[orow*64+d0*32+r32]=__float2bfloat16(o[d0][r]*rli[r]);}
    asm volatile("s_waitcnt lgkmcnt(0)":::"memory");
    #pragma unroll
    for(int i=0;i<4;++i){const int row=i*8+(lane>>3),ch=lane&7; const u32x4 v=*(const u32x4*)(stg+row*64+ch*8); ATTN_STORE16(Ow+(long)row*DM+ch*8,v);} }
  asm volatile("s_waitcnt lgkmcnt(0)\n\ts_barrier":::"memory");
  #undef DMA_K
  #undef DMA_V
  #undef CMASK
  #undef CINIT
  #undef START
  #undef RESC
  #undef ROT
}
constexpr int ATTN_LDS_BYTES=LDS_BYTES;
struct AttnTensors { const bf16* Q; const bf16* K; const bf16* V; bf16* O; const float* F2; };
struct AttnUnit { int bh; int qb; };
struct StaticOrder {
  int vcu;
  __device__ __forceinline__ explicit StaticOrder(int grid,int block):vcu((block%8)*(grid/8)+block/8){}
  __device__ __forceinline__ bool next(int i,AttnUnit&u)const{ if(i>=4)return false; const int s=vcu&15; u.bh=vcu>>4; u.qb=(i==0)?63-s:(i==1)?32+s:(i==2)?31-s:s; return true; }
  __device__ __forceinline__ void a_ready(const AttnUnit&)const{}
  __device__ __forceinline__ void done(const AttnUnit&)const{}
};
template<class Sched,int THRL=8> __device__ __forceinline__ void attn_phase(char*lds,const AttnTensors&T,const Sched&S,int wid_in){
  AttnUnit u;
  for(int i=0;S.next(i,u);++i){ S.a_ready(u); attn_unit<THRL>(0,u.bh,u.qb,T.Q,T.K,T.V,T.O,T.F2+(size_t)u.bh*SEQ,lds,wid_in); S.done(u); }
}
#undef SBAR
#undef WAIT_BAR
}
#define GAS __attribute__((address_space(1)))
#define LAS __attribute__((address_space(3)))
typedef unsigned short bf16;
typedef unsigned v4u __attribute__((ext_vector_type(4)));
typedef float f32x4 __attribute__((ext_vector_type(4)));
typedef short bf16x8 __attribute__((ext_vector_type(8)));
typedef GAS unsigned gu32;
typedef GAS unsigned long long gu64;
#define RLX_AGENT __ATOMIC_RELAXED, __HIP_MEMORY_SCOPE_AGENT
#define LDS_WAIT() asm volatile("s_waitcnt lgkmcnt(0)" ::: "memory")
#define VM_WAIT() asm volatile("s_waitcnt vmcnt(0)" ::: "memory")
__device__ __forceinline__ unsigned long long rt() { return __builtin_amdgcn_s_memrealtime(); }
__device__ __forceinline__ unsigned f2bf(float f) { unsigned u = __builtin_bit_cast(unsigned, f); return (u + 0x7fffu + ((u >> 16) & 1u)) >> 16; }
__device__ __forceinline__ unsigned pk2(float lo, float hi) { return f2bf(lo) | (f2bf(hi) << 16); }

#define XB_TMO      128
#define XB_XCNT(j)  (256  + 64 * (j))
#define XB_XSUB(j)  (1280 + 64 * (j))
#define XB_XGEN(j)  (2304 + 64 * (j))
#define XB_TOP      3328
#define XB_TOPGEN   3392
#define XCD_BAR_WORDS 3456
#define XB_SPIN_CAP (1u << 18)

__device__ __forceinline__ unsigned xb_ld(unsigned* p)              { return __hip_atomic_load(p, __ATOMIC_RELAXED, __HIP_MEMORY_SCOPE_AGENT); }
__device__ __forceinline__ unsigned xb_add(unsigned* p, unsigned v) { return __hip_atomic_fetch_add(p, v, __ATOMIC_RELAXED, __HIP_MEMORY_SCOPE_AGENT); }
__device__ __forceinline__ unsigned xb_xcc_id() { return (unsigned)__builtin_amdgcn_s_getreg((3 << 11) | 20) & 0xFu; }
#define XB_SPIN(cond, bar) do { unsigned _sp = 0; while (cond) { __builtin_amdgcn_s_sleep(1); \
    if ((++_sp & 255u) == 0u) { if (xb_ld(&(bar)[XB_TMO])) break; if (_sp > XB_SPIN_CAP) { atomicAdd(&(bar)[XB_TMO], 1u); break; } } } } while (0)

struct XcdBarrier {
    int wave;
    unsigned* bar; unsigned x;
    volatile LAS unsigned* st;
};

__device__ __forceinline__ XcdBarrier xcd_barrier_post(unsigned* bar, volatile LAS unsigned* st, int wave) {
    XcdBarrier b; b.wave = wave; b.bar = bar; b.x = xb_xcc_id(); b.st = st;
    if (wave == 0 && pg8::lane_now() == 0) (void)xb_add(&bar[XB_XCNT(b.x)], 1u);
    return b;
}
__device__ __forceinline__ void xcd_barrier_complete(unsigned* bar, unsigned x, unsigned& nloc, unsigned& nx) {
    const unsigned G = gridDim.x * gridDim.y * gridDim.z;
    unsigned sum, cnt, mine, sp = 0u;
    for (;;) {
        sum = 0u; cnt = 0u; mine = 0u;
#pragma unroll
        for (unsigned j = 0; j < 16; ++j) { const unsigned c = xb_ld(&bar[XB_XCNT(j)]); sum += c; cnt += (c > 0u) ? 1u : 0u; mine = (j == x) ? c : mine; }
        if (sum == G) break;
        __builtin_amdgcn_s_sleep(1);
        if ((++sp & 255u) == 0u) { if (xb_ld(&bar[XB_TMO])) break; if (sp > XB_SPIN_CAP) { atomicAdd(&bar[XB_TMO], 1u); break; } }
    }
    nloc = mine > 0u ? mine : 1u; nx = cnt > 0u ? cnt : 1u;
}

__device__ __forceinline__ void xcd_barrier(const XcdBarrier& b) {
    asm volatile("s_waitcnt vmcnt(0)" ::: "memory");
    __syncthreads();
    if (b.wave == 0 && pg8::lane_now() == 0) {
        unsigned* bar = b.bar;
        __builtin_amdgcn_s_waitcnt(0);
        unsigned nloc = b.st[0], nx = b.st[1];
        if (nloc == 0u) { xcd_barrier_complete(bar, b.x, nloc, nx); b.st[0] = nloc; b.st[1] = nx; }
        const unsigned old = xb_add(&bar[XB_XSUB(b.x)], 1u);
        const unsigned gen = old / nloc;
        if (old + 1u == (gen + 1u) * nloc) {
            __builtin_amdgcn_fence(__ATOMIC_RELEASE, "agent");
            asm volatile("s_waitcnt vmcnt(0)" ::: "memory");
            const unsigned og = xb_add(&bar[XB_TOP], 1u);
            const unsigned tg = og / nx;
            if (og + 1u == (tg + 1u) * nx) xb_add(&bar[XB_TOPGEN], 1u);
            else XB_SPIN(xb_ld(&bar[XB_TOPGEN]) == tg, bar);
            __builtin_amdgcn_fence(__ATOMIC_ACQUIRE, "agent");
            xb_add(&bar[XB_XGEN(b.x)], 1u);
            asm volatile("s_waitcnt vmcnt(0)" ::: "memory");
        } else {
            XB_SPIN(xb_ld(&bar[XB_XGEN(b.x)]) == gen, bar);
            __builtin_amdgcn_fence(__ATOMIC_ACQUIRE, "agent");
            asm volatile("s_waitcnt vmcnt(0)" ::: "memory");
        }
    }
    __syncthreads();
}
constexpr int NWAVES = 8;
constexpr int MP = pg8::MP, MS = pg8::MS, MT = pg8::MT, D = 1024, FF = 2816, NMODC = 9216;
constexpr int H_A = 16, HD = 64, DEC_B = 16, DEC_T = 16, PAST = 1024;
constexpr int D_INNER = 2048, SSD_H = 32, SSD_P = 64, SSD_N = 128, SSD_G = 4, CONV_DIM = 3072, D_IN = 10288;
constexpr int N_I1 = 25 * 256, N_I2 = 16 * 256;
constexpr float EPS = 1e-6f;
constexpr float LOG2E = 1.4426950408889634f;
constexpr int CQ = 0, CK = 1024, CV = 2048, CF = 3072, CZ = 3088, CX = 5136, CDT = 8208, CGA = 8240, CGS = 9264;
constexpr size_t O_Y = 0, O_KP = 17039360, O_VP = 33816576, O_LP = 50593792, O_SP = 50855936, O_CP = 51118080, O_KS = 51127296, O_VS = 51389440, O_LS = 51651584, O_SS = 51655680, O_CS = 55849984, O_END = 55997440;
constexpr size_t MiB = 1u << 20;
constexpr size_t WS_CTL = 0, CTL_ZERO_BYTES = 1 * MiB;
constexpr size_t WS_MOD = 1 * MiB, WS_F2 = 2 * MiB, WS_DT = 3 * MiB, WS_SSQ = 6 * MiB, WS_HALO = 9 * MiB;
constexpr size_t WS_W13A = 14 * MiB, WS_W2A = 25 * MiB, WS_WIN1 = 31 * MiB, WS_WIN2 = 44 * MiB, WS_WA = 52 * MiB, WS_WS = 54 * MiB, WS_WO = 58 * MiB, WS_W13B = 60 * MiB, WS_W2B = 71 * MiB;
constexpr size_t WS_HN = 77 * MiB, WS_QO = 110 * MiB, WS_KB = 143 * MiB, WS_VB = 176 * MiB, WS_XBC = 209 * MiB, WS_END = 307 * MiB;
constexpr size_t WS_GATE = WS_KB;
constexpr size_t WS_MA = WS_HN;
constexpr size_t WS_MERGED = WS_QO;
constexpr size_t WS_ACT2 = WS_XBC;
static_assert(WS_KB + (size_t)MT * 2048 * 2 <= WS_XBC && WS_XBC + (size_t)MT * 3072 * 2 <= WS_END && WS_HALO + 256 * 3 * 3072 * 2 <= WS_W13A && WS_W2B + (size_t)1024 * FF * 2 <= WS_HN, "ws map");
constexpr int CW_BAR = 4096;
constexpr int RING_OFF = 0, RING_BYTES = 131072;
constexpr int LDSCTL_OFF = RING_BYTES, MISC_OFF = LDSCTL_OFF + 320;
constexpr int LDS_BYTES = 147456;

struct Frame {
    LAS unsigned char* lds; volatile LAS unsigned* MISC; gu32* ctl;
    int tid, lane, wave, vcu, G;
};
typedef const __attribute__((address_space(4))) unsigned long long* karg_p;
__device__ __forceinline__ karg_p kbase() { karg_p p = (karg_p)__builtin_amdgcn_kernarg_segment_ptr(); asm volatile("" : "+s"(p)); return p; }
__device__ __forceinline__ const float* kin(int i) { return (const float*)(const GAS float*)kbase()[i]; }
__device__ __forceinline__ float* kout() { return (float*)(GAS float*)kbase()[32]; }
__device__ __forceinline__ unsigned char* kws() { return (unsigned char*)(GAS unsigned char*)kbase()[33]; }
#define REFRESH(F) do { (F).lane = pg8::lane_now(); (F).tid = (F).wave * 64 + (F).lane; } while (0)
__device__ __forceinline__ float wave_sum(float v) {
#pragma unroll
    for (int o = 1; o < 64; o <<= 1) v += __shfl_xor(v, o);
    return v;
}
__device__ __forceinline__ float wave_max(float v) {
#pragma unroll
    for (int o = 1; o < 64; o <<= 1) v = fmaxf(v, __shfl_xor(v, o));
    return v;
}
__device__ __forceinline__ void p0_tr_item(const float* W, int ldw, int K, int srccol, bf16* WT, int drow, int nvalid, const float* kscale, LAS float* scr, int kb, int lane) {
    const int k0 = 64 * kb;
#pragma unroll 8
    for (int i = 0; i < 32; ++i) { const int kk = 2 * i + (lane >> 5), n = lane & 31; float v = (n < nvalid) ? W[(size_t)(k0 + kk) * ldw + srccol + n] : 0.f; if (kscale) v *= kscale[k0 + kk]; scr[kk * 33 + n] = v; }
    LDS_WAIT(); asm volatile("" ::: "memory");
    const int c = lane & 7;
#pragma unroll
    for (int j = 0; j < 4; ++j) { const int n = (lane >> 3) + 8 * j; const LAS float* s = scr + (8 * c) * 33 + n;
        v4u o; o.x = pk2(s[0 * 33], s[1 * 33]); o.y = pk2(s[2 * 33], s[3 * 33]); o.z = pk2(s[4 * 33], s[5 * 33]); o.w = pk2(s[6 * 33], s[7 * 33]);
        if (n < nvalid) *(GAS v4u*)(WT + (size_t)(drow + n) * K + k0 + 8 * c) = o; }
    LDS_WAIT(); asm volatile("" ::: "memory");
}
constexpr int IT_W13 = 2 * (D / 64) * (FF / 32), IT_W2 = (FF / 64) * (D / 32), IT_FFN = IT_W13 + IT_W2;
__device__ __forceinline__ void p0_ffn_item(const float* w1, const float* w3, const float* w2, bf16* W13, bf16* W2t, LAS float* scr, int r, int lane) {
    if (r < IT_W13) { const int which = r / (IT_W13 / 2), q = r % (IT_W13 / 2), kb = q / (FF / 32), nb = q % (FF / 32), j0 = 32 * nb;
        p0_tr_item(which ? w3 : w1, FF, D, j0, W13, 256 * (j0 / 128) + (j0 % 128) + 128 * which, 32, nullptr, scr, kb, lane); }
    else { r -= IT_W13; const int kb = r / (D / 32), nb = r % (D / 32); p0_tr_item(w2, D, FF, 32 * nb, W2t, 32 * nb, 32, nullptr, scr, kb, lane); }
}
__device__ __forceinline__ void p0_prologue(Frame& F) {
    REFRESH(F);
    LAS float* scr = (LAS float*)(F.lds + RING_OFF + F.wave * 16384);
    const int gw = F.vcu * NWAVES + F.wave, NGW = F.G * NWAVES;
    bf16* W13A = (bf16*)(kws() + WS_W13A); bf16* W2A = (bf16*)(kws() + WS_W2A); bf16* W13B = (bf16*)(kws() + WS_W13B); bf16* W2B = (bf16*)(kws() + WS_W2B);
    bf16* WIN1 = (bf16*)(kws() + WS_WIN1); bf16* WIN2 = (bf16*)(kws() + WS_WIN2); bf16* WA = (bf16*)(kws() + WS_WA); bf16* WSs = (bf16*)(kws() + WS_WS); bf16* WO = (bf16*)(kws() + WS_WO);
    const float* w_in = kin(16);
    constexpr int KB16 = D / 64;
    constexpr int IT_IN1 = KB16 * ((3072 + 3072) / 32), IT_F = KB16, IT_DT = KB16, IT_IN2 = KB16 * (4096 / 32), IT_A = KB16 * 32, IT_S = 32 * 32, IT_O = KB16 * 32;
    constexpr int NITEMS = 2 * IT_FFN + IT_IN1 + IT_F + IT_DT + IT_IN2 + IT_A + IT_S + IT_O;
    for (int it = gw; it < NITEMS; it += NGW) {
        int r = it;
        if (r < IT_FFN) { p0_ffn_item(kin(12), kin(13), kin(14), W13A, W2A, scr, r, F.lane); continue; } r -= IT_FFN;
        if (r < IT_FFN) { p0_ffn_item(kin(28), kin(29), kin(30), W13B, W2B, scr, r, F.lane); continue; } r -= IT_FFN;
        if (r < IT_IN1) { const int kb = r / 192, nb = r % 192, j0 = 32 * nb;
            p0_tr_item(w_in, D_IN, D, j0 < 3072 ? j0 : CX + (j0 - 3072), WIN1, j0, 32, nullptr, scr, kb, F.lane); continue; } r -= IT_IN1;
        if (r < IT_F) { p0_tr_item(w_in, D_IN, D, CF, WIN1, 6144, 16, nullptr, scr, r, F.lane); continue; } r -= IT_F;
        if (r < IT_DT) { p0_tr_item(w_in, D_IN, D, CDT, WIN1, 6144 + 16, 32, nullptr, scr, r, F.lane); continue; } r -= IT_DT;
        if (r < IT_IN2) { const int kb = r / 128, nb = r % 128, j0 = 32 * nb;
            p0_tr_item(w_in, D_IN, D, j0 < 2048 ? CZ + j0 : (j0 < 3072 ? CGA + (j0 - 2048) : CGS + (j0 - 3072)), WIN2, j0, 32, nullptr, scr, kb, F.lane); continue; } r -= IT_IN2;
        if (r < IT_A) { p0_tr_item(kin(24), D, D, 32 * (r % 32), WA, 32 * (r % 32), 32, nullptr, scr, r / 32, F.lane); continue; } r -= IT_A;
        if (r < IT_S) { p0_tr_item(kin(25), D, D_INNER, 32 * (r % 32), WSs, 32 * (r % 32), 32, kin(23), scr, r / 32, F.lane); continue; } r -= IT_S;
        p0_tr_item(kin(26), D, D, 32 * (r % 32), WO, 32 * (r % 32), 32, nullptr, scr, r / 32, F.lane);
    }
    { GAS v4u* z = (GAS v4u*)(WIN1 + (size_t)(6144 + 48) * D); const int n16 = 208 * D * 2 / 16; const v4u zero = {0u, 0u, 0u, 0u};
      for (int i = gw * 64 + F.lane; i < n16; i += NGW * 64) z[i] = zero; }
    __syncthreads();
    LAS float* sc = (LAS float*)(F.lds + RING_OFF);
    LAS float* red = (LAS float*)(F.lds + RING_OFF + 69632);
    for (int i = F.tid; i < 17 * 1024; i += NWAVES * 64) { const int rr = i >> 10, k = i & 1023; const float c = rr == 0 ? kin(2)[k] : kin(3)[(size_t)(rr - 1) * 1024 + k]; sc[i] = pg8::silu(c); }
    __syncthreads();
    const float* w_ada = kin(9); const float* b_ada = kin(10); float* mod = (float*)(kws() + WS_MOD);
    for (int un = F.vcu; un < NMODC / 64; un += F.G) {
        const int col = un * 64 + (F.tid & 63), kg = F.tid >> 6;
        float a[17];
#pragma unroll
        for (int rr = 0; rr < 17; ++rr) a[rr] = 0.f;
        for (int k = kg * 128; k < kg * 128 + 128; ++k) { const float w = w_ada[(size_t)k * NMODC + col];
#pragma unroll
            for (int rr = 0; rr < 17; ++rr) a[rr] += sc[rr * 1024 + k] * w; }
#pragma unroll
        for (int rr = 0; rr < 17; ++rr) red[(kg * 17 + rr) * 64 + (F.tid & 63)] = a[rr];
        __syncthreads();
        for (int i = F.tid; i < 17 * 64; i += NWAVES * 64) { const int rr = i >> 6, cc = i & 63; float s = b_ada[un * 64 + cc];
#pragma unroll
            for (int g = 0; g < 8; ++g) s += red[(g * 17 + rr) * 64 + cc];
            mod[(size_t)rr * NMODC + un * 64 + cc] = s; }
        __syncthreads();
    }
}
__device__ __forceinline__ void norm_phase(Frame& F, const float* xp, const float* xs, const float* g, int chunk_shift, bf16* HN) {
    REFRESH(F);
    const int gw = F.vcu * NWAVES + F.wave, NGW = F.G * NWAVES; const float* mod = (const float*)(kws() + WS_MOD);
    for (int m = gw; m < MT; m += NGW) {
        const float* xrow = m < MP ? xp + (size_t)m * D : xs + (size_t)(m - MP) * D;
        const float* sh = mod + (size_t)pg8::bidx(m) * NMODC + chunk_shift * 1024; const float* scl = sh + 1024;
        const GAS f32x4* xr = (const GAS f32x4*)xrow + F.lane;
        f32x4 v[4]; float s = 0.f;
#pragma unroll
        for (int j = 0; j < 4; ++j) { v[j] = xr[64 * j]; s += (v[j].x * v[j].x + v[j].y * v[j].y) + (v[j].z * v[j].z + v[j].w * v[j].w); }
        const float rstd = 1.0f / sqrtf(wave_sum(s) * (1.f / D) + EPS);
        GAS unsigned long long* o8 = (GAS unsigned long long*)(HN + (size_t)m * D) + F.lane;
#pragma unroll
        for (int j = 0; j < 4; ++j) { const int c = 4 * (F.lane + 64 * j); const f32x4 gg = *(const f32x4*)(g + c), s1 = *(const f32x4*)(scl + c), s0 = *(const f32x4*)(sh + c);
            const f32x4 o = v[j] * rstd * gg * (s1 + 1.0f) + s0;
            o8[64 * j] = (unsigned long long)pk2(o.x, o.y) | ((unsigned long long)pk2(o.z, o.w) << 32); }
    }
}
__device__ __forceinline__ void final_norm_phase(Frame& F, float* X, const float* g) {
    REFRESH(F);
    const int gw = F.vcu * NWAVES + F.wave, NGW = F.G * NWAVES;
    for (int m = gw; m < MT; m += NGW) {
        GAS f32x4* xr = (GAS f32x4*)(X + (size_t)m * D) + F.lane;
        f32x4 v[4]; float s = 0.f;
#pragma unroll
        for (int j = 0; j < 4; ++j) { v[j] = xr[64 * j]; s += (v[j].x * v[j].x + v[j].y * v[j].y) + (v[j].z * v[j].z + v[j].w * v[j].w); }
        const float rstd = 1.0f / sqrtf(wave_sum(s) * (1.f / D) + EPS);
#pragma unroll
        for (int j = 0; j < 4; ++j) { const f32x4 gg = *(const f32x4*)(g + 4 * (F.lane + 64 * j)); xr[64 * j] = v[j] * rstd * gg; }
    }
}
__device__ __forceinline__ void fcum_halo_phase(Frame& F) {
    REFRESH(F);
    const float* logf = kout() + O_LP; float* F2 = (float*)(kws() + WS_F2);
    LAS float* part = (LAS float*)(F.lds + RING_OFF);
    if (F.vcu < H_A) {
        const int h = F.vcu; float loc[32]; float s = 0.f;
#pragma unroll
        for (int i = 0; i < 32; ++i) { loc[i] = logf[(size_t)(32 * F.tid + i) * H_A + h]; s += loc[i]; }
        part[F.tid] = s; __syncthreads();
        if (F.tid == 0) { float run = 0.f; for (int i = 0; i < 512; ++i) { const float t = part[i]; part[i] = run; run += t; } }
        __syncthreads();
        float run = part[F.tid];
#pragma unroll
        for (int i = 0; i < 32; ++i) { run += loc[i]; F2[(size_t)h * MP + 32 * F.tid + i] = run * LOG2E; }
        __syncthreads();
    }
    const bf16* XBC = (const bf16*)(kws() + WS_XBC); bf16* HALO = (bf16*)(kws() + WS_HALO);
    const int n8 = 256 * 3 * (CONV_DIM / 8);
    for (int i = F.vcu * NWAVES * 64 + F.tid; i < n8; i += F.G * NWAVES * 64) {
        const int r = i / (3 * 384), rem = i % (3 * 384), j = rem / 384, c8 = rem % 384;
        v4u v = {0u, 0u, 0u, 0u};
        if (r > 0) v = *(const GAS v4u*)(XBC + (size_t)(64 * r - 3 + j) * CONV_DIM + 8 * c8);
        *(GAS v4u*)(HALO + (size_t)i * 8) = v;
    }
}
__device__ __forceinline__ void conv_phase(Frame& F) {
    REFRESH(F);
    bf16* XBC = (bf16*)(kws() + WS_XBC); const bf16* HALO = (const bf16*)(kws() + WS_HALO);
    const float* cw = kin(18); const float* cb = kin(19); const float* sconv = kin(8);
    for (int un = F.vcu; un < 256 + DEC_B; un += F.G) {
        const bool smp = un >= 256; const int row0 = smp ? MP + 16 * (un - 256) : 64 * un, nrows = smp ? 16 : 64;
#pragma unroll 1
        for (int cc = 0; cc < CONV_DIM / (NWAVES * 64); ++cc) {
            const int c = cc * NWAVES * 64 + F.tid;
            const float w0 = cw[c], w1 = cw[CONV_DIM + c], w2 = cw[2 * CONV_DIM + c], w3 = cw[3 * CONV_DIM + c], bb = cb[c];
            float p0, p1, p2;
            if (smp) { const float* s = sconv + (size_t)(un - 256) * 3 * CONV_DIM + c; p0 = s[0]; p1 = s[CONV_DIM]; p2 = s[2 * CONV_DIM]; }
            else { const bf16* s = HALO + (size_t)un * 3 * CONV_DIM + c; p0 = pg8::bf2f(s[0]); p1 = pg8::bf2f(s[CONV_DIM]); p2 = pg8::bf2f(s[2 * CONV_DIM]); }
            bf16* col = XBC + (size_t)row0 * CONV_DIM + c;
#pragma unroll 8
            for (int t = 0; t < nrows; ++t) {
                const float v = pg8::bf2f(col[(size_t)t * CONV_DIM]);
                const float o = bb + w0 * p0 + w1 * p1 + w2 * p2 + w3 * v;
                col[(size_t)t * CONV_DIM] = (bf16)f2bf(pg8::silu(o));
                p0 = p1; p1 = p2; p2 = v;
            }
        }
    }
}
__device__ __forceinline__ void ssd_seq(bf16* XBC, const float* DT, int row0, int nrows, int h, int p, float a, float dsk, float& h0, float& h1, int lane) {
    const int g = h >> 3; constexpr int U = 8;
    bf16* xcol = XBC + (size_t)row0 * CONV_DIM + 64 * h + p;
    const unsigned* Bp = (const unsigned*)(XBC + (size_t)row0 * CONV_DIM + 2048 + 128 * g) + lane;
    const unsigned* Cp = (const unsigned*)(XBC + (size_t)row0 * CONV_DIM + 2560 + 128 * g) + lane;
    const float* dtp = DT + (size_t)row0 * 32 + h;
    unsigned bq[U], cq[U]; float xq[U], dq[U];
#pragma unroll
    for (int i = 0; i < U; ++i) { bq[i] = Bp[(size_t)i * (CONV_DIM / 2)]; cq[i] = Cp[(size_t)i * (CONV_DIM / 2)]; xq[i] = pg8::bf2f(xcol[(size_t)i * CONV_DIM]); dq[i] = dtp[(size_t)i * 32]; }
    for (int t0 = 0; t0 < nrows; t0 += U) {
        unsigned bn[U], cn[U]; float xn[U], dn[U];
        const int tn = (t0 + U < nrows) ? t0 + U : t0;
#pragma unroll
        for (int i = 0; i < U; ++i) { bn[i] = Bp[(size_t)(tn + i) * (CONV_DIM / 2)]; cn[i] = Cp[(size_t)(tn + i) * (CONV_DIM / 2)]; xn[i] = pg8::bf2f(xcol[(size_t)(tn + i) * CONV_DIM]); dn[i] = dtp[(size_t)(tn + i) * 32]; }
        float yv[U];
#pragma unroll
        for (int i = 0; i < U; ++i) {
            const float dA = __expf(dq[i] * a), cf = dq[i] * xq[i];
            h0 = dA * h0 + cf * pg8::bflo(bq[i]); h1 = dA * h1 + cf * pg8::bfhi(bq[i]);
            yv[i] = wave_sum(pg8::bflo(cq[i]) * h0 + pg8::bfhi(cq[i]) * h1) + dsk * xq[i];
        }
        if (lane == 0) {
#pragma unroll
            for (int i = 0; i < U; ++i) xcol[(size_t)(t0 + i) * CONV_DIM] = (bf16)f2bf(yv[i]);
        }
#pragma unroll
        for (int i = 0; i < U; ++i) { bq[i] = bn[i]; cq[i] = cn[i]; xq[i] = xn[i]; dq[i] = dn[i]; }
    }
}
__device__ __forceinline__ void ssd_rec_phase(Frame& F) {
    REFRESH(F);
    bf16* XBC = (bf16*)(kws() + WS_XBC); const float* DT = (const float*)(kws() + WS_DT);
    const float* a_log = kin(21); const float* dskip = kin(22); const float* sssm = kin(7);
    const int gw = F.vcu * NWAVES + F.wave, NGW = F.G * NWAVES;
    for (int un = gw; un < (DEC_B + 1) * SSD_H * SSD_P; un += NGW) {
        const int seq = un / (SSD_H * SSD_P), hp = un % (SSD_H * SSD_P), h = hp >> 6, p = hp & 63;
        const float a = -__expf(a_log[h]), dsk = dskip[h];
        float h0 = 0.f, h1 = 0.f;
        if (seq < DEC_B) {
            const float* s0 = sssm + (((size_t)seq * SSD_H + h) * SSD_P + p) * SSD_N + 2 * F.lane; h0 = s0[0]; h1 = s0[1];
            ssd_seq(XBC, DT, MP + 16 * seq, 16, h, p, a, dsk, h0, h1, F.lane);
            float* so = kout() + O_SS + (((size_t)seq * SSD_H + h) * SSD_P + p) * SSD_N + 2 * F.lane; so[0] = h0; so[1] = h1;
        } else {
            ssd_seq(XBC, DT, 0, MP, h, p, a, dsk, h0, h1, F.lane);
            float* so = kout() + O_SP + ((size_t)h * SSD_P + p) * SSD_N + 2 * F.lane; so[0] = h0; so[1] = h1;
        }
    }
}
__device__ __forceinline__ void attn_sample_phase(Frame& F) {
    REFRESH(F);
    constexpr int NK = PAST + DEC_T;
    const float* ck = kin(4); const float* cv = kin(5); const float* clf = kin(6);
    bf16* QO = (bf16*)(kws() + WS_QO); const bf16* KB = (const bf16*)(kws() + WS_KB); const bf16* VB = (const bf16*)(kws() + WS_VB);
    LAS float* fall = (LAS float*)(F.lds + RING_OFF);
    LAS float* qs = fall + 1040;
    LAS float* sc = qs + 1024;
    LAS float* part = sc + 16 * NK;
    for (int un = F.vcu; un < DEC_B * H_A; un += F.G) {
        const int b = un >> 4, h = un & 15;
        { float loc[2]; loc[0] = clf[((size_t)b * PAST + 2 * F.tid) * H_A + h]; loc[1] = clf[((size_t)b * PAST + 2 * F.tid + 1) * H_A + h];
          part[F.tid] = loc[0] + loc[1]; __syncthreads();
          if (F.tid == 0) { float run = 0.f; for (int i = 0; i < 512; ++i) { const float t = part[i]; part[i] = run; run += t; } }
          __syncthreads();
          const float r0 = part[F.tid] + loc[0]; fall[2 * F.tid] = r0 * LOG2E; fall[2 * F.tid + 1] = (r0 + loc[1]) * LOG2E; __syncthreads();
          if (F.tid == 0) { float run = fall[PAST - 1]; for (int i = 0; i < DEC_T; ++i) { run += kout()[O_LS + ((size_t)b * DEC_T + i) * H_A + h] * LOG2E; fall[PAST + i] = run; } } }
        for (int i = F.tid; i < 1024; i += NWAVES * 64) qs[i] = pg8::bf2f(QO[(size_t)(MP + 16 * b + (i >> 6)) * D + 64 * h + (i & 63)]);
        __syncthreads();
        for (int j = F.tid; j < NK; j += NWAVES * 64) {
            float kk[64];
            if (j < PAST) { const f32x4* kp = (const f32x4*)(ck + (((size_t)b * PAST + j) * H_A + h) * HD);
#pragma unroll
                for (int d4 = 0; d4 < 16; ++d4) { const f32x4 v = kp[d4]; kk[4 * d4] = v.x; kk[4 * d4 + 1] = v.y; kk[4 * d4 + 2] = v.z; kk[4 * d4 + 3] = v.w; } }
            else { const bf16* kp = KB + (size_t)(MP + 16 * b + (j - PAST)) * D + 64 * h;
#pragma unroll
                for (int d = 0; d < 64; ++d) kk[d] = pg8::bf2f(kp[d]); }
            const float fj = fall[j];
#pragma unroll 1
            for (int q = 0; q < DEC_T; ++q) { float s = 0.f;
#pragma unroll
                for (int d = 0; d < 64; ++d) s += qs[q * 64 + d] * kk[d];
                s += fall[PAST + q] - fj;
                sc[q * NK + j] = (j - PAST > q) ? -INFINITY : s; }
        }
        __syncthreads();
        for (int q = 2 * F.wave; q < 2 * F.wave + 2; ++q) {
            float mx = -INFINITY; for (int j = F.lane; j < NK; j += 64) mx = fmaxf(mx, sc[q * NK + j]); mx = wave_max(mx);
            float sm = 0.f; for (int j = F.lane; j < NK; j += 64) { const float pv = __builtin_amdgcn_exp2f(sc[q * NK + j] - mx); sc[q * NK + j] = pv; sm += pv; } sm = wave_sum(sm);
            const float inv = 1.0f / sm; for (int j = F.lane; j < NK; j += 64) sc[q * NK + j] *= inv;
        }
        __syncthreads();
        { const int d = F.tid & 63, q0 = 2 * (F.tid >> 6); float o0 = 0.f, o1 = 0.f;
          for (int j = 0; j < PAST; ++j) { const float v = cv[(((size_t)b * PAST + j) * H_A + h) * HD + d]; o0 += sc[q0 * NK + j] * v; o1 += sc[(q0 + 1) * NK + j] * v; }
          for (int j = 0; j < DEC_T; ++j) { const float v = pg8::bf2f(VB[(size_t)(MP + 16 * b + j) * D + 64 * h + d]); o0 += sc[q0 * NK + PAST + j] * v; o1 += sc[(q0 + 1) * NK + PAST + j] * v; }
          QO[(size_t)(MP + 16 * b + q0) * D + 64 * h + d] = (bf16)f2bf(o0); QO[(size_t)(MP + 16 * b + q0 + 1) * D + 64 * h + d] = (bf16)f2bf(o1); }
        __syncthreads();
    }
}
constexpr int N_PHASES = 18;
#ifndef MK_N_LAUNCHES
#define MK_N_LAUNCHES N_PHASES
#endif
constexpr int N_LAUNCHES = MK_N_LAUNCHES;
struct Args { const float* in[32]; float* out; unsigned char* ws; int ph_lo, ph_hi, li, pad; };
__global__ void __launch_bounds__(NWAVES * 64, 2) mk_fwd(Args args) {
    extern __shared__ __attribute__((aligned(16))) unsigned char lds[];
    Frame F;
    F.lds = (LAS unsigned char*)lds; F.MISC = (volatile LAS unsigned*)(F.lds + MISC_OFF);
    F.wave = __builtin_amdgcn_readfirstlane((int)threadIdx.x >> 6); REFRESH(F);
#ifdef MK_FENCES
    __builtin_amdgcn_fence(__ATOMIC_ACQUIRE, "agent"); asm volatile("s_waitcnt vmcnt(0)" ::: "memory");
#endif
    F.G = gridDim.x; { const int bx = blockIdx.x; F.vcu = (F.G % 8 == 0) ? (bx % 8) * (F.G / 8) + bx / 8 : bx; }
    F.ctl = (gu32*)(args.ws + WS_CTL);
    for (int u = F.tid; u < (LDS_BYTES - LDSCTL_OFF) / 4; u += NWAVES * 64) ((LAS unsigned*)(F.lds + LDSCTL_OFF))[u] = 0u;
    __syncthreads();
    XcdBarrier bar; bar.wave = F.wave; bar.bar = (unsigned*)(F.ctl + CW_BAR); bar.x = 0; bar.st = nullptr;
    if (N_LAUNCHES == 1) bar = xcd_barrier_post((unsigned*)(F.ctl + CW_BAR), F.MISC + 8, F.wave);
    const int lo = args.ph_lo, hi = args.ph_hi;
#ifndef PH_MASK
#define PH_MASK 0xFFFFFFFFu
#endif
#define IN(k) (((PH_MASK >> (k)) & 1u) && lo <= (k) && (k) < hi)
#define SEAM(k) do { if (IN(k) && IN((k) + 1)) xcd_barrier(bar); } while (0)
#define WSP(T, off) ((T*)(kws() + (off)))
#define ACT1P ((bf16*)(kout() + O_KP))
#define XP (kout() + O_Y)
#define GEMM_RUN(EPI, g, N_, E) do { pg8::StaticOrder S; S.init(MT, (N_), F.G, (int)blockIdx.x); pg8::gemm_phase<EPI, pg8::StaticOrder, true, true>(F.lds + RING_OFF, g, S, E, F.wave); } while (0)
    if (IN(0)) { p0_prologue(F); } SEAM(0);
    if (IN(1)) { norm_phase(F, kin(0), kin(1), kin(11), 0, WSP(bf16, WS_HN)); } SEAM(1);
    if (IN(2)) { pg8::Gemm g{WSP(bf16, WS_HN), WSP(const bf16, WS_W13A), MT, 2 * FF, D, D}; pg8::EpiSwiGLU E{ACT1P, FF}; GEMM_RUN(pg8::EpiSwiGLU, g, 2 * FF, E); } SEAM(2);
    if (IN(3)) { pg8::Gemm g{ACT1P, WSP(const bf16, WS_W2A), MT, D, FF, FF}; pg8::EpiResGate E{kin(0), kin(1), XP, WSP(float, WS_MOD), 2, 0.5f}; GEMM_RUN(pg8::EpiResGate, g, D, E); } SEAM(3);
    if (IN(4)) { norm_phase(F, XP, XP + (size_t)MP * D, kin(15), 3, WSP(bf16, WS_HN)); } SEAM(4);
    if (IN(5)) { pg8::Gemm g{WSP(bf16, WS_HN), WSP(const bf16, WS_WIN1), MT, N_I1, D, D};
        pg8::EpiI1 E{WSP(bf16, WS_QO), WSP(bf16, WS_KB), WSP(bf16, WS_VB), WSP(bf16, WS_XBC), kout(), WSP(float, WS_DT), kin(17), kin(20), 0.125f * LOG2E, O_KP, O_VP, O_LP, O_CP, O_KS, O_VS, O_LS, O_CS};
        GEMM_RUN(pg8::EpiI1, g, N_I1, E); } SEAM(5);
    if (IN(6)) { fcum_halo_phase(F); } SEAM(6);
    if (IN(7)) { conv_phase(F); } SEAM(7);
    if (IN(8)) { ssd_rec_phase(F); } SEAM(8);
    if (IN(9)) {
        const attn_body::AttnTensors AT{WSP(const attn_body::bf16, WS_QO), WSP(const attn_body::bf16, WS_KB), WSP(const attn_body::bf16, WS_VB), WSP(attn_body::bf16, WS_QO), WSP(const float, WS_F2)};
        const attn_body::StaticOrder S((int)F.G, (int)blockIdx.x);
        attn_body::attn_phase<attn_body::StaticOrder>((char*)lds + RING_OFF, AT, S, F.wave);
        __syncthreads();
        attn_sample_phase(F);
    } SEAM(9);
    if (IN(10)) { pg8::Gemm g{WSP(bf16, WS_HN), WSP(const bf16, WS_WIN2), MT, N_I2, D, D}; pg8::EpiI2 E{WSP(bf16, WS_XBC), WSP(bf16, WS_GATE), WSP(float, WS_SSQ)}; GEMM_RUN(pg8::EpiI2, g, N_I2, E); } SEAM(10);
    if (IN(11)) { pg8::Gemm g{WSP(bf16, WS_QO), WSP(const bf16, WS_WA), MT, D, D, D}; pg8::EpiOA E{WSP(bf16, WS_MA), WSP(const bf16, WS_GATE)}; GEMM_RUN(pg8::EpiOA, g, D, E); } SEAM(11);
    if (IN(12)) { pg8::Gemm g{WSP(bf16, WS_XBC), WSP(const bf16, WS_WS), MT, D, D_INNER, CONV_DIM}; pg8::EpiOS E{WSP(bf16, WS_MERGED), WSP(const bf16, WS_MA), WSP(const bf16, WS_GATE), WSP(const float, WS_SSQ), EPS}; GEMM_RUN(pg8::EpiOS, g, D, E); } SEAM(12);
    if (IN(13)) { pg8::Gemm g{WSP(bf16, WS_MERGED), WSP(const bf16, WS_WO), MT, D, D, D}; pg8::EpiResGate E{XP, XP + (size_t)MP * D, XP, WSP(float, WS_MOD), 5, 1.0f}; GEMM_RUN(pg8::EpiResGate, g, D, E); } SEAM(13);
    if (IN(14)) { norm_phase(F, XP, XP + (size_t)MP * D, kin(27), 6, WSP(bf16, WS_HN)); } SEAM(14);
    if (IN(15)) { pg8::Gemm g{WSP(bf16, WS_HN), WSP(const bf16, WS_W13B), MT, 2 * FF, D, D}; pg8::EpiSwiGLU E{WSP(bf16, WS_ACT2), FF}; GEMM_RUN(pg8::EpiSwiGLU, g, 2 * FF, E); } SEAM(15);
    if (IN(16)) { pg8::Gemm g{WSP(bf16, WS_ACT2), WSP(const bf16, WS_W2B), MT, D, FF, FF}; pg8::EpiResGate E{XP, XP + (size_t)MP * D, XP, WSP(float, WS_MOD), 8, 0.5f}; GEMM_RUN(pg8::EpiResGate, g, D, E); } SEAM(16);
    if (IN(17)) { final_norm_phase(F, XP, kin(31)); }
#ifdef MK_DUMP_OFF
    if (lo == 99) {
        REFRESH(F); const bf16* s = (const bf16*)(kws() + (size_t)(MK_DUMP_OFF)); float* d = kout();
        for (size_t i = (size_t)blockIdx.x * 512 + F.tid; i < (size_t)(MK_DUMP_ROWS) * (MK_DUMP_COLS); i += (size_t)gridDim.x * 512) { const size_t r = i / (MK_DUMP_COLS), c = i % (MK_DUMP_COLS); d[i] = pg8::bf2f(s[r * (MK_DUMP_PITCH) + c]); }
    }
#endif
#ifdef MK_FENCES
    asm volatile("s_waitcnt vmcnt(0)" ::: "memory"); __builtin_amdgcn_fence(__ATOMIC_RELEASE, "agent"); asm volatile("s_waitcnt vmcnt(0)" ::: "memory");
#endif
#undef IN
#undef SEAM
}

extern "C" void kernel_launch(void* const* d_in, const int* in_sizes, int n_in, void* d_out, int out_size, void* d_ws, size_t ws_size, hipStream_t stream) {
    static int grid = 0;
    if (grid == 0) {
        if (n_in != 32 || out_size != (int)O_END || ws_size < WS_END) { fprintf(stderr, "kernel_launch: unexpected shapes (n_in %d, out %d, ws %zu); nothing launched\n", n_in, out_size, ws_size); grid = -1; return; }
        int dev = 0, cus = 0, per_cu = 0;
        if (hipGetDevice(&dev) != hipSuccess || hipDeviceGetAttribute(&cus, hipDeviceAttributeMultiprocessorCount, dev) != hipSuccess) { grid = -1; return; }
        if (hipFuncSetAttribute((const void*)mk_fwd, hipFuncAttributeMaxDynamicSharedMemorySize, LDS_BYTES) != hipSuccess) { fprintf(stderr, "kernel_launch: hipFuncSetAttribute failed\n"); grid = -1; return; }
        if (hipOccupancyMaxActiveBlocksPerMultiprocessor(&per_cu, (const void*)mk_fwd, NWAVES * 64, LDS_BYTES) != hipSuccess || per_cu < 1)
            fprintf(stderr, "kernel_launch: note: occupancy query reports %d workgroups per CU\n", per_cu);
        (void)hipGetLastError();
        grid = cus;
        if (grid % 16 != 0) { fprintf(stderr, "kernel_launch: %d CUs: the attention deal needs a multiple of 16\n", grid); }
    }
    if (grid < 0) return;
    if (hipMemsetAsync((char*)d_ws + WS_CTL, 0, CTL_ZERO_BYTES, stream) != hipSuccess) return;
    Args a{};
    for (int i = 0; i < 32; ++i) a.in[i] = (const float*)d_in[i];
    a.out = (float*)d_out; a.ws = (unsigned char*)d_ws;
#ifndef MK_LAST_PHASE
#define MK_LAST_PHASE N_PHASES
#endif
    for (int li = 0; li < N_LAUNCHES && li < MK_LAST_PHASE; ++li) {
        a.ph_lo = (N_LAUNCHES == 1) ? 0 : li; a.ph_hi = (N_LAUNCHES == 1) ? N_PHASES : li + 1; a.li = li;
        hipLaunchKernelGGL(mk_fwd, dim3(grid), dim3(NWAVES * 64), LDS_BYTES, stream, a);
        const hipError_t le = hipPeekAtLastError();
        if (le != hipSuccess) { fprintf(stderr, "kernel_launch: launch %d failed: %s\n", li, hipGetErrorName(le)); break; }
    }
#ifdef MK_DUMP_OFF
    a.ph_lo = 99; a.ph_hi = 100; a.li = 99;
    hipLaunchKernelGGL(mk_fwd, dim3(grid), dim3(NWAVES * 64), LDS_BYTES, stream, a);
#endif
}
```

```cpp
#include <hip/hip_runtime.h>
#include <cstdio>
#include <cstdint>
namespace pg8 {
#define PG8_LAS __attribute__((address_space(3)))
typedef unsigned short bf16_t;
typedef short bf16x8 __attribute__((ext_vector_type(8)));
typedef float f32x4 __attribute__((ext_vector_type(4)));
typedef unsigned u32x4 __attribute__((ext_vector_type(4)));
constexpr int BM = 256, BK = 64, HALF = 128, HTB = HALF * BK * 2  , STAGE_BYTES = 8 * HTB, NXCD = 8, WGM = 4;

__host__ __device__ __forceinline__ int lds_byte(int r, int c) { const int st = (r >> 4) * 2 + (c >> 5), rr = r & 15, cc = c & 31, ob = rr * 64 + cc * 2; return st * 1024 + (ob ^ (((ob >> 9) & 1) << 5)); }
__host__ __device__ __forceinline__ void stage_rc(int b, int& R, int& C) { const int st = b / 1024, sb = b % 1024, swz = sb ^ (((sb >> 9) & 1) << 5); R = (st >> 1) * 16 + swz / 64; C = (st & 1) * 32 + (swz % 64) / 2; }
__host__ __device__ __forceinline__ int perm32(int rho) { const int n = rho >> 4, i = rho & 15; return 8 * (i >> 2) + 4 * n + (i & 3); }

struct Unit { int pm, pn; };
struct Gemm { const bf16_t* A; const bf16_t* Bt; int M, N, K, lda; };

struct StaticOrder {
    int nM, nN, nwg, G, c;
    __host__ __device__ void init(int M, int N, int G_, int c_) { nM = M / BM; nN = N / BM; nwg = nM * nN; G = G_; c = c_; }
    __host__ __device__ bool next(int i, Unit& u) const {
        const long L = (long)i * G + c; if (L >= nwg) return false;
        int wgid = (int)L; { const int q = nwg / NXCD, r = nwg % NXCD, xcd = wgid % NXCD, off = wgid / NXCD; wgid = (xcd < r ? xcd * (q + 1) : r * (q + 1) + (xcd - r) * q) + off; }
        const int nig = WGM * nN, gid = wgid / nig, fm = gid * WGM, gsz = (nM - fm) < WGM ? (nM - fm) : WGM;
        u.pm = fm + ((wgid % nig) % gsz); u.pn = (wgid % nig) / gsz; return true;
    }
    __device__ __forceinline__ void a_ready(const Unit&) const {}
    __device__ __forceinline__ void done(const Unit&) const {}
};

struct StaticOrder65 {
    StaticOrder base; int nN, n64, G, c;
    __host__ __device__ void init(int N, int G_, int c_) { base.init(64 * BM, N, G_, c_); nN = N / BM; n64 = 64 * nN; G = G_; c = c_; }
    __host__ __device__ bool next(int i, Unit& u) const {
        const long L = (long)i * G + c;
        if (L < n64) return base.next(i, u);
        if (L < n64 + nN) { u.pm = 64; u.pn = (int)(L - n64); return true; }
        return false;
    }
    __device__ __forceinline__ void a_ready(const Unit&) const {}
    __device__ __forceinline__ void done(const Unit&) const {}
};

typedef float f32x2 __attribute__((ext_vector_type(2))); typedef __bf16 bf16x2v __attribute__((ext_vector_type(2)));
__device__ __forceinline__ unsigned cvt_pk_bf16(float lo, float hi) { f32x2 v = {lo, hi}; return __builtin_bit_cast(unsigned, __builtin_convertvector(v, bf16x2v)); }
constexpr int MP = 16384, MS = 256, MT = MP + MS, DM_ = 1024, NMODC = 9 * 1024;
__device__ __forceinline__ int bidx(int m) { return m < MP ? 0 : 1 + ((m - MP) >> 4); }
__device__ __forceinline__ float sigm(float x) { return __builtin_amdgcn_rcpf(1.f + __builtin_amdgcn_exp2f(-1.4426950408889634f * x)); }
__device__ __forceinline__ float silu(float x) { return x * sigm(x); }
__device__ __forceinline__ float sigm_c(float x, float c) { return __builtin_amdgcn_rcpf(1.f + __builtin_amdgcn_exp2f(c * x)); }
__device__ __forceinline__ float silu_c(float x, float c) { return x * sigm_c(x, c); }
__device__ __forceinline__ float bf2f(unsigned short b) { return __uint_as_float(((unsigned)b) << 16); }
__device__ __forceinline__ float bflo(unsigned w) { return __uint_as_float(w << 16); }
__device__ __forceinline__ float bfhi(unsigned w) { return __uint_as_float(w & 0xffff0000u); }
__device__ __forceinline__ int lane_now() { int l; asm volatile("v_mbcnt_lo_u32_b32 %0, -1, 0\n\tv_mbcnt_hi_u32_b32 %0, -1, %0" : "=v"(l)); return l; }
__device__ __forceinline__ float xor_lane(float v, int ln, int mask) { return __int_as_float(__builtin_amdgcn_ds_bpermute((ln ^ mask) << 2, __float_as_int(v))); }
__device__ __forceinline__ float softplusf_(float x) { return fmaxf(x, 0.f) + 0.6931471805599453f * __builtin_amdgcn_logf(1.0f + __builtin_amdgcn_exp2f(-1.4426950408889634f * fabsf(x))); }

struct EpiSwiGLU {
    static constexpr bool PERM = true, AFTER_DRAIN = false;
    bf16_t* O; int ldc;
    __device__ __forceinline__ void operator()(const f32x4 (&acc)[2][2][4][2], const Unit& u, int wr, int wc, int fr_in, int fq_in) const {
        const int ln_ = lane_now(); const int fr = ln_ & 15, fq = ln_ >> 4; (void)fr_in; (void)fq_in;
        const int row0 = u.pm * BM + wr * 64 + fr, col0 = u.pn * HALF + wc * 32 + 8 * fq;
#pragma unroll
        for (int ai = 0; ai < 2; ++ai)
#pragma unroll
            for (int m = 0; m < 4; ++m) {
                bf16_t* rowp = O + (size_t)(row0 + ai * HALF + m * 16) * ldc + col0;
                const f32x4 a0 = acc[ai][0][m][0], a1 = acc[ai][0][m][1], g0 = acc[ai][1][m][0], g1 = acc[ai][1][m][1];
                u32x4 w;
                w.x = cvt_pk_bf16(silu(a0[0]) * g0[0], silu(a0[1]) * g0[1]); w.y = cvt_pk_bf16(silu(a0[2]) * g0[2], silu(a0[3]) * g0[3]);
                w.z = cvt_pk_bf16(silu(a1[0]) * g1[0], silu(a1[1]) * g1[1]); w.w = cvt_pk_bf16(silu(a1[2]) * g1[2], silu(a1[3]) * g1[3]);
                *(u32x4*)rowp = w;
                asm volatile("" ::: "memory"); __builtin_amdgcn_sched_barrier(0);
            }
    }
};
struct EpiResGate {
    static constexpr bool PERM = false, AFTER_DRAIN = false;
    const float* xp; const float* xs; float* out; const float* mod; int chunk; float gsc;
    __device__ __forceinline__ void elem(int row, int c, float v) const { const float g = mod[(size_t)bidx(row) * NMODC + chunk * 1024 + c]; const float bs = row < MP ? xp[(size_t)row * DM_ + c] : xs[(size_t)(row - MP) * DM_ + c]; out[(size_t)row * DM_ + c] = bs + (g + 1.0f) * gsc * v; }
    __device__ __forceinline__ void operator()(const f32x4 (&acc)[2][2][4][2], const Unit& u, int wr, int wc, int fr_in, int fq_in) const {
        const int ln_ = lane_now(); const int fr = ln_ & 15, fq = ln_ >> 4; (void)fr_in; (void)fq_in;
        const int col0 = u.pn * BM + wc * 32 + 4 * fq;
#pragma unroll
        for (int ai = 0; ai < 2; ++ai)
#pragma unroll
            for (int m = 0; m < 4; ++m) {
                const int row = u.pm * BM + ai * HALF + wr * 64 + m * 16 + fr;
                const float* gp = mod + (size_t)bidx(row) * NMODC + chunk * 1024;
                const float* bp = row < MP ? xp + (size_t)row * DM_ : xs + (size_t)(row - MP) * DM_;
                float* op = out + (size_t)row * DM_;
#pragma unroll
                for (int bj = 0; bj < 2; ++bj)
#pragma unroll
                    for (int n = 0; n < 2; ++n) {
                        const int c = col0 + bj * HALF + n * 16;
                        const f32x4 g = *(const f32x4*)(gp + c), bs = *(const f32x4*)(bp + c);
                        *(f32x4*)(op + c) = bs + (g + 1.0f) * gsc * acc[ai][bj][m][n];
                    }
                asm volatile("" ::: "memory"); __builtin_amdgcn_sched_barrier(0);
            }
    }
};

struct EpiI1 {
    static constexpr bool PERM = true, AFTER_DRAIN = false;
    bf16_t *Q; size_t qkv_stride; bf16_t *XBC; float* dout; float* DT; const float *b_f, *dt_bias; float c2; bf16_t* HALO;
    size_t o_kp, o_lp, o_cp, o_ks, d_v, d_vs, o_ls, o_cs;
    __device__ __forceinline__ void operator()(const f32x4 (&acc)[2][2][4][2], const Unit& u, int wr, int wc, int fr_in, int fq_in) const {
        const int ln_ = lane_now(); const int fr = ln_ & 15, fq = ln_ >> 4; (void)fr_in; (void)fq_in;
        const int pn = u.pn, row0 = u.pm * BM + wr * 64 + fr, cl = wc * 32 + 8 * fq;
        if (pn < 12) {
            const int t = pn >> 2, cb = (pn & 3) * 256;
#pragma unroll
            for (int ai = 0; ai < 2; ++ai)
#pragma unroll
                for (int m = 0; m < 4; ++m) {
                    const int row = row0 + ai * HALF + m * 16;
#pragma unroll
                    for (int bj = 0; bj < 2; ++bj) {
                        const int c = cb + bj * HALF + cl;
                        f32x4 v0 = acc[ai][bj][m][0], v1 = acc[ai][bj][m][1];
                        if (t == 0) { v0 = v0 * c2; v1 = v1 * c2; }
                        u32x4 w; w.x = cvt_pk_bf16(v0[0], v0[1]); w.y = cvt_pk_bf16(v0[2], v0[3]); w.z = cvt_pk_bf16(v1[0], v1[1]); w.w = cvt_pk_bf16(v1[2], v1[3]);
                        bf16_t* dst = Q + (size_t)t * qkv_stride + (size_t)row * DM_ + c;
                        *(u32x4*)dst = w;
                        if (t != 0) {
                            float* fo = dout + (row < MP ? o_kp + (t == 2 ? d_v : (size_t)0) + (size_t)row * DM_ : o_ks + (t == 2 ? d_vs : (size_t)0) + (size_t)(row - MP) * DM_) + c;
                            *(f32x4*)fo = v0; *(f32x4*)(fo + 4) = v1;
                        }
                    }
                    asm volatile("" ::: "memory"); __builtin_amdgcn_sched_barrier(0);
                }
        } else if (pn < 24) {
            const int cb = (pn - 12) * 256;
#pragma unroll
            for (int ai = 0; ai < 2; ++ai)
#pragma unroll
                for (int m = 0; m < 4; ++m) {
                    const int row = row0 + ai * HALF + m * 16;
#pragma unroll
                    for (int bj = 0; bj < 2; ++bj) {
                        const int c = cb + bj * HALF + cl;
                        const f32x4 v0 = acc[ai][bj][m][0], v1 = acc[ai][bj][m][1];
                        u32x4 w; w.x = cvt_pk_bf16(v0[0], v0[1]); w.y = cvt_pk_bf16(v0[2], v0[3]); w.z = cvt_pk_bf16(v1[0], v1[1]); w.w = cvt_pk_bf16(v1[2], v1[3]);
                        *(u32x4*)(XBC + (size_t)row * 3072 + c) = w;
                        if (row < MP - 3 && (row & 63) >= 61) *(u32x4*)(HALO + ((size_t)((row >> 6) + 1) * 3 + ((row & 63) - 61)) * 3072 + c) = w;
                        float* fo = nullptr;
                        if (row >= MP - 3 && row < MP) fo = dout + o_cp + (size_t)(row - (MP - 3)) * 3072 + c;
                        else if (row >= MP && ((row - MP) & 15) >= 13) fo = dout + o_cs + (size_t)((row - MP) >> 4) * 9216 + (size_t)(((row - MP) & 15) - 13) * 3072 + c;
                        if (fo) { *(f32x4*)fo = v0; *(f32x4*)(fo + 4) = v1; }
                    }
                    asm volatile("" ::: "memory"); __builtin_amdgcn_sched_barrier(0);
                }
        } else {
            if (cl < 48) {
#pragma unroll
                for (int ai = 0; ai < 2; ++ai)
#pragma unroll
                    for (int m = 0; m < 4; ++m) {
                        const int row = row0 + ai * HALF + m * 16;
#pragma unroll
                        for (int n = 0; n < 2; ++n) {
                            const f32x4 v = acc[ai][0][m][n];
#pragma unroll
                            for (int i = 0; i < 4; ++i) {
                                const int c = cl + 4 * n + i;
                                if (c < 16) { const float lf = -softplusf_(-(v[i] + b_f[c])); dout[(row < MP ? o_lp + (size_t)row * 16 : o_ls + (size_t)(row - MP) * 16) + c] = lf; }
                                else DT[(size_t)row * 32 + (c - 16)] = softplusf_(v[i] + dt_bias[c - 16]);
                            }
                        }
                    }
            }
        }
    }
};
struct EpiI2 {
    static constexpr bool PERM = true, AFTER_DRAIN = false;
    bf16_t* Y; bf16_t* GATE; float* SSQ;
    __device__ __forceinline__ void elem(int row, int c, float v) const {
        if (c < 2048) { bf16_t* yp = Y + (size_t)row * 2048 + c; *yp = (bf16_t)(cvt_pk_bf16(bf2f(*yp) * silu(v), 0.f) & 0xffffu); }
        else GATE[(size_t)row * 2048 + (c - 2048)] = (bf16_t)(cvt_pk_bf16(sigm(v), 0.f) & 0xffffu); }
    __device__ __forceinline__ void operator()(const f32x4 (&acc)[2][2][4][2], const Unit& u, int wr, int wc, int fr_in, int fq_in) const {
        const int ln_ = lane_now(); const int fr = ln_ & 15, fq = ln_ >> 4; (void)fr_in; (void)fq_in;
        const int pn = u.pn, row0 = u.pm * BM + wr * 64 + fr, cl = wc * 32 + 8 * fq;
        if (pn < 8) {
            float nl2 = -1.4426950408889634f; asm volatile("" : "+v"(nl2));
#pragma unroll
            for (int ai = 0; ai < 2; ++ai)
#pragma unroll
                for (int m = 0; m < 4; ++m) {
                    const int row = row0 + ai * HALF + m * 16; float ss = 0.f;
#pragma unroll
                    for (int bj = 0; bj < 2; ++bj) {
                        bf16_t* yp = Y + (size_t)row * 2048 + pn * 256 + bj * HALF + cl;
                        const u32x4 yv = *(const u32x4*)yp; const f32x4 z0 = acc[ai][bj][m][0], z1 = acc[ai][bj][m][1];
                        const float o0 = bflo(yv.x) * silu_c(z0[0], nl2), o1 = bfhi(yv.x) * silu_c(z0[1], nl2), o2 = bflo(yv.y) * silu_c(z0[2], nl2), o3 = bfhi(yv.y) * silu_c(z0[3], nl2);
                        const float o4 = bflo(yv.z) * silu_c(z1[0], nl2), o5 = bfhi(yv.z) * silu_c(z1[1], nl2), o6 = bflo(yv.w) * silu_c(z1[2], nl2), o7 = bfhi(yv.w) * silu_c(z1[3], nl2);
                        ss += (o0 * o0 + o1 * o1) + (o2 * o2 + o3 * o3) + (o4 * o4 + o5 * o5) + (o6 * o6 + o7 * o7);
                        u32x4 w; w.x = cvt_pk_bf16(o0, o1); w.y = cvt_pk_bf16(o2, o3); w.z = cvt_pk_bf16(o4, o5); w.w = cvt_pk_bf16(o6, o7);
                        *(u32x4*)yp = w;
                    }
                    ss += xor_lane(ss, ln_, 16); ss += xor_lane(ss, ln_, 32);
                    if (fq == 0) SSQ[(size_t)row * 32 + pn * 4 + wc] = ss;
                    asm volatile("" ::: "memory"); __builtin_amdgcn_sched_barrier(0);
                }
        } else {
            float nl2 = -1.4426950408889634f; asm volatile("" : "+v"(nl2));
            const int cb = (pn - 8) * 256;
#pragma unroll
            for (int ai = 0; ai < 2; ++ai)
#pragma unroll
                for (int m = 0; m < 4; ++m) {
                    const int row = row0 + ai * HALF + m * 16;
#pragma unroll
                    for (int bj = 0; bj < 2; ++bj) {
                        const f32x4 v0 = acc[ai][bj][m][0], v1 = acc[ai][bj][m][1];
                        u32x4 w; w.x = cvt_pk_bf16(sigm_c(v0[0], nl2), sigm_c(v0[1], nl2)); w.y = cvt_pk_bf16(sigm_c(v0[2], nl2), sigm_c(v0[3], nl2)); w.z = cvt_pk_bf16(sigm_c(v1[0], nl2), sigm_c(v1[1], nl2)); w.w = cvt_pk_bf16(sigm_c(v1[2], nl2), sigm_c(v1[3], nl2));
                        *(u32x4*)(GATE + (size_t)row * 2048 + cb + bj * HALF + cl) = w;
                    }
                    asm volatile("" ::: "memory"); __builtin_amdgcn_sched_barrier(0);
                }
        }
    }
};
struct EpiOA {
    static constexpr bool PERM = true, AFTER_DRAIN = false;
    bf16_t* MA; const bf16_t* GATE;
    __device__ __forceinline__ void elem(int row, int c, float v) const { const float o = bf2f(GATE[(size_t)row * 2048 + c]) * v; MA[(size_t)row * DM_ + c] = (bf16_t)(cvt_pk_bf16(o, 0.f) & 0xffffu); }
    __device__ __forceinline__ void operator()(const f32x4 (&acc)[2][2][4][2], const Unit& u, int wr, int wc, int fr_in, int fq_in) const {
        const int ln_ = lane_now(); const int fr = ln_ & 15, fq = ln_ >> 4; (void)fr_in; (void)fq_in;
        const int row0 = u.pm * BM + wr * 64 + fr, col0 = u.pn * BM + wc * 32 + 8 * fq;
#pragma unroll
        for (int ai = 0; ai < 2; ++ai)
#pragma unroll
            for (int m = 0; m < 4; ++m) {
                const int row = row0 + ai * HALF + m * 16;
#pragma unroll
                for (int bj = 0; bj < 2; ++bj) {
                    const int c = col0 + bj * HALF;
                    const u32x4 g = *(const u32x4*)(GATE + (size_t)row * 2048 + c); const f32x4 v0 = acc[ai][bj][m][0], v1 = acc[ai][bj][m][1];
                    u32x4 w; w.x = cvt_pk_bf16(bflo(g.x) * v0[0], bfhi(g.x) * v0[1]); w.y = cvt_pk_bf16(bflo(g.y) * v0[2], bfhi(g.y) * v0[3]);
                    w.z = cvt_pk_bf16(bflo(g.z) * v1[0], bfhi(g.z) * v1[1]); w.w = cvt_pk_bf16(bflo(g.w) * v1[2], bfhi(g.w) * v1[3]);
                    *(u32x4*)(MA + (size_t)row * DM_ + c) = w;
                }
                asm volatile("" ::: "memory"); __builtin_amdgcn_sched_barrier(0);
            }
    }
};
struct EpiOS {
    static constexpr bool PERM = true, AFTER_DRAIN = false;
    bf16_t* MERGED; const bf16_t* MA; const bf16_t* GATE; const float* SSQ; float eps;
    __device__ __forceinline__ void elem(int row, int c, float v) const { const f32x4* sp = (const f32x4*)(SSQ + (size_t)row * 32); f32x4 s4 = sp[0];
#pragma unroll
        for (int i = 1; i < 8; ++i) s4 = s4 + sp[i];
        const float rstd = __builtin_amdgcn_rsqf(((s4[0] + s4[1]) + (s4[2] + s4[3])) * (1.0f / 2048.0f) + eps);
        const float o = bf2f(MA[(size_t)row * DM_ + c]) + bf2f(GATE[(size_t)row * 2048 + 1024 + c]) * rstd * v; MERGED[(size_t)row * DM_ + c] = (bf16_t)(cvt_pk_bf16(o, 0.f) & 0xffffu); }
    __device__ __forceinline__ void operator()(const f32x4 (&acc)[2][2][4][2], const Unit& u, int wr, int wc, int fr_in, int fq_in) const {
        const int ln_ = lane_now(); const int fr = ln_ & 15, fq = ln_ >> 4; (void)fr_in; (void)fq_in;
        const int row0 = u.pm * BM + wr * 64 + fr, col0 = u.pn * BM + wc * 32 + 8 * fq;
#pragma unroll
        for (int ai = 0; ai < 2; ++ai)
#pragma unroll
            for (int m = 0; m < 4; ++m) {
                const int row = row0 + ai * HALF + m * 16;
                const f32x4* sp = (const f32x4*)(SSQ + (size_t)row * 32); f32x4 s4 = sp[0];
#pragma unroll
                for (int i = 1; i < 8; ++i) s4 = s4 + sp[i];
                const float rstd = __builtin_amdgcn_rsqf(((s4[0] + s4[1]) + (s4[2] + s4[3])) * (1.0f / 2048.0f) + eps);
#pragma unroll
                for (int bj = 0; bj < 2; ++bj) {
                    const int c = col0 + bj * HALF;
                    const u32x4 g = *(const u32x4*)(GATE + (size_t)row * 2048 + 1024 + c), a = *(const u32x4*)(MA + (size_t)row * DM_ + c);
                    const f32x4 v0 = acc[ai][bj][m][0] * rstd, v1 = acc[ai][bj][m][1] * rstd;
                    u32x4 w; w.x = cvt_pk_bf16(bflo(a.x) + bflo(g.x) * v0[0], bfhi(a.x) + bfhi(g.x) * v0[1]); w.y = cvt_pk_bf16(bflo(a.y) + bflo(g.y) * v0[2], bfhi(a.y) + bfhi(g.y) * v0[3]);
                    w.z = cvt_pk_bf16(bflo(a.z) + bflo(g.z) * v1[0], bfhi(a.z) + bfhi(g.z) * v1[1]); w.w = cvt_pk_bf16(bflo(a.w) + bflo(g.w) * v1[2], bfhi(a.w) + bfhi(g.w) * v1[3]);
                    *(u32x4*)(MERGED + (size_t)row * DM_ + c) = w;
                }
                asm volatile("" ::: "memory"); __builtin_amdgcn_sched_barrier(0);
            }
    }
};
template <class Epi, class Sched, bool ALIGN_EPI = false, bool SP2 = false>
__device__ __forceinline__ void gemm_phase(PG8_LAS unsigned char* lds, const Gemm g, const Sched& S, const Epi& E, int wid_in) {
    const int wid = wid_in, lane = lane_now(), tid = wid * 64 + lane, wr = wid >> 2, wc = wid & 3, fr = lane & 15, fq = lane >> 4;
    const int K = g.K, nt = K / BK;
    unsigned voffA[2], voffB[2];
#pragma unroll
    for (int i = 0; i < 2; ++i) { int R, C; stage_rc(tid * 16 + i * 8192, R, C); const int Rb = Epi::PERM ? ((R & ~31) + perm32(R & 31)) : R;
        voffA[i] = (unsigned)(R * g.lda + C) * 2u; voffB[i] = (unsigned)(Rb * K + C) * 2u; }
    const size_t kstep = (size_t)(BK * 2);
    const size_t hstepA = (size_t)HALF * g.lda * 2, hstepB = (size_t)HALF * K * 2;
    const size_t tstepA = 2 * hstepA, tstepB = 2 * hstepB;
    const unsigned ldsw = (unsigned)wid * 1024u;
    const int aoff = lds_byte(wr * 64 + fr, fq * 8), boff = lds_byte(wc * 32 + fr, fq * 8);
#define PG8_SA(b, h) (((b) * 2 + (h)) * HTB)
#define PG8_SB(b, h) ((4 + (b) * 2 + (h)) * HTB)
#define PG8_STAGE(bufoff, gbase, voff) do { _Pragma("unroll") for (int _i = 0; _i < 2; ++_i) \
        __builtin_amdgcn_global_load_lds((const unsigned*)((const char*)(gbase) + (voff)[_i]), (PG8_LAS unsigned*)(lds + (bufoff) + ldsw + _i * 8192), 16, 0, 0); } while (0)
#define PG8_LDA(dst, b, h) do { _Pragma("unroll") for (int m = 0; m < 4; ++m) _Pragma("unroll") for (int k = 0; k < 2; ++k) dst[m][k] = *(const PG8_LAS bf16x8*)(lds + PG8_SA(b, h) + aoff + m * 2048 + k * 1024); } while (0)
#define PG8_LDB(dst, b, h) do { _Pragma("unroll") for (int n = 0; n < 2; ++n) _Pragma("unroll") for (int k = 0; k < 2; ++k) dst[n][k] = *(const PG8_LAS bf16x8*)(lds + PG8_SB(b, h) + boff + n * 2048 + k * 1024); } while (0)
#define PG8_MMA(ai, bj, At, Bt) do { __builtin_amdgcn_s_setprio(1); _Pragma("unroll") for (int m = 0; m < 4; ++m) _Pragma("unroll") for (int n = 0; n < 2; ++n) _Pragma("unroll") for (int k = 0; k < 2; ++k) \
        acc[ai][bj][m][n] = __builtin_amdgcn_mfma_f32_16x16x32_bf16(Bt[n][k], At[m][k], acc[ai][bj][m][n], 0, 0, 0); __builtin_amdgcn_s_setprio(0); } while (0)
#define PG8_WAIT_V(n) asm volatile("s_waitcnt vmcnt(" #n ")" ::: "memory")
#define PG8_WAIT_L(n) asm volatile("s_waitcnt lgkmcnt(" #n ")" ::: "memory")
#define PG8_BAR __builtin_amdgcn_s_barrier()
#define PG8_SCHED __builtin_amdgcn_sched_barrier(0)
    Unit cur, nxt; int ui = 0;
    if (!S.next(0, cur)) return;
    f32x4 acc[2][2][4][2];
#pragma unroll
    for (int a = 0; a < 2; ++a)
#pragma unroll
        for (int b = 0; b < 2; ++b)
#pragma unroll
            for (int m = 0; m < 4; ++m)
#pragma unroll
                for (int n = 0; n < 2; ++n) acc[a][b][m][n] = (f32x4){0.f, 0.f, 0.f, 0.f};
    bf16x8 At[4][2], B0[2][2], B1[2][2];
    const char* cA = (const char*)g.A + (size_t)cur.pm * tstepA; const char* cB = (const char*)g.Bt + (size_t)cur.pn * tstepB;
    S.a_ready(cur);
    if constexpr (SP2) {
        PG8_STAGE(PG8_SB(0, 0), cB, voffB); PG8_STAGE(PG8_SB(0, 1), cB + hstepB, voffB); PG8_STAGE(PG8_SA(0, 0), cA, voffA); PG8_STAGE(PG8_SA(0, 1), cA + hstepA, voffA);
        if (wr == 1) PG8_BAR;
        PG8_WAIT_V(2); PG8_BAR;
        PG8_STAGE(PG8_SB(1, 0), cB + kstep, voffB); PG8_STAGE(PG8_SA(1, 0), cA + kstep, voffA); PG8_STAGE(PG8_SB(1, 1), cB + hstepB + kstep, voffB);
        PG8_WAIT_V(6); PG8_BAR;
    } else {
        PG8_STAGE(PG8_SB(0, 0), cB, voffB); PG8_STAGE(PG8_SA(0, 0), cA, voffA); PG8_STAGE(PG8_SB(0, 1), cB + hstepB, voffB); PG8_STAGE(PG8_SA(0, 1), cA + hstepA, voffA);
        if (wr == 1) PG8_BAR;
        PG8_WAIT_V(4); PG8_BAR;
        PG8_STAGE(PG8_SB(1, 0), cB + kstep, voffB); PG8_STAGE(PG8_SA(1, 0), cA + kstep, voffA); PG8_STAGE(PG8_SB(1, 1), cB + hstepB + kstep, voffB);
        PG8_WAIT_V(6); PG8_BAR;
    }
    for (;;) {
        const bool has_next = S.next(ui + 1, nxt);
        const char* nA = has_next ? (const char*)g.A + (size_t)nxt.pm * tstepA : cA; const char* nB = has_next ? (const char*)g.Bt + (size_t)nxt.pn * tstepB : cB;
        for (int t = 0; t < nt; t += 2) {
            const bool last = (t == nt - 2);
            const char* a1 = cA + (size_t)(t + 1) * kstep;
            const char* a2 = last ? nA : cA + (size_t)(t + 2) * kstep; const char* b2 = last ? nB : cB + (size_t)(t + 2) * kstep;
            const char* a3 = a2 + kstep; const char* b3 = b2 + kstep;
            if (last && has_next) S.a_ready(nxt);
            if constexpr (SP2) {
            PG8_LDB(B0, 0, 0); PG8_LDB(B1, 0, 1); PG8_SCHED; PG8_LDA(At, 0, 0); PG8_STAGE(PG8_SA(1, 1), a1 + hstepA, voffA);
            PG8_WAIT_V(8); PG8_WAIT_L(0); PG8_BAR; PG8_MMA(0, 0, At, B0); PG8_MMA(0, 1, At, B1); PG8_BAR; PG8_SCHED;
            PG8_LDA(At, 0, 1); PG8_STAGE(PG8_SB(0, 0), b2, voffB); PG8_STAGE(PG8_SB(0, 1), b2 + hstepB, voffB); PG8_STAGE(PG8_SA(0, 0), a2, voffA);
            PG8_WAIT_V(8); PG8_WAIT_L(0); PG8_BAR; PG8_MMA(1, 0, At, B0); PG8_MMA(1, 1, At, B1); PG8_BAR; PG8_SCHED;
            PG8_LDB(B0, 1, 0); PG8_LDB(B1, 1, 1); PG8_SCHED; PG8_LDA(At, 1, 0); PG8_STAGE(PG8_SA(0, 1), a2 + hstepA, voffA);
            PG8_WAIT_V(8); PG8_WAIT_L(0); PG8_BAR; PG8_MMA(0, 0, At, B0); PG8_MMA(0, 1, At, B1); PG8_BAR; PG8_SCHED;
            PG8_LDA(At, 1, 1); PG8_STAGE(PG8_SB(1, 0), b3, voffB); PG8_STAGE(PG8_SB(1, 1), b3 + hstepB, voffB); PG8_STAGE(PG8_SA(1, 0), a3, voffA);
            PG8_WAIT_V(8); PG8_WAIT_L(0); PG8_BAR; PG8_MMA(1, 0, At, B0); PG8_MMA(1, 1, At, B1); PG8_BAR; PG8_SCHED;
            } else {
            PG8_LDB(B0, 0, 0); PG8_SCHED; PG8_LDA(At, 0, 0); PG8_STAGE(PG8_SA(1, 1), a1 + hstepA, voffA);
            PG8_WAIT_L(8); PG8_BAR; PG8_WAIT_L(0); PG8_MMA(0, 0, At, B0); PG8_BAR; PG8_SCHED;
            PG8_LDB(B1, 0, 1); PG8_STAGE(PG8_SB(0, 0), b2, voffB);
            PG8_BAR; PG8_WAIT_L(0); PG8_MMA(0, 1, At, B1); PG8_BAR;
            PG8_LDA(At, 0, 1); PG8_STAGE(PG8_SA(0, 0), a2, voffA);
            PG8_BAR; PG8_WAIT_L(0); PG8_MMA(1, 0, At, B0); PG8_BAR; PG8_SCHED;
            PG8_STAGE(PG8_SB(0, 1), b2 + hstepB, voffB);
            PG8_WAIT_V(6); PG8_BAR; PG8_MMA(1, 1, At, B1); PG8_BAR;
            PG8_LDB(B0, 1, 0); PG8_SCHED; PG8_LDA(At, 1, 0); PG8_STAGE(PG8_SA(0, 1), a2 + hstepA, voffA);
            PG8_WAIT_L(8); PG8_BAR; PG8_WAIT_L(0); PG8_MMA(0, 0, At, B0); PG8_BAR; PG8_SCHED;
            PG8_LDB(B1, 1, 1); PG8_STAGE(PG8_SB(1, 0), b3, voffB);
            PG8_BAR; PG8_WAIT_L(0); PG8_MMA(0, 1, At, B1); PG8_BAR;
            PG8_LDA(At, 1, 1); PG8_STAGE(PG8_SA(1, 0), a3, voffA);
            PG8_BAR; PG8_WAIT_L(0); PG8_MMA(1, 0, At, B0); PG8_BAR; PG8_SCHED;
            PG8_STAGE(PG8_SB(1, 1), b3 + hstepB, voffB);
            PG8_WAIT_V(6); PG8_BAR; PG8_MMA(1, 1, At, B1); PG8_BAR;
            }
        }
        if constexpr (ALIGN_EPI) { if (wr == 0) PG8_BAR; }
        if constexpr (!Epi::AFTER_DRAIN) { E(acc, cur, wr, wc, fr, fq); S.done(cur); }
        if (!has_next) break;
#pragma unroll
        for (int a = 0; a < 2; ++a)
#pragma unroll
            for (int b = 0; b < 2; ++b)
#pragma unroll
                for (int m = 0; m < 4; ++m)
#pragma unroll
                    for (int n = 0; n < 2; ++n) acc[a][b][m][n] = (f32x4){0.f, 0.f, 0.f, 0.f};
        cur = nxt; cA = nA; cB = nB; ++ui;
        if constexpr (ALIGN_EPI) { if (wr == 1) PG8_BAR; }
    }
    PG8_WAIT_V(0);
    if constexpr (!ALIGN_EPI) { if (wr == 0) PG8_BAR; }
    PG8_BAR;
    if constexpr (Epi::AFTER_DRAIN) { E.fused(acc, cur, wr, wc, fr, fq, lds, wid, lane); S.done(cur); }
#undef PG8_SA
#undef PG8_SB
#undef PG8_STAGE
#undef PG8_LDA
#undef PG8_LDB
#undef PG8_MMA
#undef PG8_WAIT_V
#undef PG8_WAIT_L
#undef PG8_BAR
#undef PG8_SCHED
}
}

#ifndef PG8_SP2
#define PG8_SP2 true
#endif
#ifndef PG8_ALIGN
#define PG8_ALIGN true
#endif
#include <hip/hip_bf16.h>
#include <cmath>
namespace attn_body {
using bf16=__hip_bfloat16;
using bf16x8=__attribute__((ext_vector_type(8)))short;
using s16x4=__attribute__((ext_vector_type(4)))short;
using f32x16=__attribute__((ext_vector_type(16)))float;
using u32x4=__attribute__((ext_vector_type(4)))unsigned;
constexpr int BATCH=1,NHEAD=16,SEQ=16384,D=64,DM=NHEAD*D;
constexpr int NW=8,QBLK=32,QB=QBLK*NW,KVBLK=64,NQB=SEQ/QB;
constexpr int ATTN_PITCH=DM, ATTN_UNIT_ROWS=QB;
__device__ __forceinline__ int crow(int r,int hi){return (r&3)+8*(r>>2)+4*hi;}
#define SBAR() __builtin_amdgcn_sched_barrier(0)
__device__ __forceinline__ void cmask(f32x16&p0,f32x16&p1,int jb,int qrel,int hi){
  const float NEG=-INFINITY; int kb=64*jb+4*hi;
  #pragma unroll
  for(int r=0;r<16;++r){int kv=kb+(r&3)+8*(r>>2); if(kv>qrel)p0[r]=NEG; if(kv+32>qrel)p1[r]=NEG;}
}

constexpr int NSLOT=3, SLOTB=8192;
constexpr int LDS_K=0, LDS_V=NSLOT*SLOTB, LDS_WS=2*NSLOT*SLOTB, LDS_OST=LDS_WS+NW*64*4, LDS_FK=LDS_OST+NW*4096, LDS_BYTES=LDS_FK+NW*NSLOT*256;
constexpr float C2=0.125f*1.4426950408889634f;
__device__ __forceinline__ void glds16(const void*gsrc,unsigned lds_dst){unsigned keep;
  asm volatile("s_mov_b32 %0, m0\n\ts_mov_b32 m0, %2\n\ts_nop 0\n\tglobal_load_lds_dwordx4 %1, off\n\ts_mov_b32 m0, %0":"=&s"(keep):"v"(gsrc),"s"(lds_dst):"memory");}
__device__ __forceinline__ float max3f(float a,float b,float c){float r;asm("v_max3_f32 %0, %1, %2, %3":"=v"(r):"v"(a),"v"(b),"v"(c));return r;}
__device__ __forceinline__ float max2f(float a,float b){float r;asm("v_max_f32_e32 %0, %1, %2":"=v"(r):"v"(a),"v"(b));return r;}
__device__ __forceinline__ float fadd_s(float a,float b){float r;asm("v_add_f32_e32 %0, %1, %2":"=v"(r):"v"(a),"v"(b));return r;}
__device__ __forceinline__ float fsub_s(float a,float b){float r;asm("v_sub_f32_e32 %0, %1, %2":"=v"(r):"v"(a),"v"(b));return r;}
typedef float f32x2_t __attribute__((ext_vector_type(2))); typedef float f32x4_t __attribute__((ext_vector_type(4))); typedef __bf16 bf16x2_t __attribute__((ext_vector_type(2)));
__device__ __forceinline__ unsigned cvtpk_s(float lo,float hi){f32x2_t v={lo,hi};bf16x2_t b=__builtin_convertvector(v,bf16x2_t);return __builtin_bit_cast(unsigned,b);}
__device__ __forceinline__ void glds4(const void*gsrc,unsigned lds_dst){unsigned keep;
  asm volatile("s_mov_b32 %0, m0\n\ts_mov_b32 m0, %2\n\ts_nop 0\n\tglobal_load_lds_dword %1, off\n\ts_mov_b32 m0, %0":"=&s"(keep):"v"(gsrc),"s"(lds_dst):"memory");}
#define WAIT_BAR(N) asm volatile("s_waitcnt vmcnt(" #N ") lgkmcnt(0)\n\ts_barrier":::"memory")

__device__ __forceinline__ void qkt(f32x16&p0,f32x16&p1,const char*Kslot,const bf16x8*qr,int r32,int hi){
  const char*kb=Kslot+hi*1024+r32*16;
  #pragma unroll
  for(int d0=0;d0<4;++d0){
    const bf16x8 b0=*reinterpret_cast<const bf16x8*>(kb+d0*2048);
    const bf16x8 b1=*reinterpret_cast<const bf16x8*>(kb+d0*2048+512);
    p0=__builtin_amdgcn_mfma_f32_32x32x16_bf16(b0,qr[d0],p0,0,0,0);p1=__builtin_amdgcn_mfma_f32_32x32x16_bf16(b1,qr[d0],p1,0,0,0);}
}
typedef __attribute__((address_space(3))) const char* lds_cptr;
typedef short v4i16_t __attribute__((ext_vector_type(4)));
__device__ __forceinline__ void kload8(bf16x8*kf,lds_cptr kp){
  kf[0]=*(const __attribute__((address_space(3))) bf16x8*)(kp);      kf[1]=*(const __attribute__((address_space(3))) bf16x8*)(kp+512);
  kf[2]=*(const __attribute__((address_space(3))) bf16x8*)(kp+2048); kf[3]=*(const __attribute__((address_space(3))) bf16x8*)(kp+2560);
  kf[4]=*(const __attribute__((address_space(3))) bf16x8*)(kp+4096); kf[5]=*(const __attribute__((address_space(3))) bf16x8*)(kp+4608);
  kf[6]=*(const __attribute__((address_space(3))) bf16x8*)(kp+6144); kf[7]=*(const __attribute__((address_space(3))) bf16x8*)(kp+6656);
}
__device__ __forceinline__ void kload2(bf16x8*kf,lds_cptr kp,int j){ kf[2*j]=*(const __attribute__((address_space(3))) bf16x8*)(kp+j*2048); kf[2*j+1]=*(const __attribute__((address_space(3))) bf16x8*)(kp+j*2048+512); }
__device__ __forceinline__ s16x4 vtr(lds_cptr p){ return __builtin_bit_cast(s16x4,__builtin_amdgcn_ds_read_tr16_b64_v4i16((__attribute__((address_space(3))) v4i16_t*)p)); }
__device__ __forceinline__ float rowmax(const f32x16&p0,const f32x16&p1){
  float a=max3f(p0[0],p0[1],p1[0]),b=max3f(p0[2],p0[3],p1[1]);a=max3f(a,p1[2],p1[3]);
  #pragma unroll
  for(int r=4;r<16;r+=4){a=max3f(a,p0[r],p0[r+1]);b=max3f(b,p0[r+2],p0[r+3]);a=max3f(a,p1[r],p1[r+1]);b=max3f(b,p1[r+2],p1[r+3]);}
  const float m=max2f(a,b);
  auto rr=__builtin_amdgcn_permlane32_swap(__float_as_uint(m),__float_as_uint(m),false,false);
  return max2f(__uint_as_float(rr[0]),__uint_as_float(rr[1]));
}
__device__ __forceinline__ void pv(f32x16*o,int vb,bf16x8 pa0,bf16x8 pa1,bf16x8 pa2,bf16x8 pa3){
  #pragma unroll
  for(int d0=0;d0<2;++d0){s16x4 lo[4],hi[4];
    #pragma unroll
    for(int ks=0;ks<4;++ks){
      asm volatile("ds_read_b64_tr_b16 %0,%1 offset:%c2":"=&v"(lo[ks]):"v"(vb),"i"(d0*4096+ks*1024):"memory");
      asm volatile("ds_read_b64_tr_b16 %0,%1 offset:%c2":"=&v"(hi[ks]):"v"(vb),"i"(d0*4096+ks*1024+512):"memory");}
    asm volatile("s_waitcnt lgkmcnt(0)":::"memory");SBAR();
    #define PK(k) (bf16x8){lo[k][0],lo[k][1],lo[k][2],lo[k][3],hi[k][0],hi[k][1],hi[k][2],hi[k][3]}
    o[d0]=__builtin_amdgcn_mfma_f32_32x32x16_bf16(pa0,PK(0),o[d0],0,0,0);
    o[d0]=__builtin_amdgcn_mfma_f32_32x32x16_bf16(pa1,PK(1),o[d0],0,0,0);
    o[d0]=__builtin_amdgcn_mfma_f32_32x32x16_bf16(pa2,PK(2),o[d0],0,0,0);
    o[d0]=__builtin_amdgcn_mfma_f32_32x32x16_bf16(pa3,PK(3),o[d0],0,0,0);
    #undef PK
  }
}

#ifndef ATTN_STORE16
#define ATTN_STORE16(p,v) (*(u32x4*)(p)=(v))
#endif
template<int THRL> __device__ __forceinline__ void attn_unit(int b,int h,int qb,const bf16*Q,const bf16*__restrict__ K,const bf16*__restrict__ V,bf16*O,const float*__restrict__ F2h,char*shm,int wid_in,int t_start){
  const int wid=wid_in,lane=pg8::lane_now(),tid=wid*64+lane,r32=lane&31,hi=lane>>5; (void)tid;
  const long rowbase=(long)b*SEQ; const int q0=qb*QB;
  const bf16*Qw=Q+(rowbase+q0+wid*QBLK)*DM+h*D;
  const bf16*Kh=K+(rowbase+(long)t_start*KVBLK)*DM+h*D,*Vh=V+(rowbase+(long)t_start*KVBLK)*DM+h*D; const float*F2k=F2h+(long)t_start*KVBLK;
  const unsigned lds0=(unsigned)(uintptr_t)shm;
  float*wsf=(float*)(shm+LDS_WS)+wid*64;
  const bf16*ksrc=Kh+(long)lane*DM+wid*8;
  const bf16*vsrc=Vh+(long)(16*(wid&3)+(lane>>2))*DM+(wid>>2)*32+(lane&3)*8;
  const unsigned kdst=lds0+LDS_K+wid*1024, vdst=lds0+LDS_V+wid*1024;
  #define DMA_K(t,slot) glds16(ksrc+(long)(t)*KVBLK*DM,(unsigned)__builtin_amdgcn_readfirstlane(kdst+(slot)))
  #define DMA_V(t,slot) glds16(vsrc+(long)(t)*KVBLK*DM,(unsigned)__builtin_amdgcn_readfirstlane(vdst+(slot)))
  const unsigned fdst=lds0+LDS_FK+wid*(NSLOT*256); const float*fsrc=F2k+lane;
  #define DMA_F(t,slot) glds4(fsrc+(long)(t)*KVBLK,(unsigned)__builtin_amdgcn_readfirstlane(fdst+((slot)>>5)))
  const int vb0=(int)(lds0+LDS_V)+((lane>>4)&1)*32+(lane&3)*8+(4*hi+((lane&15)>>2))*64;
  const char*Kbase=shm+LDS_K; bf16x8 kf[8];
  const lds_cptr shm3=(lds_cptr)shm; const lds_cptr kp0=shm3+LDS_K+hi*1024+r32*16; const lds_cptr vp0=shm3+LDS_V+((lane>>4)&1)*32+(lane&3)*8+(4*hi+((lane&15)>>2))*64;
  const int NT=(q0+QB)/KVBLK-t_start;
  DMA_K(0,0);DMA_F(0,0);DMA_V(0,0);DMA_K(1,SLOTB);DMA_F(1,SLOTB);
  bf16x8 qr[4];
  #pragma unroll
  for(int d0=0;d0<4;++d0)qr[d0]=*reinterpret_cast<const bf16x8*>(&Qw[(long)r32*DM+d0*16+hi*8]);
  float mhat=0.f,l_reg=0.f;f32x16 o[2];o[0]=f32x16{};o[1]=f32x16{};
  const int qrel=wid*QBLK+r32;
  const float Gq=F2h[q0+qrel];
  float negs=Gq;
  const __attribute__((address_space(3))) char* fk3=(const __attribute__((address_space(3))) char*)shm+LDS_FK+wid*(NSLOT*256)+hi*16;
  #define CINIT(C0_,C1_,slot_) do{ const __attribute__((address_space(3))) f32x4_t*fp_=(const __attribute__((address_space(3))) f32x4_t*)(fk3+((slot_)>>5)); \
    _Pragma("unroll") for(int j_=0;j_<4;++j_){ const f32x4_t a_=fp_[2*j_], b_=fp_[8+2*j_]; \
      C0_[4*j_]=negs-a_[0];C0_[4*j_+1]=negs-a_[1];C0_[4*j_+2]=negs-a_[2];C0_[4*j_+3]=negs-a_[3]; \
      C1_[4*j_]=negs-b_[0];C1_[4*j_+1]=negs-b_[1];C1_[4*j_+2]=negs-b_[2];C1_[4*j_+3]=negs-b_[3]; } }while(0)
  #define CMASK(P0,P1,t) do{int jb_=(t)-(NT-4); if(jb_>=0)cmask(P0,P1,jb_,qrel,hi);}while(0)
  bool resc=false;
  float sdiag=0.f;
  { const bf16*Kd=K+(rowbase+q0+qrel)*DM+h*D+hi*8;
    #pragma unroll
    for(int d0=0;d0<4;++d0){ const bf16x8 kd=*reinterpret_cast<const bf16x8*>(Kd+d0*16);
      #pragma unroll
      for(int j=0;j<8;++j)sdiag+=__uint_as_float(((unsigned)(unsigned short)qr[d0][j])<<16)*__uint_as_float(((unsigned)(unsigned short)kd[j])<<16); }
    auto rr_=__builtin_amdgcn_permlane32_swap(__float_as_uint(sdiag),__float_as_uint(sdiag),false,false); sdiag=__uint_as_float(rr_[0])+__uint_as_float(rr_[1]); }
  #define START(P0,P1) do{ const float rm=sdiag; resc=false; \
    { const float dl=rm; mhat=fadd_s(mhat,dl); \
      _Pragma("unroll") for(int r=0;r<16;++r){P0[r]=fsub_s(P0[r],dl);P1[r]=fsub_s(P1[r],dl);} \
      negs=Gq-mhat; } \
    _Pragma("unroll") for(int r=0;r<16;++r)P0[r]=__builtin_amdgcn_exp2f(P0[r]); }while(0)
  #define RESC() do{ if(resc){ asm volatile("s_waitcnt lgkmcnt(0)":::"memory"); \
      _Pragma("unroll") for(int d_=0;d_<2;++d_) _Pragma("unroll") for(int r=0;r<16;++r)o[d_][r]*=wsf[crow(r,hi)]; } }while(0)
  f32x16 pA0,pA1,pB0,pB1;
  int sl_prev=0,sl_cur=0,sl_next=SLOTB;
  #define ROT() do{sl_prev=sl_cur;sl_cur=sl_next;sl_next=(sl_next==(NSLOT-1)*SLOTB)?0:sl_next+SLOTB;}while(0)
  DMA_K(2,2*SLOTB);DMA_F(2,2*SLOTB);
  WAIT_BAR(3);
  CINIT(pA0,pA1,0); qkt(pA0,pA1,Kbase,qr,r32,hi);asm volatile("s_nop 15\n\ts_nop 7":"+v"(pA0),"+v"(pA1));CMASK(pA0,pA1,0);
  START(pA0,pA1);
  _Pragma("unroll") for(int r=0;r<16;++r)pA1[r]=__builtin_amdgcn_exp2f(pA1[r]);
  WAIT_BAR(0);
  DMA_K(3,0);DMA_F(3,0);DMA_V(1,SLOTB);
  ROT();
  kload8(kf,kp0+sl_cur);
  WAIT_BAR(3);
  s16x4 vlo[8],vhi[8]; u32x4 pw0,pw1,pw2,pw3;
  #define PKW(P,B) cvtpk_s(P[B],P[B+1])
  #define PAF(k) __builtin_bit_cast(bf16x8,pw##k)
  #define VFR(i) (bf16x8){vlo[i][0],vlo[i][1],vlo[i][2],vlo[i][3],vhi[i][0],vhi[i][1],vhi[i][2],vhi[i][3]}
  #define PIN(x) asm volatile("":"+v"(x))
  #define MX3(a,b,c) __builtin_fmaxf(__builtin_fmaxf((a),(b)),(c))
  #define GAPA(MF,A0,A1,A2,A3,W0,W1,PW) do{ MF; sacc+=A0; sacc+=A1; sacc+=A2; sacc+=A3; PIN(sacc); W0; W1; PIN(PW); SBAR(); }while(0)
  #define EX(v) __builtin_amdgcn_exp2f(v)
  #define GAPB(MF,X,B) do{ MF; X[B]=EX(X[B]); X[B+1]=EX(X[B+1]); X[B+2]=EX(X[B+2]); X[B+3]=EX(X[B+3]); PIN(X); SBAR(); }while(0)
  #define VRD(i) do{ vlo[i]=vtr(vp_+(((i)>>2)*4096+((i)&3)*1024)); vhi[i]=vtr(vp_+(((i)>>2)*4096+((i)&3)*1024+512)); }while(0)
  #define KRD(G,j) do{ if(G){ kload2(kf,kp0+sl_next,j); SBAR(); } }while(0)
  #define STEP(C0,C1,P0,P1,t,GK,GV,GL) do{ SBAR(); \
    CINIT(C0,C1,sl_cur); \
    const lds_cptr vp_=vp0+sl_prev; \
    VRD(0); SBAR(); float sacc=(P0[0]+P0[1]); \
    GAPA(C0=__builtin_amdgcn_mfma_f32_32x32x16_bf16(kf[0],qr[0],C0,0,0,0), P0[2],P0[3],P0[4],P0[5],     pw0[0]=PKW(P0,0), pw0[1]=PKW(P0,2), pw0); \
    VRD(4); SBAR(); GAPA(C1=__builtin_amdgcn_mfma_f32_32x32x16_bf16(kf[1],qr[0],C1,0,0,0), P0[6],P0[7],P0[8],P0[9],     pw0[2]=PKW(P0,4), pw0[3]=PKW(P0,6), pw0); \
    VRD(1); SBAR(); GAPA(C0=__builtin_amdgcn_mfma_f32_32x32x16_bf16(kf[2],qr[1],C0,0,0,0),   P0[10],P0[11],P0[12],P0[13], pw1[0]=PKW(P0,8), pw1[1]=PKW(P0,10), pw1); \
    VRD(5); SBAR(); GAPA(C1=__builtin_amdgcn_mfma_f32_32x32x16_bf16(kf[3],qr[1],C1,0,0,0),   P0[14],P0[15],P1[0],P1[1],   pw1[2]=PKW(P0,12),pw1[3]=PKW(P0,14), pw1); \
    VRD(2); SBAR(); GAPA(C0=__builtin_amdgcn_mfma_f32_32x32x16_bf16(kf[4],qr[2],C0,0,0,0),   P1[2],P1[3],P1[4],P1[5],     pw2[0]=PKW(P1,0), pw2[1]=PKW(P1,2), pw2); \
    VRD(6); SBAR(); GAPA(C1=__builtin_amdgcn_mfma_f32_32x32x16_bf16(kf[5],qr[2],C1,0,0,0),   P1[6],P1[7],P1[8],P1[9],     pw2[2]=PKW(P1,4), pw2[3]=PKW(P1,6), pw2); \
    VRD(3); SBAR(); GAPA(C0=__builtin_amdgcn_mfma_f32_32x32x16_bf16(kf[6],qr[3],C0,0,0,0),   P1[10],P1[11],P1[12],P1[13], pw3[0]=PKW(P1,8), pw3[1]=PKW(P1,10), pw3); \
    VRD(7); SBAR(); GAPA(C1=__builtin_amdgcn_mfma_f32_32x32x16_bf16(kf[7],qr[3],C1,0,0,0),   P1[14],P1[15],0.f,0.f,       pw3[2]=PKW(P1,12),pw3[3]=PKW(P1,14), pw3); \
    l_reg+=sacc; \
    if(GK){DMA_K((t)+3,sl_cur);DMA_F((t)+3,sl_cur);} if(GV){DMA_V((t)+1,sl_next);} \
    CMASK(C0,C1,t); \
    { float a=MX3(C0[0],C0[1],C1[0]),b=MX3(C0[2],C0[3],C1[1]); a=MX3(a,C1[2],C1[3]); \
      _Pragma("unroll") for(int r=4;r<16;r+=4){a=MX3(a,C0[r],C0[r+1]);b=MX3(b,C0[r+2],C0[r+3]);a=MX3(a,C1[r],C1[r+1]);b=MX3(b,C1[r+2],C1[r+3]);} \
      float rm=__builtin_fmaxf(a,b); { auto rr=__builtin_amdgcn_permlane32_swap(__float_as_uint(rm),__float_as_uint(rm),false,false); rm=__builtin_fmaxf(__uint_as_float(rr[0]),__uint_as_float(rr[1])); } \
      resc=false; \
      if(__builtin_expect(__any(rm>(float)THRL),0)){ const float dl=__builtin_fmaxf(rm,0.f); mhat+=dl; \
        _Pragma("unroll") for(int r=0;r<16;++r){C0[r]-=dl;C1[r]-=dl;} \
        negs=Gq-mhat; \
        const float f=__builtin_amdgcn_exp2f(-dl); l_reg*=f; if(hi==0)wsf[r32]=f; resc=true; } } \
    SBAR(); \
    GAPB(o[0]=__builtin_amdgcn_mfma_f32_32x32x16_bf16(PAF(0),VFR(0),o[0],0,0,0), C0,0); \
    GAPB(o[1]=__builtin_amdgcn_mfma_f32_32x32x16_bf16(PAF(0),VFR(4),o[1],0,0,0), C0,4); \
    KRD(GL,0); GAPB(o[0]=__builtin_amdgcn_mfma_f32_32x32x16_bf16(PAF(1),VFR(1),o[0],0,0,0), C0,8); \
    KRD(GL,1); GAPB(o[1]=__builtin_amdgcn_mfma_f32_32x32x16_bf16(PAF(1),VFR(5),o[1],0,0,0), C0,12); \
    KRD(GL,2); GAPB(o[0]=__builtin_amdgcn_mfma_f32_32x32x16_bf16(PAF(2),VFR(2),o[0],0,0,0), C1,0); \
    KRD(GL,3); GAPB(o[1]=__builtin_amdgcn_mfma_f32_32x32x16_bf16(PAF(2),VFR(6),o[1],0,0,0), C1,4); \
    GAPB(o[0]=__builtin_amdgcn_mfma_f32_32x32x16_bf16(PAF(3),VFR(3),o[0],0,0,0), C1,8); \
    GAPB(o[1]=__builtin_amdgcn_mfma_f32_32x32x16_bf16(PAF(3),VFR(7),o[1],0,0,0), C1,12); \
    }while(0)
  int t=1;
  #undef CMASK
  #define CMASK(P0,P1,t) do{}while(0)
  for(;t+5<NT;t+=2){
    STEP(pB0,pB1,pA0,pA1,t,true,true,true);     WAIT_BAR(3); RESC(); ROT();
    STEP(pA0,pA1,pB0,pB1,t+1,true,true,true);   WAIT_BAR(3); RESC(); ROT();
  }
  #undef CMASK
  #define CMASK(P0,P1,t) do{int jb_=(t)-(NT-4); if(jb_>=0)cmask(P0,P1,jb_,qrel,hi);}while(0)
  #define ENDW(tt) do{ if((tt)+3<NT){WAIT_BAR(3);} else if((tt)+2<NT){WAIT_BAR(1);} else {WAIT_BAR(0);} }while(0)
  for(;t+1<NT;t+=2){
    STEP(pB0,pB1,pA0,pA1,t,(t+3<NT),(t+1<NT),(t+1<NT));       ENDW(t);   RESC(); ROT();
    STEP(pA0,pA1,pB0,pB1,t+1,(t+4<NT),(t+2<NT),(t+2<NT));     ENDW(t+1); RESC(); ROT();
  }
  STEP(pB0,pB1,pA0,pA1,NT-1,false,false,false); RESC();
  { float sacc=pB0[0]+pB0[1]; _Pragma("unroll") for(int r=2;r<16;++r)sacc+=pB0[r]; _Pragma("unroll") for(int r=0;r<16;++r)sacc+=pB1[r]; l_reg+=sacc;
    pw0=(u32x4){PKW(pB0,0),PKW(pB0,2),PKW(pB0,4),PKW(pB0,6)};pw1=(u32x4){PKW(pB0,8),PKW(pB0,10),PKW(pB0,12),PKW(pB0,14)};pw2=(u32x4){PKW(pB1,0),PKW(pB1,2),PKW(pB1,4),PKW(pB1,6)};pw3=(u32x4){PKW(pB1,8),PKW(pB1,10),PKW(pB1,12),PKW(pB1,14)};
    SBAR(); pv(o,vb0+sl_cur,PAF(0),PAF(1),PAF(2),PAF(3)); }
  #undef PKW
  #undef PAF
  #undef VFR
  #undef PIN
  #undef MX3
  #undef GAPA
  #undef GAPB
  #undef EX
  #undef VRD
  #undef KRD
  #undef STEP
  #undef ENDW
  {auto rr=__builtin_amdgcn_permlane32_swap(__float_as_uint(l_reg),__float_as_uint(l_reg),false,false);l_reg=__uint_as_float(rr[0])+__uint_as_float(rr[1]);}
  if(hi==0)wsf[32+r32]=l_reg;asm volatile("s_waitcnt lgkmcnt(0)":::"memory");
  float rli[16];
  #pragma unroll
  for(int r=0;r<16;++r)rli[r]=__builtin_amdgcn_rcpf(wsf[32+crow(r,hi)]);
  bf16*Ow=O+(rowbase+q0+wid*QBLK)*DM+h*D;
  { bf16*stg=(bf16*)(shm+LDS_OST)+wid*2048;
    #pragma unroll
    for(int r=0;r<16;++r){const int orow=crow(r,hi);
      #pragma unroll
      for(int d0=0;d0<2;++d0)stg[orow*64+d0*32+r32]=__float2bfloat16(o[d0][r]*rli[r]);}
    asm volatile("s_waitcnt lgkmcnt(0)":::"memory");
    #pragma unroll
    for(int i=0;i<4;++i){const int row=i*8+(lane>>3),ch=lane&7; const u32x4 v=*(const u32x4*)(stg+row*64+ch*8); ATTN_STORE16(Ow+(long)row*DM+ch*8,v);} }
  asm volatile("s_waitcnt lgkmcnt(0)\n\ts_barrier":::"memory");
  #undef DMA_K
  #undef DMA_V
  #undef DMA_F
  #undef CMASK
  #undef CINIT
  #undef START
  #undef RESC
  #undef ROT
}
constexpr int ATTN_LDS_BYTES=LDS_BYTES;
struct AttnTensors { const bf16* Q; const bf16* K; const bf16* V; bf16* O; const float* F2; };
struct AttnUnit { int bh; int qb; };
struct StaticOrder {
  int vcu;
  __device__ __forceinline__ explicit StaticOrder(int grid,int block):vcu((block%8)*(grid/8)+block/8){}
  __device__ __forceinline__ bool next(int i,AttnUnit&u)const{ if(i>=4)return false; const int s=vcu&15; u.bh=vcu>>4; u.qb=(i==0)?63-s:(i==1)?32+s:(i==2)?31-s:s; return true; }
  __device__ __forceinline__ void a_ready(const AttnUnit&)const{}
  __device__ __forceinline__ void done(const AttnUnit&)const{}
};
template<class Sched,int THRL=8> __device__ __forceinline__ void attn_phase(char*lds,const AttnTensors&T,const Sched&S,int wid_in){
  AttnUnit u;
  for(int i=0;S.next(i,u);++i){ S.a_ready(u); attn_unit<THRL>(0,u.bh,u.qb,T.Q,T.K,T.V,T.O,T.F2+(size_t)u.bh*SEQ,lds,wid_in,0); S.done(u); }
}
constexpr float PRUNE_LOG2=30.f;
struct AttnQueue { const float* kqmax; unsigned* ticket; };
template<int THRL=8> __device__ __forceinline__ void attn_phase_queue(char*lds,const AttnTensors&T,const AttnQueue&Q,int wid_in){
  const int lane=pg8::lane_now(),tid=wid_in*64+lane;
  typedef __attribute__((address_space(3))) unsigned short lu16; typedef __attribute__((address_space(3))) unsigned lu32;
  lu16*tst=(lu16*)lds;
  lu16*ord=tst+1024;
  lu32*tk=(lu32*)(ord+1024);
  { typedef __attribute__((address_space(3))) float lf32; lf32*fe=(lf32*)(lds+16384);
    for(int i=tid;i<NHEAD*(SEQ/KVBLK);i+=NW*64) fe[i]=T.F2[(size_t)(i>>8)*SEQ+64*(i&255)+63];
    asm volatile("s_waitcnt vmcnt(0) lgkmcnt(0)\n\ts_barrier":::"memory");
    for(int u=tid;u<NHEAD*NQB;u+=NW*64){ const int h=u>>6,qb=u&63;
      const float U=sqrtf(Q.kqmax[h]*Q.kqmax[16+h]); const int dk_=((const int*)Q.kqmax)[64+h*64+qb]; const float dmin=__int_as_float(dk_^((dk_>>31)&0x7fffffff));
      const float lim=T.F2[(size_t)h*SEQ+qb*QB]+U-dmin+PRUNE_LOG2;
      int lo=0,hi=4*qb;
      while(lo<hi){ const int mid=(lo+hi)>>1; if(fe[h*256+mid]>lim)lo=mid+1; else hi=mid; }
      tst[u]=(unsigned short)(lo&~1); } }
  asm volatile("s_waitcnt lgkmcnt(0)\n\ts_barrier":::"memory");
  { lu32*key=(lu32*)(lds+8192);
    for(int u=tid;u<NHEAD*NQB;u+=NW*64) key[u]=((unsigned)(4*(u&63)+4-(int)tst[u])<<10)|(unsigned)(1023-u);
    asm volatile("s_waitcnt lgkmcnt(0)\n\ts_barrier":::"memory");
    for(int k=2;k<=NHEAD*NQB;k<<=1) for(int j=k>>1;j>0;j>>=1){
      const int i=((tid&~(j-1))<<1)|(tid&(j-1)),l=i|j; const unsigned a_=key[i],b_=key[l]; const bool desc=((i&k)==0);
      if((a_<b_)==desc){ key[i]=b_; key[l]=a_; }
      asm volatile("s_waitcnt lgkmcnt(0)\n\ts_barrier":::"memory"); }
    for(int r=tid;r<NHEAD*NQB;r+=NW*64) ord[r]=(unsigned short)(1023u-(key[r]&1023u)); }
  asm volatile("s_waitcnt lgkmcnt(0)\n\ts_barrier":::"memory");
  char*shm=lds+8192;
  for(;;){
    if(tid==0)tk[0]=__hip_atomic_fetch_add(Q.ticket,1u,__ATOMIC_RELAXED,__HIP_MEMORY_SCOPE_AGENT);
    asm volatile("s_waitcnt vmcnt(0) lgkmcnt(0)\n\ts_barrier":::"memory");
    const unsigned t=tk[0];
    asm volatile("s_waitcnt lgkmcnt(0)\n\ts_barrier":::"memory");
    if(t>=(unsigned)(NHEAD*NQB))break;
    const int u=ord[t],h=u>>6,qb=u&63,ts=tst[u];
    attn_unit<THRL>(0,h,qb,T.Q,T.K,T.V,T.O,T.F2+(size_t)h*SEQ,shm,wid_in,ts);
  }
}
#undef SBAR
#undef WAIT_BAR
}
#define GAS __attribute__((address_space(1)))
#define LAS __attribute__((address_space(3)))
typedef unsigned short bf16;
typedef unsigned v4u __attribute__((ext_vector_type(4)));
typedef float f32x4 __attribute__((ext_vector_type(4)));
typedef short bf16x8 __attribute__((ext_vector_type(8)));
typedef GAS unsigned gu32;
typedef GAS unsigned long long gu64;
#define RLX_AGENT __ATOMIC_RELAXED, __HIP_MEMORY_SCOPE_AGENT
#define LDS_WAIT() asm volatile("s_waitcnt lgkmcnt(0)" ::: "memory")
#define VM_WAIT() asm volatile("s_waitcnt vmcnt(0)" ::: "memory")
__device__ __forceinline__ unsigned long long rt() { return __builtin_amdgcn_s_memrealtime(); }
__device__ __forceinline__ unsigned f2bf(float f) { unsigned u = __builtin_bit_cast(unsigned, f); return (u + 0x7fffu + ((u >> 16) & 1u)) >> 16; }
__device__ __forceinline__ unsigned pk2(float lo, float hi) { return f2bf(lo) | (f2bf(hi) << 16); }

#define XB_TMO      128
#define XB_XCNT(j)  (256  + 64 * (j))
#define XB_XSUB(j)  (1280 + 64 * (j))
#define XB_XGEN(j)  (2304 + 64 * (j))
#define XB_TOP      3328
#define XB_TOPGEN   3392
#define XCD_BAR_WORDS 3456
#define XB_SPIN_CAP (1u << 18)

__device__ __forceinline__ unsigned xb_ld(unsigned* p)              { return __hip_atomic_load(p, __ATOMIC_RELAXED, __HIP_MEMORY_SCOPE_AGENT); }
__device__ __forceinline__ unsigned xb_add(unsigned* p, unsigned v) { return __hip_atomic_fetch_add(p, v, __ATOMIC_RELAXED, __HIP_MEMORY_SCOPE_AGENT); }
__device__ __forceinline__ unsigned xb_xcc_id() { return (unsigned)__builtin_amdgcn_s_getreg((3 << 11) | 20) & 0xFu; }
#define XB_SPIN(cond, bar) do { unsigned _sp = 0; while (cond) { __builtin_amdgcn_s_sleep(1); \
    if ((++_sp & 255u) == 0u) { if (xb_ld(&(bar)[XB_TMO])) break; if (_sp > XB_SPIN_CAP) { atomicAdd(&(bar)[XB_TMO], 1u); break; } } } } while (0)

struct XcdBarrier {
    int wave;
    unsigned* bar; unsigned x;
    volatile LAS unsigned* st;
};

__device__ __forceinline__ XcdBarrier xcd_barrier_post(unsigned* bar, volatile LAS unsigned* st, int wave) {
    XcdBarrier b; b.wave = wave; b.bar = bar; b.x = xb_xcc_id(); b.st = st;
    if (wave == 0 && pg8::lane_now() == 0) (void)xb_add(&bar[XB_XCNT(b.x)], 1u);
    return b;
}
__device__ __forceinline__ void xcd_barrier_complete(unsigned* bar, unsigned x, unsigned& nloc, unsigned& nx) {
    const unsigned G = gridDim.x * gridDim.y * gridDim.z;
    unsigned sum, cnt, mine, sp = 0u;
    for (;;) {
        sum = 0u; cnt = 0u; mine = 0u;
#pragma unroll
        for (unsigned j = 0; j < 16; ++j) { const unsigned c = xb_ld(&bar[XB_XCNT(j)]); sum += c; cnt += (c > 0u) ? 1u : 0u; mine = (j == x) ? c : mine; }
        if (sum == G) break;
        __builtin_amdgcn_s_sleep(1);
        if ((++sp & 255u) == 0u) { if (xb_ld(&bar[XB_TMO])) break; if (sp > XB_SPIN_CAP) { atomicAdd(&bar[XB_TMO], 1u); break; } }
    }
    nloc = mine > 0u ? mine : 1u; nx = cnt > 0u ? cnt : 1u;
}

__device__ __forceinline__ void xcd_barrier(const XcdBarrier& b) {
    asm volatile("s_waitcnt vmcnt(0)" ::: "memory");
    __syncthreads();
    if (b.wave == 0 && pg8::lane_now() == 0) {
        unsigned* bar = b.bar;
        __builtin_amdgcn_s_waitcnt(0);
        unsigned nloc = b.st[0], nx = b.st[1];
        if (nloc == 0u) { xcd_barrier_complete(bar, b.x, nloc, nx); b.st[0] = nloc; b.st[1] = nx; }
        const unsigned old = xb_add(&bar[XB_XSUB(b.x)], 1u);
        const unsigned gen = old / nloc;
        if (old + 1u == (gen + 1u) * nloc) {
            __builtin_amdgcn_fence(__ATOMIC_RELEASE, "agent");
            asm volatile("s_waitcnt vmcnt(0)" ::: "memory");
            const unsigned og = xb_add(&bar[XB_TOP], 1u);
            const unsigned tg = og / nx;
            if (og + 1u == (tg + 1u) * nx) xb_add(&bar[XB_TOPGEN], 1u);
            else XB_SPIN(xb_ld(&bar[XB_TOPGEN]) == tg, bar);
            __builtin_amdgcn_fence(__ATOMIC_ACQUIRE, "agent");
            xb_add(&bar[XB_XGEN(b.x)], 1u);
            asm volatile("s_waitcnt vmcnt(0)" ::: "memory");
        } else {
            XB_SPIN(xb_ld(&bar[XB_XGEN(b.x)]) == gen, bar);
            __builtin_amdgcn_fence(__ATOMIC_ACQUIRE, "agent");
            asm volatile("s_waitcnt vmcnt(0)" ::: "memory");
        }
    }
    __syncthreads();
}
constexpr int NWAVES = 8;
constexpr int MP = pg8::MP, MS = pg8::MS, MT = pg8::MT, D = 1024, FF = 2816, NMODC = 9216;
constexpr int H_A = 16, HD = 64, DEC_B = 16, DEC_T = 16, PAST = 1024;
constexpr int D_INNER = 2048, SSD_H = 32, SSD_P = 64, SSD_N = 128, SSD_G = 4, CONV_DIM = 3072, D_IN = 10288;
constexpr int N_I1 = 25 * 256, N_I2 = 16 * 256;
constexpr float EPS = 1e-6f;
constexpr float LOG2E = 1.4426950408889634f;
constexpr int CQ = 0, CK = 1024, CV = 2048, CF = 3072, CZ = 3088, CX = 5136, CDT = 8208, CGA = 8240, CGS = 9264;
constexpr size_t O_Y = 0, O_KP = 17039360, O_VP = 33816576, O_LP = 50593792, O_SP = 50855936, O_CP = 51118080, O_KS = 51127296, O_VS = 51389440, O_LS = 51651584, O_SS = 51655680, O_CS = 55849984, O_END = 55997440;
constexpr size_t MiB = 1u << 20;
constexpr size_t WS_CTL = 0, CTL_ZERO_BYTES = 128 * 1024;
constexpr size_t WS_MOD = 1 * MiB, WS_F2 = 2 * MiB, WS_DT = 3 * MiB, WS_SSQ = 6 * MiB, WS_HALO = 9 * MiB;
constexpr size_t WS_W13A = 14 * MiB, WS_W2A = 25 * MiB, WS_WIN1 = 31 * MiB, WS_WIN2 = 44 * MiB, WS_WA = 52 * MiB, WS_WS = 54 * MiB, WS_WO = 58 * MiB, WS_W13B = 60 * MiB, WS_W2B = 71 * MiB;
constexpr size_t WS_HN = 77 * MiB, WS_QO = 110 * MiB, WS_KB = 143 * MiB, WS_VB = 176 * MiB, WS_XBC = 209 * MiB, WS_XCH = 307 * MiB, WS_XB = 309 * MiB, WS_END = 341 * MiB;
constexpr size_t WS_YB = WS_KB;
constexpr size_t WS_GATE = WS_XBC;
constexpr size_t WS_SSEG = WS_W13A, WS_DSEG = WS_W13A + 10 * MiB;
constexpr size_t WS_MA = WS_HN;
constexpr size_t WS_MERGED = WS_QO;
constexpr size_t WS_ACT2 = WS_XBC;
static_assert(WS_KB + (size_t)MT * 2048 * 2 <= WS_XBC && WS_XBC + (size_t)MT * 3072 * 2 <= WS_END && WS_HALO + 256 * 3 * 3072 * 2 <= WS_W13A && WS_W2B + (size_t)1024 * FF * 2 <= WS_HN, "ws map");
constexpr int CW_BAR = 4096, CW_KQ = 8192, CW_TICKET = 10240, CW_SEAM = 16384, SEAM_BANK = 64 * 64;
constexpr int RING_OFF = 0, RING_BYTES = 131072;
constexpr int LDSCTL_OFF = RING_BYTES, MISC_OFF = LDSCTL_OFF + 320;
constexpr int LDS_BYTES = 147456;

struct Frame {
    LAS unsigned char* lds; volatile LAS unsigned* MISC; gu32* ctl;
    int tid, lane, wave, vcu, G;
};
typedef const __attribute__((address_space(4))) unsigned long long* karg_p;
__device__ __forceinline__ karg_p kbase() { karg_p p = (karg_p)__builtin_amdgcn_kernarg_segment_ptr(); asm volatile("" : "+s"(p)); return p; }
__device__ __forceinline__ const float* kin(int i) { return (const float*)(const GAS float*)kbase()[i]; }
__device__ __forceinline__ float* kout() { return (float*)(GAS float*)kbase()[32]; }
__device__ __forceinline__ unsigned char* kws() { return (unsigned char*)(GAS unsigned char*)kbase()[33]; }
#define REFRESH(F) do { (F).lane = pg8::lane_now(); (F).tid = (F).wave * 64 + (F).lane; } while (0)
__device__ __forceinline__ float wave_sum(float v) {
#pragma unroll
    for (int o = 1; o < 64; o <<= 1) v += __shfl_xor(v, o);
    return v;
}
__device__ __forceinline__ float wave_max(float v) {
#pragma unroll
    for (int o = 1; o < 64; o <<= 1) v = fmaxf(v, __shfl_xor(v, o));
    return v;
}
__device__ __forceinline__ void p0_tr_item(const float* W, int ldw, int K, int srccol, bf16* WT, int drow, int nvalid, const float* kscale, LAS float* scr, int kb, int lane) {
    const int k0 = 64 * kb;
#pragma unroll
    for (int i = 0; i < 8; ++i) { const int kk = 8 * i + (lane >> 3), n4 = 4 * (lane & 7);
        f32x4 v = (n4 < nvalid) ? *(const GAS f32x4*)(W + (size_t)(k0 + kk) * ldw + srccol + n4) : (f32x4){0.f, 0.f, 0.f, 0.f};
        if (kscale) v = v * kscale[k0 + kk];
        LAS float* d = scr + kk * 33 + n4; d[0] = v.x; d[1] = v.y; d[2] = v.z; d[3] = v.w; }
    LDS_WAIT(); asm volatile("" ::: "memory");
    const int c = lane & 7;
#pragma unroll
    for (int j = 0; j < 4; ++j) { const int n = (lane >> 3) + 8 * j; const LAS float* s = scr + (8 * c) * 33 + n;
        v4u o; o.x = pk2(s[0 * 33], s[1 * 33]); o.y = pk2(s[2 * 33], s[3 * 33]); o.z = pk2(s[4 * 33], s[5 * 33]); o.w = pk2(s[6 * 33], s[7 * 33]);
        if (n < nvalid) *(GAS v4u*)(WT + (size_t)(drow + n) * K + k0 + 8 * c) = o; }
    LDS_WAIT(); asm volatile("" ::: "memory");
}
constexpr int IT_W13 = 2 * (D / 64) * (FF / 32), IT_W2 = (FF / 64) * (D / 32), IT_FFN = IT_W13 + IT_W2;
__device__ __forceinline__ void p0_ffn_item(const float* w1, const float* w3, const float* w2, bf16* W13, bf16* W2t, LAS float* scr, int r, int lane) {
    if (r < IT_W13) { const int which = r / (IT_W13 / 2), q = r % (IT_W13 / 2), kb = q / (FF / 32), nb = q % (FF / 32), j0 = 32 * nb;
        p0_tr_item(which ? w3 : w1, FF, D, j0, W13, 256 * (j0 / 128) + (j0 % 128) + 128 * which, 32, nullptr, scr, kb, lane); }
    else { r -= IT_W13; const int kb = r / (D / 32), nb = r % (D / 32); p0_tr_item(w2, D, FF, 32 * nb, W2t, 32 * nb, 32, nullptr, scr, kb, lane); }
}
template <bool LATE>
__device__ __forceinline__ void p0_prologue(Frame& F) {
    REFRESH(F);
    LAS float* scr = (LAS float*)(F.lds + RING_OFF + F.wave * 16384);
    const int gw = F.vcu * NWAVES + F.wave, NGW = F.G * NWAVES;
    bf16* W13A = (bf16*)(kws() + WS_W13A); bf16* W2A = (bf16*)(kws() + WS_W2A); bf16* W13B = (bf16*)(kws() + WS_W13B); bf16* W2B = (bf16*)(kws() + WS_W2B);
    bf16* WIN1 = (bf16*)(kws() + WS_WIN1); bf16* WIN2 = (bf16*)(kws() + WS_WIN2); bf16* WA = (bf16*)(kws() + WS_WA); bf16* WSs = (bf16*)(kws() + WS_WS); bf16* WO = (bf16*)(kws() + WS_WO);
    const float* w_in = kin(16);
    constexpr int KB16 = D / 64;
    constexpr int IT_IN1 = KB16 * ((3072 + 3072) / 32), IT_F = KB16, IT_DT = KB16, IT_IN2 = KB16 * (4096 / 32), IT_A = KB16 * 32, IT_S = 32 * 32, IT_O = KB16 * 32;
    constexpr int NITEMS = 2 * IT_FFN + IT_IN1 + IT_F + IT_DT + IT_IN2 + IT_A + IT_S + IT_O;
    for (int it = gw; it < NITEMS; it += NGW) {
        int r = it;
        { const bool late = (it >= IT_FFN && it < 2 * IT_FFN) || it >= 2 * IT_FFN + IT_IN1 + IT_F + IT_DT; if (late != LATE) continue; }
        if (r < IT_FFN) { p0_ffn_item(kin(12), kin(13), kin(14), W13A, W2A, scr, r, F.lane); continue; } r -= IT_FFN;
        if (r < IT_FFN) { p0_ffn_item(kin(28), kin(29), kin(30), W13B, W2B, scr, r, F.lane); continue; } r -= IT_FFN;
        if (r < IT_IN1) { const int kb = r / 192, nb = r % 192, j0 = 32 * nb;
            p0_tr_item(w_in, D_IN, D, j0 < 3072 ? j0 : CX + (j0 - 3072), WIN1, j0, 32, nullptr, scr, kb, F.lane); continue; } r -= IT_IN1;
        if (r < IT_F) { p0_tr_item(w_in, D_IN, D, CF, WIN1, 6144, 16, nullptr, scr, r, F.lane); continue; } r -= IT_F;
        if (r < IT_DT) { p0_tr_item(w_in, D_IN, D, CDT, WIN1, 6144 + 16, 32, nullptr, scr, r, F.lane); continue; } r -= IT_DT;
        if (r < IT_IN2) { const int kb = r / 128, nb = r % 128, j0 = 32 * nb;
            p0_tr_item(w_in, D_IN, D, j0 < 2048 ? CZ + j0 : (j0 < 3072 ? CGA + (j0 - 2048) : CGS + (j0 - 3072)), WIN2, j0, 32, nullptr, scr, kb, F.lane); continue; } r -= IT_IN2;
        if (r < IT_A) { p0_tr_item(kin(24), D, D, 32 * (r % 32), WA, 32 * (r % 32), 32, nullptr, scr, r / 32, F.lane); continue; } r -= IT_A;
        if (r < IT_S) { p0_tr_item(kin(25), D, D_INNER, 32 * (r % 32), WSs, 32 * (r % 32), 32, kin(23), scr, r / 32, F.lane); continue; } r -= IT_S;
        p0_tr_item(kin(26), D, D, 32 * (r % 32), WO, 32 * (r % 32), 32, nullptr, scr, r / 32, F.lane);
    }
    if (LATE) return;
    { GAS v4u* z = (GAS v4u*)(WIN1 + (size_t)(6144 + 48) * D); const int n16 = 208 * D * 2 / 16; const v4u zero = {0u, 0u, 0u, 0u};
      for (int i = gw * 64 + F.lane; i < n16; i += NGW * 64) z[i] = zero; }
    __syncthreads();
    LAS float* sc = (LAS float*)(F.lds + RING_OFF);
    LAS float* red = (LAS float*)(F.lds + RING_OFF + 69632);
    for (int i = F.tid; i < 17 * 1024; i += NWAVES * 64) { const int rr = i >> 10, k = i & 1023; const float c = rr == 0 ? kin(2)[k] : kin(3)[(size_t)(rr - 1) * 1024 + k]; sc[i] = pg8::silu(c); }
    __syncthreads();
    const float* w_ada = kin(9); const float* b_ada = kin(10); float* mod = (float*)(kws() + WS_MOD);
    for (int un = F.vcu; un < NMODC / 64; un += F.G) {
        const int col = un * 64 + (F.tid & 63), kg = F.tid >> 6;
        float a[17];
#pragma unroll
        for (int rr = 0; rr < 17; ++rr) a[rr] = 0.f;
        for (int k0 = kg * 128; k0 < kg * 128 + 128; k0 += 8) {
            float w[8];
#pragma unroll
            for (int i = 0; i < 8; ++i) w[i] = w_ada[(size_t)(k0 + i) * NMODC + col];
#pragma unroll
            for (int i = 0; i < 8; ++i)
#pragma unroll
                for (int rr = 0; rr < 17; ++rr) a[rr] += sc[rr * 1024 + k0 + i] * w[i]; }
#pragma unroll
        for (int rr = 0; rr < 17; ++rr) red[(kg * 17 + rr) * 64 + (F.tid & 63)] = a[rr];
        __syncthreads();
        for (int i = F.tid; i < 17 * 64; i += NWAVES * 64) { const int rr = i >> 6, cc = i & 63; float s = b_ada[un * 64 + cc];
#pragma unroll
            for (int g = 0; g < 8; ++g) s += red[(g * 17 + rr) * 64 + cc];
            mod[(size_t)rr * NMODC + un * 64 + cc] = s; }
        __syncthreads();
    }
}
__device__ __forceinline__ void norm_phase(Frame& F, const float* xp, const float* xs, const float* g, int chunk_shift, bf16* HN, int m_lo = 0) {
    REFRESH(F);
    const int gw = F.vcu * NWAVES + F.wave, NGW = F.G * NWAVES; const float* mod = (const float*)(kws() + WS_MOD);
    for (int m = m_lo + gw; m < MT; m += NGW) {
        const float* xrow = m < MP ? xp + (size_t)m * D : xs + (size_t)(m - MP) * D;
        const float* sh = mod + (size_t)pg8::bidx(m) * NMODC + chunk_shift * 1024; const float* scl = sh + 1024;
        const GAS f32x4* xr = (const GAS f32x4*)xrow + F.lane;
        f32x4 v[4]; float s = 0.f;
#pragma unroll
        for (int j = 0; j < 4; ++j) { v[j] = xr[64 * j]; s += (v[j].x * v[j].x + v[j].y * v[j].y) + (v[j].z * v[j].z + v[j].w * v[j].w); }
        const float rstd = 1.0f / sqrtf(wave_sum(s) * (1.f / D) + EPS);
        GAS unsigned long long* o8 = (GAS unsigned long long*)(HN + (size_t)m * D) + F.lane;
#pragma unroll
        for (int j = 0; j < 4; ++j) { const int c = 4 * (F.lane + 64 * j); const f32x4 gg = *(const f32x4*)(g + c), s1 = *(const f32x4*)(scl + c), s0 = *(const f32x4*)(sh + c);
            const f32x4 o = v[j] * rstd * gg * (s1 + 1.0f) + s0;
            o8[64 * j] = (unsigned long long)pk2(o.x, o.y) | ((unsigned long long)pk2(o.z, o.w) << 32); }
    }
}
__device__ __forceinline__ void final_norm_phase(Frame& F, float* X, const float* g, int m_lo = 0) {
    REFRESH(F);
    const int gw = F.vcu * NWAVES + F.wave, NGW = F.G * NWAVES;
    for (int m = m_lo + gw; m < MT; m += NGW) {
        GAS f32x4* xr = (GAS f32x4*)(X + (size_t)m * D) + F.lane;
        f32x4 v[4]; float s = 0.f;
#pragma unroll
        for (int j = 0; j < 4; ++j) { v[j] = xr[64 * j]; s += (v[j].x * v[j].x + v[j].y * v[j].y) + (v[j].z * v[j].z + v[j].w * v[j].w); }
        const float rstd = 1.0f / sqrtf(wave_sum(s) * (1.f / D) + EPS);
#pragma unroll
        for (int j = 0; j < 4; ++j) { const f32x4 gg = *(const f32x4*)(g + 4 * (F.lane + 64 * j)); xr[64 * j] = v[j] * rstd * gg; }
    }
}
__device__ __forceinline__ void qknorm_phase(Frame& F) {
    REFRESH(F);
    const bf16* QO = (const bf16*)(kws() + WS_QO); const bf16* KB = (const bf16*)(kws() + WS_KB); unsigned* kq = (unsigned*)(kws() + WS_CTL) + CW_KQ;
    const int gw = F.vcu * NWAVES + F.wave, NGW = F.G * NWAVES; float mq = 0.f, mk = 0.f;
    for (int m = gw; m < MP; m += NGW) {
        const v4u* qp = (const v4u*)(QO + (size_t)m * D + 16 * F.lane); const v4u* kp = (const v4u*)(KB + (size_t)m * D + 16 * F.lane);
        float sq = 0.f, sk = 0.f, sd = 0.f;
#pragma unroll
        for (int i = 0; i < 2; ++i) { const v4u a = qp[i], b = kp[i]; const unsigned* aw = (const unsigned*)&a; const unsigned* bw = (const unsigned*)&b;
#pragma unroll
            for (int j = 0; j < 4; ++j) { const float a0 = pg8::bflo(aw[j]), a1 = pg8::bfhi(aw[j]), b0 = pg8::bflo(bw[j]), b1 = pg8::bfhi(bw[j]); sq += a0 * a0 + a1 * a1; sk += b0 * b0 + b1 * b1; sd += a0 * b0 + a1 * b1; } }
        sq += __shfl_xor(sq, 1); sq += __shfl_xor(sq, 2); sk += __shfl_xor(sk, 1); sk += __shfl_xor(sk, 2); sd += __shfl_xor(sd, 1); sd += __shfl_xor(sd, 2);
        mq = fmaxf(mq, sq); mk = fmaxf(mk, sk);
        if ((F.lane & 3) == 0) { const int b_ = __float_as_int(fminf(sd, 0.f)); atomicMin((int*)kq + 64 + (F.lane >> 2) * 64 + (m >> 8), b_ ^ ((b_ >> 31) & 0x7fffffff)); }
    }
    if ((F.lane & 3) == 0) { atomicMax(kq + (F.lane >> 2), __float_as_uint(mq)); atomicMax(kq + 16 + (F.lane >> 2), __float_as_uint(mk)); }
}
__device__ __forceinline__ void fcum_halo_phase(Frame& F) {
    REFRESH(F);
    const float* logf = kout() + O_LP; float* F2 = (float*)(kws() + WS_F2);
    LAS float* part = (LAS float*)(F.lds + RING_OFF);
    if (F.vcu < H_A) {
        const int h = F.vcu; float loc[32]; float s = 0.f;
#pragma unroll
        for (int i = 0; i < 32; ++i) { loc[i] = logf[(size_t)(32 * F.tid + i) * H_A + h]; s += loc[i]; }
        float v = s;
#pragma unroll
        for (int o = 1; o < 64; o <<= 1) { const float nn = __shfl_up(v, o); if (F.lane >= o) v += nn; }
        if (F.lane == 63) part[F.wave] = v;
        __syncthreads();
        float run = v - s;
#pragma unroll
        for (int w = 0; w < 8; ++w) run += (w < F.wave) ? part[w] : 0.f;
#pragma unroll
        for (int i = 0; i < 32; ++i) { run += loc[i]; F2[(size_t)h * MP + 32 * F.tid + i] = run * LOG2E; }
        __syncthreads();
    }
}
__device__ __forceinline__ void conv_phase(Frame& F) {
    REFRESH(F);
    bf16* XBC = (bf16*)(kws() + WS_XBC); const bf16* HALO = (const bf16*)(kws() + WS_HALO);
    const float* cw = kin(18); const float* cb = kin(19); const float* sconv = kin(8);
    for (int un = F.vcu; un < 256 + DEC_B; un += F.G) {
        const bool smp = un >= 256; const int row0 = smp ? MP + 16 * (un - 256) : 64 * un, nrows = smp ? 16 : 64;
        if (F.tid < CONV_DIM / 8) {
            const int c = 8 * F.tid; float w[4][8], bb[8], p0[8], p1[8], p2[8];
#pragma unroll
            for (int j = 0; j < 8; ++j) { w[0][j] = cw[c + j]; w[1][j] = cw[CONV_DIM + c + j]; w[2][j] = cw[2 * CONV_DIM + c + j]; w[3][j] = cw[3 * CONV_DIM + c + j]; bb[j] = cb[c + j]; }
            if (smp) { const float* s = sconv + (size_t)(un - 256) * 3 * CONV_DIM + c;
#pragma unroll
                for (int j = 0; j < 8; ++j) { p0[j] = s[j]; p1[j] = s[CONV_DIM + j]; p2[j] = s[2 * CONV_DIM + j]; } }
            else if (un == 0) {
#pragma unroll
                for (int j = 0; j < 8; ++j) { p0[j] = 0.f; p1[j] = 0.f; p2[j] = 0.f; } }
            else { const v4u h0 = *(const GAS v4u*)(HALO + (size_t)un * 3 * CONV_DIM + c), h1 = *(const GAS v4u*)(HALO + (size_t)un * 3 * CONV_DIM + CONV_DIM + c), h2 = *(const GAS v4u*)(HALO + (size_t)un * 3 * CONV_DIM + 2 * CONV_DIM + c);
                const unsigned* a0 = (const unsigned*)&h0; const unsigned* a1 = (const unsigned*)&h1; const unsigned* a2 = (const unsigned*)&h2;
#pragma unroll
                for (int j = 0; j < 8; ++j) { p0[j] = (j & 1) ? pg8::bfhi(a0[j >> 1]) : pg8::bflo(a0[j >> 1]); p1[j] = (j & 1) ? pg8::bfhi(a1[j >> 1]) : pg8::bflo(a1[j >> 1]); p2[j] = (j & 1) ? pg8::bfhi(a2[j >> 1]) : pg8::bflo(a2[j >> 1]); } }
            GAS v4u* col = (GAS v4u*)(XBC + (size_t)row0 * CONV_DIM + c);
#pragma unroll 1
            for (int t0 = 0; t0 < nrows; t0 += 16) {
                v4u rvs[16];
#pragma unroll
                for (int i = 0; i < 16; ++i) rvs[i] = col[(size_t)(t0 + i) * (CONV_DIM / 8)];
#pragma unroll
                for (int i = 0; i < 16; ++i) { const unsigned* rw = (const unsigned*)&rvs[i]; float o[8];
#pragma unroll
                    for (int j = 0; j < 8; ++j) { const float v = (j & 1) ? pg8::bfhi(rw[j >> 1]) : pg8::bflo(rw[j >> 1]);
                        o[j] = pg8::silu(bb[j] + w[0][j] * p0[j] + w[1][j] * p1[j] + w[2][j] * p2[j] + w[3][j] * v); p0[j] = p1[j]; p1[j] = p2[j]; p2[j] = v; }
                    v4u ov; ov.x = pk2(o[0], o[1]); ov.y = pk2(o[2], o[3]); ov.z = pk2(o[4], o[5]); ov.w = pk2(o[6], o[7]);
                    col[(size_t)(t0 + i) * (CONV_DIM / 8)] = ov; }
            }
        }
    }
}
__device__ __forceinline__ void ssd_seq(const bf16* XBC, bf16* YB, const float* DT, int row0, int nrows, int h, int p, float a, float dsk, float& h0, float& h1, int lane) {
    const int g = h >> 3; constexpr int U = 8;
    const bf16* xcol = XBC + (size_t)row0 * CONV_DIM + 64 * h + p; bf16* ycol = YB + (size_t)row0 * D_INNER + 64 * h + p;
    const unsigned* Bp = (const unsigned*)(XBC + (size_t)row0 * CONV_DIM + 2048 + 128 * g) + lane;
    const unsigned* Cp = (const unsigned*)(XBC + (size_t)row0 * CONV_DIM + 2560 + 128 * g) + lane;
    const float* dtp = DT + (size_t)row0 * 32 + h;
    unsigned bq[U], cq[U]; float xq[U], dq[U];
#pragma unroll
    for (int i = 0; i < U; ++i) { bq[i] = Bp[(size_t)i * (CONV_DIM / 2)]; cq[i] = Cp[(size_t)i * (CONV_DIM / 2)]; xq[i] = pg8::bf2f(xcol[(size_t)i * CONV_DIM]); dq[i] = dtp[(size_t)i * 32]; }
    for (int t0 = 0; t0 < nrows; t0 += U) {
        unsigned bn[U], cn[U]; float xn[U], dn[U];
        const int tn = (t0 + U < nrows) ? t0 + U : t0;
#pragma unroll
        for (int i = 0; i < U; ++i) { bn[i] = Bp[(size_t)(tn + i) * (CONV_DIM / 2)]; cn[i] = Cp[(size_t)(tn + i) * (CONV_DIM / 2)]; xn[i] = pg8::bf2f(xcol[(size_t)(tn + i) * CONV_DIM]); dn[i] = dtp[(size_t)(tn + i) * 32]; }
        float yv[U];
#pragma unroll
        for (int i = 0; i < U; ++i) {
            const float dA = __expf(dq[i] * a), cf = dq[i] * xq[i];
            h0 = dA * h0 + cf * pg8::bflo(bq[i]); h1 = dA * h1 + cf * pg8::bfhi(bq[i]);
            yv[i] = wave_sum(pg8::bflo(cq[i]) * h0 + pg8::bfhi(cq[i]) * h1) + dsk * xq[i];
        }
        if (lane == 0) {
#pragma unroll
            for (int i = 0; i < U; ++i) ycol[(size_t)(t0 + i) * D_INNER] = (bf16)f2bf(yv[i]);
        }
#pragma unroll
        for (int i = 0; i < U; ++i) { bq[i] = bn[i]; cq[i] = cn[i]; xq[i] = xn[i]; dq[i] = dn[i]; }
    }
}
__device__ __forceinline__ void ssd_sample_rec(Frame& F) {
    const bf16* XBC = (const bf16*)(kws() + WS_XBC); bf16* YB = (bf16*)(kws() + WS_YB); const float* DT = (const float*)(kws() + WS_DT);
    const float* a_log = kin(21); const float* dskip = kin(22); const float* sssm = kin(7);
    for (int un = F.vcu; un < DEC_B * SSD_H / 2; un += F.G) {
        const int pi = 2 * un + (F.tid >> 8), b = pi >> 5, h = pi & 31, g = h >> 3, p = (F.tid & 255) >> 2, q = F.tid & 3;
        const float a = -__expf(a_log[h]), dsk = dskip[h];
        typedef float f32x2v __attribute__((ext_vector_type(2)));
        f32x2v hs[16];
        { const f32x4* sp = (const f32x4*)(sssm + (((size_t)b * SSD_H + h) * SSD_P + p) * SSD_N + 32 * q);
#pragma unroll
          for (int j = 0; j < 8; ++j) { const f32x4 v = sp[j]; hs[2 * j] = (f32x2v){v.x, v.y}; hs[2 * j + 1] = (f32x2v){v.z, v.w}; } }
        LAS unsigned char* SL = F.lds + RING_OFF + (F.tid >> 8) * 18688;
        { const int ht = F.tid & 255, tok = ht >> 4, pc = ht & 15; const size_t row = (size_t)MP + 16 * b + tok;
          const v4u bv = *(const v4u*)(XBC + row * CONV_DIM + 2048 + 128 * g + 8 * pc), cv = *(const v4u*)(XBC + row * CONV_DIM + 2560 + 128 * g + 8 * pc);
          LAS f32x4* bd = (LAS f32x4*)(SL + tok * 512 + pc * 32); LAS f32x4* cd = (LAS f32x4*)(SL + 8192 + tok * 512 + pc * 32);
          bd[0] = (f32x4){pg8::bflo(bv.x), pg8::bfhi(bv.x), pg8::bflo(bv.y), pg8::bfhi(bv.y)}; bd[1] = (f32x4){pg8::bflo(bv.z), pg8::bfhi(bv.z), pg8::bflo(bv.w), pg8::bfhi(bv.w)};
          cd[0] = (f32x4){pg8::bflo(cv.x), pg8::bfhi(cv.x), pg8::bflo(cv.y), pg8::bfhi(cv.y)}; cd[1] = (f32x4){pg8::bflo(cv.z), pg8::bfhi(cv.z), pg8::bflo(cv.w), pg8::bfhi(cv.w)};
          if (pc < 8) *(LAS v4u*)(SL + 16384 + tok * 128 + pc * 16) = *(const v4u*)(XBC + row * CONV_DIM + 64 * h + 8 * pc);
          if (pc == 8) *(LAS float*)(SL + 18432 + tok * 4) = DT[row * 32 + h]; }
        __syncthreads();
#pragma unroll 2
        for (int t = 0; t < DEC_T; ++t) {
            const size_t row = (size_t)MP + 16 * b + t;
            const float dtv = *(const LAS float*)(SL + 18432 + t * 4), xv = pg8::bf2f(*(const LAS unsigned short*)(SL + 16384 + t * 128 + p * 2));
            const LAS f32x4* bp = (const LAS f32x4*)(SL + t * 512 + 128 * q); const LAS f32x4* cp = (const LAS f32x4*)(SL + 8192 + t * 512 + 128 * q);
            const float dA = __expf(dtv * a), cf = dtv * xv; f32x2v part2 = (f32x2v){0.f, 0.f};
#pragma unroll
            for (int j = 0; j < 8; ++j) { const f32x4 bv = bp[j], cv = cp[j];
                hs[2 * j] = dA * hs[2 * j] + cf * (f32x2v){bv.x, bv.y}; part2 += (f32x2v){cv.x, cv.y} * hs[2 * j];
                hs[2 * j + 1] = dA * hs[2 * j + 1] + cf * (f32x2v){bv.z, bv.w}; part2 += (f32x2v){cv.z, cv.w} * hs[2 * j + 1]; }
            float part = part2.x + part2.y;
            part += __shfl_xor(part, 1); part += __shfl_xor(part, 2);
            if (q == 0) YB[row * D_INNER + 64 * h + p] = (bf16)f2bf(part + dsk * xv);
        }
        __syncthreads();
        { f32x4* so = (f32x4*)(kout() + O_SS + (((size_t)b * SSD_H + h) * SSD_P + p) * SSD_N + 32 * q);
#pragma unroll
          for (int j = 0; j < 8; ++j) so[j] = (f32x4){hs[2 * j].x, hs[2 * j].y, hs[2 * j + 1].x, hs[2 * j + 1].y}; }
    }
}
template <class Epi>
__device__ __forceinline__ void skinny_gemm(Frame& F, const bf16* A, int lda, const bf16* Bt, int K, const Epi& E, int NB = 32) {
    REFRESH(F);
    typedef short bf16x8 __attribute__((ext_vector_type(8)));
    LAS float* red = (LAS float*)(F.lds + RING_OFF);
    const int lane = F.lane, wave = F.wave, l15 = lane & 15, quad = lane >> 4, kw = K / 8;
    for (int v = F.vcu; v < 8 * NB; v += F.G) {
        const int row0 = MP + 32 * (v / NB), col0 = 32 * (v % NB);
        const bf16* ap = A + (size_t)(row0 + l15) * lda + wave * kw + 8 * quad; const bf16* bp = Bt + (size_t)(col0 + l15) * K + wave * kw + 8 * quad;
        f32x4 acc[2][2];
#pragma unroll
        for (int i = 0; i < 2; ++i)
#pragma unroll
            for (int j = 0; j < 2; ++j) acc[i][j] = (f32x4){0.f, 0.f, 0.f, 0.f};
#pragma unroll 4
        for (int k0 = 0; k0 < kw; k0 += 32) {
            const bf16x8 a0 = *(const bf16x8*)(ap + k0), a1 = *(const bf16x8*)(ap + (size_t)16 * lda + k0), b0 = *(const bf16x8*)(bp + k0), b1 = *(const bf16x8*)(bp + (size_t)16 * K + k0);
            acc[0][0] = __builtin_amdgcn_mfma_f32_16x16x32_bf16(a0, b0, acc[0][0], 0, 0, 0); acc[0][1] = __builtin_amdgcn_mfma_f32_16x16x32_bf16(a0, b1, acc[0][1], 0, 0, 0);
            acc[1][0] = __builtin_amdgcn_mfma_f32_16x16x32_bf16(a1, b0, acc[1][0], 0, 0, 0); acc[1][1] = __builtin_amdgcn_mfma_f32_16x16x32_bf16(a1, b1, acc[1][1], 0, 0, 0);
        }
#pragma unroll
        for (int i = 0; i < 2; ++i)
#pragma unroll
            for (int j = 0; j < 2; ++j)
#pragma unroll
                for (int r = 0; r < 4; ++r) red[(wave * 32 + 16 * i + 4 * quad + r) * 33 + 16 * j + l15] = acc[i][j][r];
        __syncthreads();
        for (int i = F.tid; i < 1024; i += NWAVES * 64) { const int rr = i >> 5, cc = i & 31; float s = 0.f;
#pragma unroll
            for (int w = 0; w < 8; ++w) s += red[(w * 32 + rr) * 33 + cc];
            E.elem(row0 + rr, col0 + cc, s); }
        __syncthreads();
    }
}
__device__ __forceinline__ void ssq_sample_pass(Frame& F) {
    REFRESH(F);
    const bf16* Y = (const bf16*)(kws() + WS_YB); float* SSQ = (float*)(kws() + WS_SSQ);
    const int gw = F.vcu * NWAVES + F.wave, NGW = F.G * NWAVES;
    for (int r = gw; r < MS; r += NGW) {
        const v4u* yp = (const v4u*)(Y + (size_t)(MP + r) * D_INNER) + F.lane; float s = 0.f;
#pragma unroll
        for (int i = 0; i < 4; ++i) { const v4u a = yp[64 * i]; const unsigned* aw = (const unsigned*)&a;
#pragma unroll
            for (int j = 0; j < 4; ++j) { const float a0 = pg8::bflo(aw[j]), a1 = pg8::bfhi(aw[j]); s += a0 * a0 + a1 * a1; } }
        s = wave_sum(s);
        if (F.lane < 32) SSQ[(size_t)(MP + r) * 32 + F.lane] = F.lane == 0 ? s : 0.f;
    }
}
__device__ __forceinline__ void attn_sample_phase(Frame& F, bf16* OUT = nullptr) {
    REFRESH(F);
    constexpr int NK = PAST + DEC_T, NKP = 1056;
    typedef short bf16x8 __attribute__((ext_vector_type(8)));
    const float* ck = kin(4); const float* cv = kin(5); const float* clf = kin(6);
    bf16* QO = (bf16*)(kws() + WS_QO); const bf16* KB = (const bf16*)(kws() + WS_KB); const bf16* VB = (const bf16*)(kws() + WS_VB);
    LAS unsigned char* L = F.lds + RING_OFF;
    LAS float* fall = (LAS float*)L;
    LAS float* pt = fall + NKP;
    LAS float* red = pt + NKP * 16;
    LAS float* stat = red + 8 * 1024;
    const int lane = F.lane, wave = F.wave, tid = F.tid, l15 = lane & 15, quad = lane >> 4;
    for (int un = F.vcu; un < DEC_B * H_A; un += F.G) {
        const int b = un >> 4, h = un & 15;
        { const float l0 = clf[((size_t)b * PAST + 2 * tid) * H_A + h], l1 = clf[((size_t)b * PAST + 2 * tid + 1) * H_A + h];
          float v = l0 + l1;
#pragma unroll
          for (int o = 1; o < 64; o <<= 1) { const float nn = __shfl_up(v, o); if (lane >= o) v += nn; }
          if (lane == 63) stat[32 + wave] = v;
          __syncthreads();
          float base = 0.f;
#pragma unroll
          for (int w = 0; w < 8; ++w) base += (w < wave) ? stat[32 + w] : 0.f;
          const float incl = base + v;
          fall[2 * tid] = (incl - l1) * LOG2E; fall[2 * tid + 1] = incl * LOG2E;
          __syncthreads();
          if (wave == 0) { float nv = lane < DEC_T ? kout()[O_LS + ((size_t)b * DEC_T + lane) * H_A + h] : 0.f;
#pragma unroll
              for (int o = 1; o < 16; o <<= 1) { const float nn = __shfl_up(nv, o); if (lane >= o) nv += nn; }
              if (lane < DEC_T) fall[PAST + lane] = fall[PAST - 1] + nv * LOG2E; else if (lane < 32) fall[PAST + lane] = 0.f; }
          __syncthreads(); }
        { const bf16* qp = QO + (size_t)(MP + 16 * b + l15) * D + 64 * h + 8 * quad;
          const bf16x8 qa0 = *(const bf16x8*)qp, qa1 = *(const bf16x8*)(qp + 32);
          f32x4 kr[8][4];
#pragma unroll
          for (int i = 0; i < 8; ++i) { const f32x4* kp = (const f32x4*)(ck + (((size_t)b * PAST + 16 * (wave + 8 * i) + l15) * H_A + h) * HD + 8 * quad); kr[i][0] = kp[0]; kr[i][1] = kp[1]; kr[i][2] = kp[8]; kr[i][3] = kp[9]; }
#pragma unroll
          for (int i = 0; i < 9; ++i) {
              const int kb = wave + 8 * i; if (kb >= NKP / 16) break;
              const int key = 16 * kb + l15; bf16x8 k0, k1;
              if (i < 8) { const f32x4 a0 = kr[i & 7][0], a1 = kr[i & 7][1], a2 = kr[i & 7][2], a3 = kr[i & 7][3];
                  k0 = (bf16x8){(short)f2bf(a0.x), (short)f2bf(a0.y), (short)f2bf(a0.z), (short)f2bf(a0.w), (short)f2bf(a1.x), (short)f2bf(a1.y), (short)f2bf(a1.z), (short)f2bf(a1.w)};
                  k1 = (bf16x8){(short)f2bf(a2.x), (short)f2bf(a2.y), (short)f2bf(a2.z), (short)f2bf(a2.w), (short)f2bf(a3.x), (short)f2bf(a3.y), (short)f2bf(a3.z), (short)f2bf(a3.w)}; }
              else if (key < NK) { const bf16* kp = KB + (size_t)(MP + 16 * b + (key - PAST)) * D + 64 * h + 8 * quad; k0 = *(const bf16x8*)kp; k1 = *(const bf16x8*)(kp + 32); }
              else { k0 = (bf16x8){0, 0, 0, 0, 0, 0, 0, 0}; k1 = k0; }
              f32x4 acc = (f32x4){0.f, 0.f, 0.f, 0.f};
              acc = __builtin_amdgcn_mfma_f32_16x16x32_bf16(qa0, k0, acc, 0, 0, 0);
              acc = __builtin_amdgcn_mfma_f32_16x16x32_bf16(qa1, k1, acc, 0, 0, 0);
              const float fk = fall[key];
#pragma unroll
              for (int r = 0; r < 4; ++r) { const int q = 4 * quad + r; const float s = acc[r] + fall[PAST + q] - fk;
                  pt[key * 16 + q] = (key >= NK || key - PAST > q) ? -INFINITY : s; }
          } }
        __syncthreads();
        for (int q = 2 * wave; q < 2 * wave + 2; ++q) {
            float mx = -INFINITY; for (int j = lane; j < NKP; j += 64) mx = fmaxf(mx, pt[j * 16 + q]); mx = wave_max(mx);
            float sm = 0.f; for (int j = lane; j < NKP; j += 64) sm += __builtin_amdgcn_exp2f(pt[j * 16 + q] - mx); sm = wave_sum(sm);
            if (lane == 0) { stat[q] = mx; stat[16 + q] = 1.0f / sm; }
        }
        __syncthreads();
        for (int i = tid; i < NKP * 16; i += NWAVES * 64) { const int q = i & 15; pt[i] = __builtin_amdgcn_exp2f(pt[i] - stat[q]) * stat[16 + q]; }
        __syncthreads();
        { f32x4 o[16];
#pragma unroll
          for (int q = 0; q < 16; ++q) o[q] = (f32x4){0.f, 0.f, 0.f, 0.f};
          const int ks = wave * 4 + quad;
#pragma unroll
          for (int jb = 0; jb < 2; ++jb) {
              f32x4 vr[16];
#pragma unroll
              for (int j = 0; j < 16; ++j) vr[j] = *(const f32x4*)(cv + (((size_t)b * PAST + ks + 32 * (16 * jb + j)) * H_A + h) * HD + 4 * l15);
#pragma unroll
              for (int j = 0; j < 16; ++j) { const f32x4 v = vr[j]; const LAS f32x4* pp = (const LAS f32x4*)(pt + (ks + 32 * (16 * jb + j)) * 16);
#pragma unroll
                  for (int q4 = 0; q4 < 4; ++q4) { const f32x4 p = pp[q4]; o[4 * q4] = o[4 * q4] + v * p.x; o[4 * q4 + 1] = o[4 * q4 + 1] + v * p.y; o[4 * q4 + 2] = o[4 * q4 + 2] + v * p.z; o[4 * q4 + 3] = o[4 * q4 + 3] + v * p.w; } }
          }
          { const int key = ks + PAST;
            if (key < NK) { const bf16* vp = VB + (size_t)(MP + 16 * b + (key - PAST)) * D + 64 * h + 4 * l15; const f32x4 v = (f32x4){pg8::bf2f(vp[0]), pg8::bf2f(vp[1]), pg8::bf2f(vp[2]), pg8::bf2f(vp[3])};
              const LAS f32x4* pp = (const LAS f32x4*)(pt + key * 16);
#pragma unroll
              for (int q4 = 0; q4 < 4; ++q4) { const f32x4 p = pp[q4]; o[4 * q4] = o[4 * q4] + v * p.x; o[4 * q4 + 1] = o[4 * q4 + 1] + v * p.y; o[4 * q4 + 2] = o[4 * q4 + 2] + v * p.z; o[4 * q4 + 3] = o[4 * q4 + 3] + v * p.w; } } }
#pragma unroll
          for (int q = 0; q < 16; ++q)
#pragma unroll
              for (int c = 0; c < 4; ++c) { float t = o[q][c]; t += __shfl_xor(t, 16); t += __shfl_xor(t, 32); o[q][c] = t; }
          if (quad == 0) {
#pragma unroll
              for (int q = 0; q < 16; ++q) *(LAS f32x4*)(red + (wave * 16 + q) * 64 + 4 * l15) = o[q];
          } }
        __syncthreads();
        for (int i = tid; i < 1024; i += NWAVES * 64) { float s = 0.f;
#pragma unroll
            for (int w = 0; w < 8; ++w) s += red[w * 1024 + i];
            (OUT ? OUT : QO)[(size_t)(MP + 16 * b + (i >> 6)) * D + 64 * h + (i & 63)] = (bf16)f2bf(s); }
        __syncthreads();
    }
}
namespace ssd {
constexpr int PC = 136, PS = 72;
constexpr int L_CS = 0, L_BS = L_CS + 64 * PC * 2, L_BT = L_BS + 64 * PC * 2, L_XT = L_BT + 128 * PS * 2, L_XW = L_XT + 64 * PS * 2, L_GS = L_XW + 64 * PS * 2,
              L_HS = L_GS + 64 * PS * 2, L_YS = L_HS + 64 * PC * 2, L_AT = L_YS + 64 * PS * 2, L_DT = L_AT + 2048 * 4, L_WT = L_DT + 2048 * 4, L_END = L_WT + 64;
static_assert(L_END <= 131072, "SSD LDS map");
typedef short bf16x8 __attribute__((ext_vector_type(8)));
typedef float f32x4 __attribute__((ext_vector_type(4)));
typedef unsigned v2u __attribute__((ext_vector_type(2)));
__device__ __forceinline__ bf16x8 frag(const LAS unsigned char* L, int base, int row, int pitch, int k0) { return *(const LAS bf16x8*)(L + base + (row * pitch + k0) * 2); }
__device__ __forceinline__ v4u ld8(const bf16* XBC, int t, int col) { v4u z = {0u, 0u, 0u, 0u}; return t >= 0 ? *(const GAS v4u*)(XBC + (size_t)t * CONV_DIM + col) : z; }

#define SSD_OPQ(x) asm volatile("" : "+v"(x))
__device__ __forceinline__ unsigned short bf1(float v) { return (unsigned short)(pg8::cvt_pk_bf16(v, 0.f) & 0xffffu); }
template <bool FULL, int VAR = 0>
__device__ __forceinline__ void ssd_unit(Frame& F, int h, int sg, const bf16* XBC, const float* DT, bf16* YB, float* SSEG, float* DSEG, float* ssm_out,
                                         const float* conv_w, const float* conv_b, const float* a_log, const float* dskip, const int nck = 32) {
    (void)conv_w; (void)conv_b;
    LAS unsigned char* L = F.lds + RING_OFF;
    const int lane = F.lane, wave = F.wave, g = h >> 3, l15 = lane & 15, quad = lane >> 4, tb = wave >> 1, hb = wave & 1;
    const float a = -__expf(a_log[h]), dsk = dskip[h];
    LAS float* AT = (LAS float*)(L + L_AT); LAS float* DTT = (LAS float*)(L + L_DT);
    int fPC = (l15 * PC + 8 * quad) * 2, fPS = (l15 * PS + 8 * quad) * 2;
    int fPCt = fPC + 16 * tb * PC * 2, fPSt = fPS + 16 * tb * PS * 2;
    int fPCh = fPC + 32 * hb * PC * 2;
    const int h3 = l15 >> 3;
    int xfo[2][2], xwo[4][2], bto[2], xe[2];
#pragma unroll
    for (int j = 0; j < 2; ++j) { const int p = 32 * hb + 16 * j + l15, f = (4 * hb + 2 * j + h3) & 7;
#pragma unroll
        for (int k = 0; k < 2; ++k) xfo[j][k] = p * PS * 2 + (((4 * k + quad) ^ f) << 4);
        xe[j] = p * PS * 2 + (((2 * tb + (quad >> 1)) ^ f) << 4) + 8 * (quad & 1); }
#pragma unroll
    for (int pb = 0; pb < 4; ++pb)
#pragma unroll
        for (int k = 0; k < 2; ++k) xwo[pb][k] = (16 * pb + l15) * PS * 2 + (((4 * k + quad) ^ ((2 * pb + h3) & 7)) << 4);
#pragma unroll
    for (int k = 0; k < 2; ++k) bto[k] = (16 * wave + l15) * PS * 2 + (((4 * k + quad) ^ ((2 * wave + h3) & 7)) << 4);
    int wTP = ((16 * tb + 4 * quad) * PS + 32 * hb + l15) * 2;
    int wHS = ((4 * quad) * PC + 16 * wave + l15) * 2;
    int sT = (16 * tb + 4 * quad) * 4, sS = (32 * hb + l15) * 4;
    const int cgx = lane & 7, rx = 8 * wave + (lane >> 3);
    int sXT = (8 * cgx * PS + (((wave ^ cgx) << 3) | (lane >> 3))) * 2;
    const int cgb = lane & 15, rb = 8 * wave + 2 * (lane >> 4);
    int sBR = (rb * PC + 8 * cgb) * 2, sBT = (8 * cgb * PS + (((wave ^ (cgb & 7)) << 3) | (2 * (lane >> 4)))) * 2;
    int yRD = ((lane >> 3) * PS + 8 * (lane & 7)) * 2 + (8 * wave) * PS * 2;
    SSD_OPQ(fPCt); SSD_OPQ(fPSt); SSD_OPQ(fPCh); SSD_OPQ(wTP); SSD_OPQ(wHS); SSD_OPQ(xfo[0][0]); SSD_OPQ(xfo[0][1]); SSD_OPQ(xfo[1][0]); SSD_OPQ(xfo[1][1]); SSD_OPQ(xe[0]); SSD_OPQ(xe[1]); SSD_OPQ(bto[0]); SSD_OPQ(bto[1]);
    SSD_OPQ(xwo[0][0]); SSD_OPQ(xwo[0][1]); SSD_OPQ(xwo[1][0]); SSD_OPQ(xwo[1][1]); SSD_OPQ(xwo[2][0]); SSD_OPQ(xwo[2][1]); SSD_OPQ(xwo[3][0]); SSD_OPQ(xwo[3][1]); SSD_OPQ(sT); SSD_OPQ(sS); SSD_OPQ(sXT); SSD_OPQ(sBR); SSD_OPQ(sBT); SSD_OPQ(yRD);
    const int ncol = 16 * wave + l15;
    {
        const int tid = wave * 64 + lane; const float* dp = DT + (size_t)(sg * 2048 + 4 * tid) * 32 + h;
        const float d0 = dp[0], d1 = dp[32], d2 = dp[64], d3 = dp[96]; const float s4 = (d0 + d1 + d2 + d3) * a; float v = s4;
#pragma unroll
        for (int o = 1; o < 64; o <<= 1) { const float nn = __shfl_up(v, o); if (lane >= o) v += nn; }
        LAS float* WT = (LAS float*)(L + L_WT); if (lane == 63) WT[wave] = v;
        __syncthreads();
        float run = v - s4;
#pragma unroll
        for (int w = 0; w < 8; ++w) run += (w < wave) ? WT[w] : 0.f;
        run += d0 * a; AT[4 * tid] = run; run += d1 * a; AT[4 * tid + 1] = run; run += d2 * a; AT[4 * tid + 2] = run; run += d3 * a; AT[4 * tid + 3] = run;
        DTT[4 * tid] = d0; DTT[4 * tid + 1] = d1; DTT[4 * tid + 2] = d2; DTT[4 * tid + 3] = d3;
        __syncthreads();
    }
    const float aend = AT[2047];
    f32x4 hacc[4];
#pragma unroll
    for (int pb = 0; pb < 4; ++pb) hacc[pb] = (f32x4){0.f, 0.f, 0.f, 0.f};
    if (FULL) {
#pragma unroll 1
        for (int s2 = 0; s2 < sg; ++s2) { const float dg = DSEG[s2 * SSD_H + h]; const float* sp = SSEG + (((size_t)s2 * SSD_H + h) * SSD_P) * SSD_N + ncol;
#pragma unroll
            for (int pb = 0; pb < 4; ++pb)
#pragma unroll
                for (int r = 0; r < 4; ++r) hacc[pb][r] = dg * hacc[pb][r] + sp[(size_t)(16 * pb + 4 * quad + r) * SSD_N]; }
#pragma unroll
        for (int pb = 0; pb < 4; ++pb)
#pragma unroll
            for (int r = 0; r < 4; ++r) *(LAS unsigned short*)(L + L_HS + wHS + ((16 * pb + r) * PC) * 2) = bf1(hacc[pb][r]);
    }
    const bf16* gx = XBC + (size_t)(sg * 2048 + rx) * CONV_DIM + 64 * h + 8 * cgx;
    const bf16* gb = XBC + (size_t)(sg * 2048 + rb) * CONV_DIM + 2048 + 128 * g + 8 * cgb;
    constexpr int PD = FULL ? 4 : 8, PDC = FULL ? 2 : 8;
    v4u xq[PD], bq[PDC][2], cq[PDC][2];
#pragma unroll
    for (int i = 0; i < PD; ++i) { const bf16* gx2 = gx + (size_t)i * 64 * CONV_DIM; const bf16* gb2 = gb + (size_t)i * 64 * CONV_DIM;
        xq[i] = *(const GAS v4u*)gx2; if (i < PDC) { bq[i][0] = *(const GAS v4u*)gb2; bq[i][1] = *(const GAS v4u*)(gb2 + CONV_DIM); cq[i][0] = bq[i][0]; cq[i][1] = bq[i][1]; }
        if (FULL && i < PDC) { cq[i][0] = *(const GAS v4u*)(gb2 + 512); cq[i][1] = *(const GAS v4u*)(gb2 + CONV_DIM + 512); } }
    auto chunk = [&](const int ck, v4u& xn, v4u (&bn)[2], v4u (&cn)[2]) __attribute__((always_inline)) {
        const v4u xr = xn, br0 = bn[0], br1 = bn[1], cr0 = cn[0], cr1 = cn[1];
        const int oXW = (!FULL && (ck & 1)) ? L_CS : L_XW, oBT = (!FULL && (ck & 1)) ? L_GS : L_BT;
        const int cb4 = 256 * ck;
        const float abase = ck ? AT[64 * ck - 1] : 0.f, acend = AT[64 * ck + 63];
        {   const unsigned* xw_ = (const unsigned*)&xr; const float wr_ = DTT[64 * ck + rx] * __expf((FULL ? acend : aend) - AT[64 * ck + rx]);
#pragma unroll
            for (int j = 0; j < 8; ++j) { const unsigned short xb = (unsigned short)((j & 1) ? (xw_[j >> 1] >> 16) : (xw_[j >> 1] & 0xffffu));
                if (FULL) *(LAS unsigned short*)(L + L_XT + sXT + j * PS * 2) = xb;
                *(LAS unsigned short*)(L + oXW + sXT + j * PS * 2) = bf1(wr_ * pg8::bf2f(xb)); }
        }
        {   const unsigned* b0 = (const unsigned*)&br0; const unsigned* b1 = (const unsigned*)&br1;
            if (FULL) { *(LAS v4u*)(L + L_BS + sBR) = br0; *(LAS v4u*)(L + L_BS + sBR + PC * 2) = br1; }
#pragma unroll
            for (int j = 0; j < 8; ++j) { const unsigned lo = (j & 1) ? (b0[j >> 1] >> 16) : (b0[j >> 1] & 0xffffu), hi_ = (j & 1) ? (b1[j >> 1] & 0xffff0000u) : (b1[j >> 1] << 16);
                *(LAS unsigned*)(L + oBT + sBT + j * PS * 2) = lo | hi_; }
        }
        if (FULL) { *(LAS v4u*)(L + L_CS + sBR) = cr0; *(LAS v4u*)(L + L_CS + sBR + PC * 2) = cr1; }
        __syncthreads();
        if (ck + PD < 32) {
            const bf16* gx2 = gx + (size_t)(ck + PD) * 64 * CONV_DIM; const bf16* gb2 = gb + (size_t)(ck + PD) * 64 * CONV_DIM;
            xn = *(const GAS v4u*)gx2; (void)gb2;
        }
        if (ck + PDC < 32) { const bf16* gb3 = gb + (size_t)(ck + PDC) * 64 * CONV_DIM; bn[0] = *(const GAS v4u*)gb3; bn[1] = *(const GAS v4u*)(gb3 + CONV_DIM); if (FULL) { cn[0] = *(const GAS v4u*)(gb3 + 512); cn[1] = *(const GAS v4u*)(gb3 + CONV_DIM + 512); } }
        const float etot = FULL ? __expf(acend - abase) : 1.0f;
        if (FULL && VAR != 2) {
            const f32x4 cst = *(const LAS f32x4*)(L + L_AT + cb4 + sT);
            bf16x8 ca[4];
#pragma unroll
            for (int k = 0; k < 4; ++k) ca[k] = *(const LAS bf16x8*)(L + L_CS + fPCt + 64 * k);
            {
                bf16x8 bb[2][4];
#pragma unroll
                for (int k = 0; k < 4; ++k) { bb[0][k] = *(const LAS bf16x8*)(L + L_BS + fPCh + 64 * k); bb[1][k] = *(const LAS bf16x8*)(L + L_BS + fPCh + (16 * PC) * 2 + 64 * k); }
                const float css0 = *(const LAS float*)(L + L_AT + cb4 + sS), css1 = *(const LAS float*)(L + L_AT + cb4 + sS + 64), dts0 = *(const LAS float*)(L + L_DT + cb4 + sS), dts1 = *(const LAS float*)(L + L_DT + cb4 + sS + 64);
                f32x4 g0 = (f32x4){0.f, 0.f, 0.f, 0.f}, g1 = g0;
#pragma unroll
                for (int k = 0; k < 4; ++k) { g0 = __builtin_amdgcn_mfma_f32_16x16x32_bf16(ca[k], bb[0][k], g0, 0, 0, 0); g1 = __builtin_amdgcn_mfma_f32_16x16x32_bf16(ca[k], bb[1][k], g1, 0, 0, 0); }
                const int s0 = 32 * hb + l15, t0 = 16 * tb + 4 * quad;
#pragma unroll
                for (int r = 0; r < 4; ++r) {
                    const float v0 = (s0 <= t0 + r) ? g0[r] * __expf(cst[r] - css0) * dts0 : 0.f, v1 = (s0 + 16 <= t0 + r) ? g1[r] * __expf(cst[r] - css1) * dts1 : 0.f;
                    *(LAS unsigned short*)(L + L_GS + wTP + (r * PS) * 2) = bf1(v0); *(LAS unsigned short*)(L + L_GS + wTP + (r * PS + 16) * 2) = bf1(v1); }
            }
            if (VAR != 1) __syncthreads();
            {
                bf16x8 hs[2][4], ga[2], xa[2][2]; v2u xv[2];
#pragma unroll
                for (int k = 0; k < 4; ++k) { hs[0][k] = *(const LAS bf16x8*)(L + L_HS + fPCh + 64 * k); hs[1][k] = *(const LAS bf16x8*)(L + L_HS + fPCh + (16 * PC) * 2 + 64 * k); }
#pragma unroll
                for (int k = 0; k < 2; ++k) { ga[k] = *(const LAS bf16x8*)(L + L_GS + fPSt + 64 * k); xa[0][k] = *(const LAS bf16x8*)(L + L_XT + xfo[0][k]); xa[1][k] = *(const LAS bf16x8*)(L + L_XT + xfo[1][k]); }
                xv[0] = *(const LAS v2u*)(L + L_XT + xe[0]); xv[1] = *(const LAS v2u*)(L + L_XT + xe[1]);
                f32x4 y0 = (f32x4){0.f, 0.f, 0.f, 0.f}, y1 = y0;
#pragma unroll
                for (int k = 0; k < 4; ++k) { y0 = __builtin_amdgcn_mfma_f32_16x16x32_bf16(ca[k], hs[0][k], y0, 0, 0, 0); y1 = __builtin_amdgcn_mfma_f32_16x16x32_bf16(ca[k], hs[1][k], y1, 0, 0, 0); }
#pragma unroll
                for (int r = 0; r < 4; ++r) { const float e = __expf(cst[r] - abase); y0[r] *= e; y1[r] *= e; }
#pragma unroll
                for (int k = 0; k < 2; ++k) { y0 = __builtin_amdgcn_mfma_f32_16x16x32_bf16(ga[k], xa[0][k], y0, 0, 0, 0); y1 = __builtin_amdgcn_mfma_f32_16x16x32_bf16(ga[k], xa[1][k], y1, 0, 0, 0); }
#pragma unroll
                for (int r = 0; r < 4; ++r) {
                    const unsigned w0 = (r & 2) ? xv[0].y : xv[0].x, w1 = (r & 2) ? xv[1].y : xv[1].x;
                    const float x0 = (r & 1) ? pg8::bfhi(w0) : pg8::bflo(w0), x1 = (r & 1) ? pg8::bfhi(w1) : pg8::bflo(w1);
                    *(LAS unsigned short*)(L + L_YS + wTP + (r * PS) * 2) = bf1(y0[r] + dsk * x0); *(LAS unsigned short*)(L + L_YS + wTP + (r * PS + 16) * 2) = bf1(y1[r] + dsk * x1); }
            }
        }
        {
            bf16x8 xw[4][2], bt[2];
#pragma unroll
            for (int k = 0; k < 2; ++k) { bt[k] = *(const LAS bf16x8*)(L + oBT + bto[k]);
#pragma unroll
                for (int pb = 0; pb < 4; ++pb) xw[pb][k] = *(const LAS bf16x8*)(L + oXW + xwo[pb][k]); }
#pragma unroll
            for (int pb = 0; pb < 4; ++pb)
#pragma unroll
                for (int r = 0; r < 4; ++r) hacc[pb][r] *= etot;
#pragma unroll
            for (int k = 0; k < 2; ++k)
#pragma unroll
                for (int pb = 0; pb < 4; ++pb) hacc[pb] = __builtin_amdgcn_mfma_f32_16x16x32_bf16(xw[pb][k], bt[k], hacc[pb], 0, 0, 0);
        }
        if (FULL && VAR != 1) __syncthreads();
        if (FULL) {
            { const v4u v = *(const LAS v4u*)(L + L_YS + yRD); *(GAS v4u*)(YB + (size_t)(sg * 2048 + 64 * ck + 8 * wave + (lane >> 3)) * D_INNER + 64 * h + 8 * (lane & 7)) = v; }
#pragma unroll
            for (int pb = 0; pb < 4; ++pb)
#pragma unroll
                for (int r = 0; r < 4; ++r) *(LAS unsigned short*)(L + L_HS + wHS + ((16 * pb + r) * PC) * 2) = bf1(hacc[pb][r]);
        }
    };
#pragma unroll 1
    for (int ck2 = 0; ck2 < nck; ck2 += PD) { chunk(ck2, xq[0], bq[0], cq[0]); chunk(ck2 + 1, xq[1], bq[1 % PDC], cq[1 % PDC]); if (PD >= 4) { chunk(ck2 + 2, xq[2 % PD], bq[2 % PDC], cq[2 % PDC]); chunk(ck2 + 3, xq[3 % PD], bq[3 % PDC], cq[3 % PDC]); }
        if (PD >= 8) { chunk(ck2 + 4, xq[4 % PD], bq[4 % PDC], cq[4 % PDC]); chunk(ck2 + 5, xq[5 % PD], bq[5 % PDC], cq[5 % PDC]); chunk(ck2 + 6, xq[6 % PD], bq[6 % PDC], cq[6 % PDC]); chunk(ck2 + 7, xq[7 % PD], bq[7 % PDC], cq[7 % PDC]); } }
    if (!FULL) {
        float* sp = SSEG + (((size_t)sg * SSD_H + h) * SSD_P) * SSD_N + ncol;
#pragma unroll
        for (int pb = 0; pb < 4; ++pb)
#pragma unroll
            for (int r = 0; r < 4; ++r) sp[(size_t)(16 * pb + 4 * quad + r) * SSD_N] = hacc[pb][r];
        if (wave == 0 && lane == 0) DSEG[sg * SSD_H + h] = __expf(aend);
    } else if (sg == 7) {
        float* sp = ssm_out + ((size_t)h * SSD_P) * SSD_N + ncol;
#pragma unroll
        for (int pb = 0; pb < 4; ++pb)
#pragma unroll
            for (int r = 0; r < 4; ++r) sp[(size_t)(16 * pb + 4 * quad + r) * SSD_N] = hacc[pb][r];
    }
    __syncthreads();
}
}
__device__ __forceinline__ void ssd_passA_phase(Frame& F) {
    REFRESH(F);
    ssd_sample_rec(F);
    __syncthreads();
#ifdef MK_PROBE_SREC
    ssd_sample_rec(F);
    __syncthreads();
#endif
    for (int un = F.vcu; un < SSD_H * 7; un += F.G) {
        ssd::ssd_unit<false>(F, un & 31, un >> 5, (const bf16*)(kws() + WS_XBC), (const float*)(kws() + WS_DT), (bf16*)(kws() + WS_YB), (float*)(kws() + WS_SSEG), (float*)(kws() + WS_DSEG), kout() + O_SP, kin(18), kin(19), kin(21), kin(22));
    }
}
__device__ __forceinline__ void ssd_passB_phase(Frame& F) {
    REFRESH(F);
#ifdef MK_PROBE_LOOP
    int reps_ = MK_PROBE_LOOP; asm volatile("" : "+s"(reps_));
#pragma unroll 1
    for (int rep_ = 0; rep_ < reps_; ++rep_)
    for (int un = F.vcu; un < SSD_H * 8; un += F.G)
        ssd::ssd_unit<true>(F, un & 31, un >> 5, (const bf16*)(kws() + WS_XBC), (const float*)(kws() + WS_DT), (bf16*)(kws() + WS_YB), (float*)(kws() + WS_SSEG), (float*)(kws() + WS_DSEG), kout() + O_SP, kin(18), kin(19), kin(21), kin(22), rep_ == reps_ - 1 ? 32 : 0);
#else
    for (int un = F.vcu; un < SSD_H * 8; un += F.G)
        ssd::ssd_unit<true>(F, un & 31, un >> 5, (const bf16*)(kws() + WS_XBC), (const float*)(kws() + WS_DT), (bf16*)(kws() + WS_YB), (float*)(kws() + WS_SSEG), (float*)(kws() + WS_DSEG), kout() + O_SP, kin(18), kin(19), kin(21), kin(22));
#endif
}

namespace pg8 {
struct PanelStats {
    unsigned* xbuf;
    unsigned* cnt;
    unsigned* tmo;
    int ntn; float eps;
    unsigned code;
    __device__ __forceinline__ bool run(const f32x4 (&v)[2][2][4][2], const Unit& u, int wr, int wc, int fr, int fq, PG8_LAS unsigned char* lds, int wid, int lane) const {
        typedef float f32x2v __attribute__((ext_vector_type(2)));
        PG8_LAS f32x2v* P = (PG8_LAS f32x2v*)lds;
        PG8_LAS f32x2v* S = (PG8_LAS f32x2v*)(lds + 8192);
        PG8_LAS unsigned* flag = (PG8_LAS unsigned*)(lds + 8192 + 2048);
#pragma unroll
        for (int ai = 0; ai < 2; ++ai)
#pragma unroll
            for (int m = 0; m < 4; ++m) {
                float s = 0.f;
#pragma unroll
                for (int bj = 0; bj < 2; ++bj)
#pragma unroll
                    for (int n = 0; n < 2; ++n) { const f32x4 x = v[ai][bj][m][n]; s += (x[0] + x[1]) + (x[2] + x[3]); }
                s += __shfl_xor(s, 16); s += __shfl_xor(s, 32);
                const float mw = s * (1.0f / 64.0f); float q = 0.f;
#pragma unroll
                for (int bj = 0; bj < 2; ++bj)
#pragma unroll
                    for (int n = 0; n < 2; ++n) { const f32x4 d = v[ai][bj][m][n] - mw; q += (d[0] * d[0] + d[1] * d[1]) + (d[2] * d[2] + d[3] * d[3]); }
                q += __shfl_xor(q, 16); q += __shfl_xor(q, 32);
                if (fq == 0) P[(ai * HALF + wr * 64 + m * 16 + fr) * 4 + wc] = (f32x2v){mw, q};
            }
        asm volatile("s_waitcnt lgkmcnt(0)" ::: "memory"); __builtin_amdgcn_s_barrier(); asm volatile("" ::: "memory");
        const int row = wid * 32 + (lane & 31);
        if (lane < 32) {
            const f32x2v a = P[row * 4 + 0], b = P[row * 4 + 1], c = P[row * 4 + 2], d = P[row * 4 + 3];
            const float mt = (a.x + b.x + c.x + d.x) * 0.25f;
            const float da = a.x - mt, db = b.x - mt, dc = c.x - mt, dd = d.x - mt;
            const float m2 = (a.y + b.y) + (c.y + d.y) + 64.0f * ((da * da + db * db) + (dc * dc + dd * dd));
            unsigned long long* slot = (unsigned long long*)xbuf + ((size_t)(u.pm * BM + row) * 4 + u.pn);
            __hip_atomic_store(slot, ((unsigned long long)__float_as_uint(m2) << 32) | __float_as_uint(mt), __ATOMIC_RELAXED, __HIP_MEMORY_SCOPE_AGENT);
        }
        asm volatile("s_waitcnt vmcnt(0)" ::: "memory");
        if (lane == 0) __hip_atomic_fetch_add(cnt + 64 * u.pm, 1u, __ATOMIC_RELAXED, __HIP_MEMORY_SCOPE_AGENT);
        if (wid == 0) {
            const unsigned want = 8u * (unsigned)ntn;
            while ((unsigned)__builtin_amdgcn_readfirstlane(__hip_atomic_load(cnt + 64 * u.pm, __ATOMIC_RELAXED, __HIP_MEMORY_SCOPE_AGENT)) < want) __builtin_amdgcn_s_sleep(2);
            __builtin_amdgcn_fence(__ATOMIC_ACQUIRE, "agent");
        }
        asm volatile("s_waitcnt vmcnt(0) lgkmcnt(0)" ::: "memory"); __builtin_amdgcn_s_barrier(); asm volatile("" ::: "memory");
        if (lane < 32) {
            const unsigned long long* slot = (const unsigned long long*)xbuf + (size_t)(u.pm * BM + row) * 4; float mt[4], m2[4]; float ms = 0.f;
#pragma unroll
            for (int t = 0; t < 4; ++t) { if (t < ntn) { const unsigned long long w = __hip_atomic_load(slot + t, __ATOMIC_RELAXED, __HIP_MEMORY_SCOPE_AGENT); mt[t] = __uint_as_float((unsigned)w); m2[t] = __uint_as_float((unsigned)(w >> 32)); } else { mt[t] = 0.f; m2[t] = 0.f; } ms += mt[t]; }
            const float mean = ms / (float)ntn; float q = 0.f;
#pragma unroll
            for (int t = 0; t < 4; ++t) if (t < ntn) { const float dm = mt[t] - mean; q += m2[t] + 256.0f * dm * dm; }
            S[row] = (f32x2v){mean, 1.0f / sqrtf(q / (256.0f * (float)ntn) + mean * mean + eps)};
        }
        asm volatile("s_waitcnt lgkmcnt(0)" ::: "memory"); __builtin_amdgcn_s_barrier(); asm volatile("" ::: "memory");
        return false;
    }
};

template <int WHICH> struct EpiResGateNorm {
    static constexpr bool PERM = false, AFTER_DRAIN = true;
    static constexpr int CHUNK = WHICH == 0 ? 2 : (WHICH == 1 ? 5 : 8), CSH = WHICH == 0 ? 3 : 6; static constexpr bool FINAL = WHICH == 2;
    __device__ __forceinline__ void fused(f32x4 (&acc)[2][2][4][2], const Unit& u, int wr, int wc, int fr_in, int fq_in, PG8_LAS unsigned char* lds, int wid, int lane_in) const {
        const int ln_ = lane_now(); const int fr = ln_ & 15, fq = ln_ >> 4; (void)fr_in; (void)fq_in; (void)lane_in;
        typedef float f32x2v __attribute__((ext_vector_type(2))); typedef unsigned u32x2v __attribute__((ext_vector_type(2)));
        const float gsc = WHICH == 1 ? 1.0f : 0.5f;
        const int col0 = u.pn * BM + wc * 32 + 4 * fq;
        {
            const float* xp = ::kin(0); float* X = ::kout() + ::O_Y; bf16_t* XB = (bf16_t*)(::kws() + ::WS_XB); const float* gp = (const float*)(::kws() + ::WS_MOD) + CHUNK * 1024;
            f32x4 gt[2][2];
#pragma unroll
            for (int bj = 0; bj < 2; ++bj)
#pragma unroll
                for (int n = 0; n < 2; ++n) gt[bj][n] = (*(const f32x4*)(gp + col0 + bj * HALF + n * 16) + 1.0f) * gsc;
            typedef typename std::conditional<WHICH == 0, f32x4, u32x2v>::type RawT;
            RawT bs[3][2][2];
#pragma unroll
            for (int p = 0; p < 2; ++p) { const size_t off = (size_t)(u.pm * BM + (p >> 2) * HALF + wr * 64 + (p & 3) * 16 + fr) * DM_ + col0;
#pragma unroll
                for (int bj = 0; bj < 2; ++bj)
#pragma unroll
                    for (int n = 0; n < 2; ++n) { if constexpr (WHICH == 0) bs[p][bj][n] = *(const f32x4*)(xp + off + bj * HALF + n * 16); else bs[p][bj][n] = *(const u32x2v*)(XB + off + bj * HALF + n * 16); } }
#pragma unroll
            for (int grp = 0; grp < 8; ++grp) {
                const int ai = grp >> 2, m = grp & 3;
                if (grp + 2 < 8) { const int g2 = grp + 2; const size_t off2 = (size_t)(u.pm * BM + (g2 >> 2) * HALF + wr * 64 + (g2 & 3) * 16 + fr) * DM_ + col0;
#pragma unroll
                    for (int bj = 0; bj < 2; ++bj)
#pragma unroll
                        for (int n = 0; n < 2; ++n) { if constexpr (WHICH == 0) bs[g2 % 3][bj][n] = *(const f32x4*)(xp + off2 + bj * HALF + n * 16); else bs[g2 % 3][bj][n] = *(const u32x2v*)(XB + off2 + bj * HALF + n * 16); } }
                const size_t off = (size_t)(u.pm * BM + ai * HALF + wr * 64 + m * 16 + fr) * DM_ + col0;
#pragma unroll
                for (int bj = 0; bj < 2; ++bj)
#pragma unroll
                    for (int n = 0; n < 2; ++n) { f32x4 b_; if constexpr (WHICH == 0) b_ = bs[grp % 3][bj][n]; else { const u32x2v r_ = bs[grp % 3][bj][n]; b_ = (f32x4){bflo(r_.x), bfhi(r_.x), bflo(r_.y), bfhi(r_.y)}; }
                        acc[ai][bj][m][n] = b_ + gt[bj][n] * acc[ai][bj][m][n];
                        if (!FINAL) { const f32x4 o_ = acc[ai][bj][m][n]; u32x2v w_; w_.x = cvt_pk_bf16(o_[0], o_[1]); w_.y = cvt_pk_bf16(o_[2], o_[3]); *(u32x2v*)(XB + off + bj * HALF + n * 16) = w_; } }
                if (FINAL) asm volatile("" : "+v"(acc[ai][0][m][0]), "+v"(acc[ai][0][m][1]), "+v"(acc[ai][1][m][0]), "+v"(acc[ai][1][m][1]));
                __builtin_amdgcn_sched_barrier(0);
            }
        }
        { PanelStats st{(unsigned*)(::kws() + ::WS_XCH + (size_t)WHICH * 512 * 1024), (unsigned*)(::kws() + ::WS_CTL) + ::CW_SEAM + WHICH * ::SEAM_BANK, (unsigned*)(::kws() + ::WS_CTL), 4, ::EPS, 0x700u + 0x40u * WHICH};
          (void)st.run(acc, u, wr, wc, fr, fq, lds, wid, ln_); }
        const PG8_LAS f32x2v* S = (const PG8_LAS f32x2v*)(lds + 8192);
        {
            const int l2_ = lane_now(); const int fr = l2_ & 15, fq = l2_ >> 4; const int col0 = u.pn * BM + wc * 32 + 4 * fq;
            const float* gvec = ::kin(WHICH == 0 ? 15 : (WHICH == 1 ? 27 : 31)); const float* sh = (const float*)(::kws() + ::WS_MOD) + CSH * 1024; const float* scl = sh + 1024;
            float* X = ::kout() + ::O_Y; bf16_t* HN = (bf16_t*)(::kws() + ::WS_HN);
            f32x4 ca_[2][2], cb_[2][2];
#pragma unroll
            for (int bj = 0; bj < 2; ++bj)
#pragma unroll
                for (int n = 0; n < 2; ++n) { const int c = col0 + bj * HALF + n * 16; ca_[bj][n] = *(const f32x4*)(gvec + c); cb_[bj][n] = (f32x4){0.f, 0.f, 0.f, 0.f};
                    if (!FINAL) { ca_[bj][n] = ca_[bj][n] * (*(const f32x4*)(scl + c) + 1.0f); cb_[bj][n] = *(const f32x4*)(sh + c); } }
#pragma unroll
            for (int ai = 0; ai < 2; ++ai)
#pragma unroll
                for (int m = 0; m < 4; ++m) {
                    const int r = ai * HALF + wr * 64 + m * 16 + fr; const float rstd = S[r].y; const size_t off = (size_t)(u.pm * BM + r) * DM_ + col0;
#pragma unroll
                    for (int bj = 0; bj < 2; ++bj)
#pragma unroll
                        for (int n = 0; n < 2; ++n) { const int c = bj * HALF + n * 16; const f32x4 o = acc[ai][bj][m][n] * rstd * ca_[bj][n] + cb_[bj][n];
                            if (!FINAL) { u32x2v w; w.x = cvt_pk_bf16(o[0], o[1]); w.y = cvt_pk_bf16(o[2], o[3]); *(u32x2v*)(HN + off + c) = w; }
                            else *(f32x4*)(X + off + c) = o; }
                    __builtin_amdgcn_sched_barrier(0);
                }
        }
    }
};
}
constexpr int N_PHASES = 18;
#ifndef MK_N_LAUNCHES
#define MK_N_LAUNCHES 1
#endif
constexpr int N_LAUNCHES = MK_N_LAUNCHES;
struct Args { const float* in[32]; float* out; unsigned char* ws; int ph_lo, ph_hi, li, pad; };
__global__ void __launch_bounds__(NWAVES * 64, 2) mk_fwd(Args args) {
    extern __shared__ __attribute__((aligned(16))) unsigned char lds[];
    Frame F;
    F.lds = (LAS unsigned char*)lds; F.MISC = (volatile LAS unsigned*)(F.lds + MISC_OFF);
    F.wave = __builtin_amdgcn_readfirstlane((int)threadIdx.x >> 6); REFRESH(F);
#ifdef MK_FENCES
    __builtin_amdgcn_fence(__ATOMIC_ACQUIRE, "agent"); asm volatile("s_waitcnt vmcnt(0)" ::: "memory");
#endif
    F.G = gridDim.x; { const int bx = blockIdx.x; F.vcu = (F.G % 8 == 0) ? (bx % 8) * (F.G / 8) + bx / 8 : bx; }
    F.ctl = (gu32*)(args.ws + WS_CTL);
    for (int u = F.tid; u < (LDS_BYTES - LDSCTL_OFF) / 4; u += NWAVES * 64) ((LAS unsigned*)(F.lds + LDSCTL_OFF))[u] = 0u;
    __syncthreads();
    XcdBarrier bar; bar.wave = F.wave; bar.bar = (unsigned*)(F.ctl + CW_BAR); bar.x = 0; bar.st = nullptr;
    if (N_LAUNCHES == 1) bar = xcd_barrier_post((unsigned*)(F.ctl + CW_BAR), F.MISC + 8, F.wave);
    const int lo = args.ph_lo, hi = args.ph_hi;
#ifndef PH_MASK
#define PH_MASK 0xFFFFFFFFu
#endif
#define IN(k) (((PH_MASK >> (k)) & 1u) && lo <= (k) && (k) < hi)
#define SEAM(k) do { if (IN(k) && IN((k) + 1)) xcd_barrier(bar); } while (0)
#ifndef MK_DOUBLE_MASK
#define MK_DOUBLE_MASK 0u
#endif
#define REPS(k) (1 + (int)((MK_DOUBLE_MASK >> (k)) & 1u))
#define PHASE(k) for (int rp_ = 0, nreps_ = (IN(k) ? REPS(k) : 0); rp_ < nreps_; ++rp_, (rp_ < nreps_ ? xcd_barrier(bar) : (void)0))
#define WSP(T, off) ((T*)(kws() + (off)))
#define ACT1P ((bf16*)(kout() + O_KP))
#define XP (kout() + O_Y)
#ifdef MK_PROBE_NOSK
#define SKINNY_ON (rp_ + 1 == nreps_)
#else
#define SKINNY_ON true
#endif
#define GEMM_RUN_P(EPI, g, E) do { pg8::Gemm gp_ = g; gp_.M = MP; pg8::StaticOrder S; S.init(MP, D, F.G, (int)blockIdx.x); pg8::gemm_phase<EPI, pg8::StaticOrder, true, true>(F.lds + RING_OFF, gp_, S, E, F.wave); \
        if (SKINNY_ON) skinny_gemm<EPI>(F, g.A, g.lda, g.Bt, g.K, E); } while (0)
#define GEMM_RUN_PN(g, W_, ES) do { pg8::Gemm gp_ = g; gp_.M = MP; pg8::StaticOrder S; S.init(MP, D, F.G, (int)blockIdx.x); pg8::EpiResGateNorm<W_> EN; pg8::gemm_phase<pg8::EpiResGateNorm<W_>, pg8::StaticOrder, false, true>(F.lds + RING_OFF, gp_, S, EN, F.wave); __syncthreads();     \
        skinny_gemm<pg8::EpiResGate>(F, g.A, g.lda, g.Bt, g.K, ES); } while (0)
#define GEMM_RUN(EPI, g, N_, E) do { pg8::StaticOrder65 S; S.init((N_), F.G, (int)blockIdx.x); pg8::gemm_phase<EPI, pg8::StaticOrder65, true, true>(F.lds + RING_OFF, g, S, E, F.wave); } while (0)
    PHASE(0) { p0_prologue<false>(F); } SEAM(0);
    PHASE(1) { norm_phase(F, kin(0), kin(1), kin(11), 0, WSP(bf16, WS_HN)); } SEAM(1);
    PHASE(2) { pg8::Gemm g{WSP(bf16, WS_HN), WSP(const bf16, WS_W13A), MT, 2 * FF, D, D}; pg8::EpiSwiGLU E{ACT1P, FF}; GEMM_RUN(pg8::EpiSwiGLU, g, 2 * FF, E); } SEAM(2);
    PHASE(3) { pg8::Gemm g{ACT1P, WSP(const bf16, WS_W2A), MT, D, FF, FF}; pg8::EpiResGate E{kin(0), kin(1), XP, WSP(float, WS_MOD), 2, 0.5f}; if (F.G == 256) GEMM_RUN_PN(g, 0, E); else GEMM_RUN_P(pg8::EpiResGate, g, E); } SEAM(3);
    PHASE(4) { norm_phase(F, XP, XP + (size_t)MP * D, kin(15), 3, WSP(bf16, WS_HN), F.G == 256 ? MP : 0); } SEAM(4);
    PHASE(5) { pg8::Gemm g{WSP(bf16, WS_HN), WSP(const bf16, WS_WIN1), MT, N_I1, D, D};
        static_assert(WS_KB - WS_QO == WS_VB - WS_KB, "Q | K | V copies equally spaced");
        pg8::EpiI1 E{WSP(bf16, WS_QO), (size_t)(WS_KB - WS_QO) / 2, WSP(bf16, WS_XBC), kout(), WSP(float, WS_DT), kin(17), kin(20), 0.125f * LOG2E, WSP(bf16, WS_HALO), O_KP, O_LP, O_CP, O_KS, O_VP - O_KP, O_VS - O_KS, O_LS, O_CS};
        GEMM_RUN(pg8::EpiI1, g, N_I1, E); } SEAM(5);
    PHASE(6) { fcum_halo_phase(F); conv_phase(F); qknorm_phase(F); p0_prologue<true>(F); } SEAM(6);
    PHASE(7) {
        const attn_body::AttnTensors AT{WSP(const attn_body::bf16, WS_QO), WSP(const attn_body::bf16, WS_KB), WSP(const attn_body::bf16, WS_VB), WSP(attn_body::bf16, WS_QO), WSP(const float, WS_F2)};
        const attn_body::StaticOrder S((int)F.G, (int)blockIdx.x);
#ifdef MK_PROBE_ATTN
        { const attn_body::AttnTensors AT2{AT.Q, AT.K, AT.V, (attn_body::bf16*)(kws() + 9 * MiB), AT.F2}; attn_body::attn_phase<attn_body::StaticOrder>((char*)lds + RING_OFF, AT2, S, F.wave); xcd_barrier(bar); }
#endif
        (void)S; { const attn_body::AttnQueue AQ{(const float*)(kws() + WS_CTL) + CW_KQ, (unsigned*)(kws() + WS_CTL) + CW_TICKET}; attn_body::attn_phase_queue<8>((char*)lds + RING_OFF, AT, AQ, F.wave); }
        __syncthreads();
#ifdef MK_PROBE_SATTN
        attn_sample_phase(F, (bf16*)(kws() + WS_W13A) - (size_t)MP * D);
#endif
        attn_sample_phase(F);
    } SEAM(7);
    PHASE(8) { ssd_passA_phase(F); } SEAM(8);
    PHASE(9) { ssd_passB_phase(F); } SEAM(9);
    PHASE(10) { pg8::Gemm g{WSP(bf16, WS_HN), WSP(const bf16, WS_WIN2), MT, N_I2, D, D}; pg8::EpiI2 E{WSP(bf16, WS_YB), WSP(bf16, WS_GATE), WSP(float, WS_SSQ)}; { pg8::StaticOrder S; S.init(MP, N_I2, F.G, (int)blockIdx.x); pg8::gemm_phase<pg8::EpiI2, pg8::StaticOrder, true, true>(F.lds + RING_OFF, g, S, E, F.wave); } skinny_gemm<pg8::EpiI2>(F, g.A, g.lda, g.Bt, g.K, E, N_I2 / 32);     } SEAM(10);
    PHASE(11) { ssq_sample_pass(F); pg8::Gemm g{WSP(bf16, WS_QO), WSP(const bf16, WS_WA), MT, D, D, D}; pg8::EpiOA E{WSP(bf16, WS_MA), WSP(const bf16, WS_GATE)}; GEMM_RUN_P(pg8::EpiOA, g, E); } SEAM(11);
    PHASE(12) { pg8::Gemm g{WSP(bf16, WS_YB), WSP(const bf16, WS_WS), MT, D, D_INNER, D_INNER}; pg8::EpiOS E{WSP(bf16, WS_MERGED), WSP(const bf16, WS_MA), WSP(const bf16, WS_GATE), WSP(const float, WS_SSQ), EPS}; GEMM_RUN_P(pg8::EpiOS, g, E); } SEAM(12);
    PHASE(13) { pg8::Gemm g{WSP(bf16, WS_MERGED), WSP(const bf16, WS_WO), MT, D, D, D}; pg8::EpiResGate E{XP, XP + (size_t)MP * D, XP, WSP(float, WS_MOD), 5, 1.0f}; if (F.G == 256) GEMM_RUN_PN(g, 1, E); else GEMM_RUN_P(pg8::EpiResGate, g, E); } SEAM(13);
    PHASE(14) { norm_phase(F, XP, XP + (size_t)MP * D, kin(27), 6, WSP(bf16, WS_HN), F.G == 256 ? MP : 0); } SEAM(14);
    PHASE(15) { pg8::Gemm g{WSP(bf16, WS_HN), WSP(const bf16, WS_W13B), MT, 2 * FF, D, D}; pg8::EpiSwiGLU E{WSP(bf16, WS_ACT2), FF}; GEMM_RUN(pg8::EpiSwiGLU, g, 2 * FF, E); } SEAM(15);
    PHASE(16) { pg8::Gemm g{WSP(bf16, WS_ACT2), WSP(const bf16, WS_W2B), MT, D, FF, FF}; pg8::EpiResGate E{XP, XP + (size_t)MP * D, XP, WSP(float, WS_MOD), 8, 0.5f}; if (F.G == 256) GEMM_RUN_PN(g, 2, E); else GEMM_RUN_P(pg8::EpiResGate, g, E); } SEAM(16);
    PHASE(17) { final_norm_phase(F, XP, kin(31), F.G == 256 ? MP : 0); }
#ifdef MK_DUMP_OFF
    if (lo == 99) {
        REFRESH(F); const bf16* s = (const bf16*)(kws() + (size_t)(MK_DUMP_OFF)); float* d = kout();
        for (size_t i = (size_t)blockIdx.x * 512 + F.tid; i < (size_t)(MK_DUMP_ROWS) * (MK_DUMP_COLS); i += (size_t)gridDim.x * 512) { const size_t r = i / (MK_DUMP_COLS), c = i % (MK_DUMP_COLS); d[i] = pg8::bf2f(s[r * (MK_DUMP_PITCH) + c]); }
    }
#endif
#ifdef MK_FENCES
    asm volatile("s_waitcnt vmcnt(0)" ::: "memory"); __builtin_amdgcn_fence(__ATOMIC_RELEASE, "agent"); asm volatile("s_waitcnt vmcnt(0)" ::: "memory");
#endif
#undef IN
#undef SEAM
}

extern "C" void kernel_launch(void* const* d_in, const int* in_sizes, int n_in, void* d_out, int out_size, void* d_ws, size_t ws_size, hipStream_t stream) {
    static int grid = 0;
    if (grid == 0) {
        if (n_in != 32 || out_size != (int)O_END || ws_size < WS_END) { fprintf(stderr, "kernel_launch: unexpected shapes (n_in %d, out %d, ws %zu); nothing launched\n", n_in, out_size, ws_size); grid = -1; return; }
        int dev = 0, cus = 0, per_cu = 0;
        if (hipGetDevice(&dev) != hipSuccess || hipDeviceGetAttribute(&cus, hipDeviceAttributeMultiprocessorCount, dev) != hipSuccess) { grid = -1; return; }
        if (hipFuncSetAttribute((const void*)mk_fwd, hipFuncAttributeMaxDynamicSharedMemorySize, LDS_BYTES) != hipSuccess) { fprintf(stderr, "kernel_launch: hipFuncSetAttribute failed\n"); grid = -1; return; }
        if (hipOccupancyMaxActiveBlocksPerMultiprocessor(&per_cu, (const void*)mk_fwd, NWAVES * 64, LDS_BYTES) != hipSuccess || per_cu < 1)
            fprintf(stderr, "kernel_launch: note: occupancy query reports %d workgroups per CU\n", per_cu);
        (void)hipGetLastError();
        grid = cus;
        if (grid % 16 != 0) { fprintf(stderr, "kernel_launch: %d CUs: the attention deal needs a multiple of 16\n", grid); }
    }
    if (grid < 0) return;
    if (hipMemsetAsync((char*)d_ws + WS_CTL, 0, CTL_ZERO_BYTES, stream) != hipSuccess) return;
    Args a{};
    for (int i = 0; i < 32; ++i) a.in[i] = (const float*)d_in[i];
    a.out = (float*)d_out; a.ws = (unsigned char*)d_ws;
#ifndef MK_LAST_PHASE
#define MK_LAST_PHASE N_PHASES
#endif
    for (int li = 0; li < N_LAUNCHES && li < MK_LAST_PHASE; ++li) {
        a.ph_lo = (N_LAUNCHES == 1) ? 0 : li; a.ph_hi = (N_LAUNCHES == 1) ? N_PHASES : li + 1; a.li = li;
        hipLaunchKernelGGL(mk_fwd, dim3(grid), dim3(NWAVES * 64), LDS_BYTES, stream, a);
        const hipError_t le = hipPeekAtLastError();
        if (le != hipSuccess) { fprintf(stderr, "kernel_launch: launch %d failed: %s\n", li, hipGetErrorName(le)); break; }
    }
#ifdef MK_DUMP_OFF
    a.ph_lo = 99; a.ph_hi = 100; a.li = 99;
    hipLaunchKernelGGL(mk_fwd, dim3(grid), dim3(NWAVES * 64), LDS_BYTES, stream, a);
#endif
}
```

```cpp
#include <hip/hip_runtime.h>
#include <cstdio>
#include <cstdint>
namespace pg8 {
#define PG8_LAS __attribute__((address_space(3)))
typedef unsigned short bf16_t;
typedef short bf16x8 __attribute__((ext_vector_type(8)));
typedef float f32x4 __attribute__((ext_vector_type(4)));
typedef unsigned u32x4 __attribute__((ext_vector_type(4)));
constexpr int BM = 256, BK = 64, HALF = 128, HTB = HALF * BK * 2  , STAGE_BYTES = 8 * HTB, NXCD = 8, WGM = 4;

__host__ __device__ __forceinline__ int lds_byte(int r, int c) { const int st = (r >> 4) * 2 + (c >> 5), rr = r & 15, cc = c & 31, ob = rr * 64 + cc * 2; return st * 1024 + (ob ^ (((ob >> 9) & 1) << 5)); }
__host__ __device__ __forceinline__ void stage_rc(int b, int& R, int& C) { const int st = b / 1024, sb = b % 1024, swz = sb ^ (((sb >> 9) & 1) << 5); R = (st >> 1) * 16 + swz / 64; C = (st & 1) * 32 + (swz % 64) / 2; }
__host__ __device__ __forceinline__ int perm32(int rho) { const int n = rho >> 4, i = rho & 15; return 8 * (i >> 2) + 4 * n + (i & 3); }

struct Unit { int pm, pn; };
struct Gemm { const bf16_t* A; const bf16_t* Bt; int M, N, K, lda; };

struct StaticOrder {
    int nM, nN, nwg, G, c;
    __host__ __device__ void init(int M, int N, int G_, int c_) { nM = M / BM; nN = N / BM; nwg = nM * nN; G = G_; c = c_; }
    __host__ __device__ bool next(int i, Unit& u) const {
        const long L = (long)i * G + c; if (L >= nwg) return false;
        int wgid = (int)L; { const int q = nwg / NXCD, r = nwg % NXCD, xcd = wgid % NXCD, off = wgid / NXCD; wgid = (xcd < r ? xcd * (q + 1) : r * (q + 1) + (xcd - r) * q) + off; }
        const int nig = WGM * nN, gid = wgid / nig, fm = gid * WGM, gsz = (nM - fm) < WGM ? (nM - fm) : WGM;
        u.pm = fm + ((wgid % nig) % gsz); u.pn = (wgid % nig) / gsz; return true;
    }
    __device__ __forceinline__ void a_ready(const Unit&) const {}
    __device__ __forceinline__ void done(const Unit&) const {}
};

struct StaticOrder65 {
    StaticOrder base; int nN, n64, G, c;
    __host__ __device__ void init(int N, int G_, int c_) { base.init(64 * BM, N, G_, c_); nN = N / BM; n64 = 64 * nN; G = G_; c = c_; }
    __host__ __device__ bool next(int i, Unit& u) const {
        const long L = (long)i * G + c;
        if (L < n64) return base.next(i, u);
        if (L < n64 + nN) { u.pm = 64; u.pn = (int)(L - n64); return true; }
        return false;
    }
    __device__ __forceinline__ void a_ready(const Unit&) const {}
    __device__ __forceinline__ void done(const Unit&) const {}
};

typedef float f32x2 __attribute__((ext_vector_type(2))); typedef __bf16 bf16x2v __attribute__((ext_vector_type(2)));
__device__ __forceinline__ unsigned cvt_pk_bf16(float lo, float hi) { f32x2 v = {lo, hi}; return __builtin_bit_cast(unsigned, __builtin_convertvector(v, bf16x2v)); }
constexpr int MP = 16384, MS = 256, MT = MP + MS, DM_ = 1024, NMODC = 9 * 1024;
__device__ __forceinline__ int bidx(int m) { return m < MP ? 0 : 1 + ((m - MP) >> 4); }
__device__ __forceinline__ float sigm(float x) { return __builtin_amdgcn_rcpf(1.f + __builtin_amdgcn_exp2f(-1.4426950408889634f * x)); }
__device__ __forceinline__ float silu(float x) { return x * sigm(x); }
__device__ __forceinline__ float sigm_c(float x, float c) { return __builtin_amdgcn_rcpf(1.f + __builtin_amdgcn_exp2f(c * x)); }
__device__ __forceinline__ float silu_c(float x, float c) { return x * sigm_c(x, c); }
__device__ __forceinline__ float bf2f(unsigned short b) { return __uint_as_float(((unsigned)b) << 16); }
__device__ __forceinline__ float bflo(unsigned w) { return __uint_as_float(w << 16); }
__device__ __forceinline__ float bfhi(unsigned w) { return __uint_as_float(w & 0xffff0000u); }
__device__ __forceinline__ int lane_now() { int l; asm volatile("v_mbcnt_lo_u32_b32 %0, -1, 0\n\tv_mbcnt_hi_u32_b32 %0, -1, %0" : "=v"(l)); return l; }
__device__ __forceinline__ float xor_lane(float v, int ln, int mask) { return __int_as_float(__builtin_amdgcn_ds_bpermute((ln ^ mask) << 2, __float_as_int(v))); }
__device__ __forceinline__ float softplusf_(float x) { return fmaxf(x, 0.f) + 0.6931471805599453f * __builtin_amdgcn_logf(1.0f + __builtin_amdgcn_exp2f(-1.4426950408889634f * fabsf(x))); }

struct EpiSwiGLU {
    static constexpr bool PERM = true, AFTER_DRAIN = false;
    bf16_t* O; int ldc;
    __device__ __forceinline__ void operator()(const f32x4 (&acc)[2][2][4][2], const Unit& u, int wr, int wc, int fr_in, int fq_in) const {
        const int ln_ = lane_now(); const int fr = ln_ & 15, fq = ln_ >> 4; (void)fr_in; (void)fq_in;
        const int row0 = u.pm * BM + wr * 64 + fr, col0 = u.pn * HALF + wc * 32 + 8 * fq;
#pragma unroll
        for (int ai = 0; ai < 2; ++ai)
#pragma unroll
            for (int m = 0; m < 4; ++m) {
                bf16_t* rowp = O + (size_t)(row0 + ai * HALF + m * 16) * ldc + col0;
                const f32x4 a0 = acc[ai][0][m][0], a1 = acc[ai][0][m][1], g0 = acc[ai][1][m][0], g1 = acc[ai][1][m][1];
                u32x4 w;
                w.x = cvt_pk_bf16(silu(a0[0]) * g0[0], silu(a0[1]) * g0[1]); w.y = cvt_pk_bf16(silu(a0[2]) * g0[2], silu(a0[3]) * g0[3]);
                w.z = cvt_pk_bf16(silu(a1[0]) * g1[0], silu(a1[1]) * g1[1]); w.w = cvt_pk_bf16(silu(a1[2]) * g1[2], silu(a1[3]) * g1[3]);
                *(u32x4*)rowp = w;
                asm volatile("" ::: "memory"); __builtin_amdgcn_sched_barrier(0);
            }
    }
};
struct EpiResGate {
    static constexpr bool PERM = false, AFTER_DRAIN = false;
    const float* xp; const float* xs; float* out; const float* mod; int chunk; float gsc;
    __device__ __forceinline__ void elem(int row, int c, float v) const { const float g = mod[(size_t)bidx(row) * NMODC + chunk * 1024 + c]; const float bs = row < MP ? xp[(size_t)row * DM_ + c] : xs[(size_t)(row - MP) * DM_ + c]; out[(size_t)row * DM_ + c] = bs + (g + 1.0f) * gsc * v; }
    __device__ __forceinline__ void operator()(const f32x4 (&acc)[2][2][4][2], const Unit& u, int wr, int wc, int fr_in, int fq_in) const {
        const int ln_ = lane_now(); const int fr = ln_ & 15, fq = ln_ >> 4; (void)fr_in; (void)fq_in;
        const int col0 = u.pn * BM + wc * 32 + 4 * fq;
#pragma unroll
        for (int ai = 0; ai < 2; ++ai)
#pragma unroll
            for (int m = 0; m < 4; ++m) {
                const int row = u.pm * BM + ai * HALF + wr * 64 + m * 16 + fr;
                const float* gp = mod + (size_t)bidx(row) * NMODC + chunk * 1024;
                const float* bp = row < MP ? xp + (size_t)row * DM_ : xs + (size_t)(row - MP) * DM_;
                float* op = out + (size_t)row * DM_;
#pragma unroll
                for (int bj = 0; bj < 2; ++bj)
#pragma unroll
                    for (int n = 0; n < 2; ++n) {
                        const int c = col0 + bj * HALF + n * 16;
                        const f32x4 g = *(const f32x4*)(gp + c), bs = *(const f32x4*)(bp + c);
                        *(f32x4*)(op + c) = bs + (g + 1.0f) * gsc * acc[ai][bj][m][n];
                    }
                asm volatile("" ::: "memory"); __builtin_amdgcn_sched_barrier(0);
            }
    }
};

struct EpiI1 {
    static constexpr bool PERM = true, AFTER_DRAIN = false;
    bf16_t *Q; size_t qkv_stride; bf16_t *XBC; float* dout; float* DT; const float *b_f, *dt_bias; float c2; bf16_t* HALO;
    size_t o_kp, o_lp, o_cp, o_ks, d_v, d_vs, o_ls, o_cs;
    __device__ __forceinline__ void operator()(const f32x4 (&acc)[2][2][4][2], const Unit& u, int wr, int wc, int fr_in, int fq_in) const {
        const int ln_ = lane_now(); const int fr = ln_ & 15, fq = ln_ >> 4; (void)fr_in; (void)fq_in;
        const int pn = u.pn, row0 = u.pm * BM + wr * 64 + fr, cl = wc * 32 + 8 * fq;
        if (pn < 12) {
            const int t = pn >> 2, cb = (pn & 3) * 256;
#pragma unroll
            for (int ai = 0; ai < 2; ++ai)
#pragma unroll
                for (int m = 0; m < 4; ++m) {
                    const int row = row0 + ai * HALF + m * 16;
#pragma unroll
                    for (int bj = 0; bj < 2; ++bj) {
                        const int c = cb + bj * HALF + cl;
                        f32x4 v0 = acc[ai][bj][m][0], v1 = acc[ai][bj][m][1];
                        if (t == 0) { v0 = v0 * c2; v1 = v1 * c2; }
                        u32x4 w; w.x = cvt_pk_bf16(v0[0], v0[1]); w.y = cvt_pk_bf16(v0[2], v0[3]); w.z = cvt_pk_bf16(v1[0], v1[1]); w.w = cvt_pk_bf16(v1[2], v1[3]);
                        bf16_t* dst = Q + (size_t)t * qkv_stride + (size_t)row * DM_ + c;
                        *(u32x4*)dst = w;
                        if (t != 0) {
                            float* fo = dout + (row < MP ? o_kp + (t == 2 ? d_v : (size_t)0) + (size_t)row * DM_ : o_ks + (t == 2 ? d_vs : (size_t)0) + (size_t)(row - MP) * DM_) + c;
                            *(f32x4*)fo = v0; *(f32x4*)(fo + 4) = v1;
                        }
                    }
                    asm volatile("" ::: "memory"); __builtin_amdgcn_sched_barrier(0);
                }
        } else if (pn < 24) {
            const int cb = (pn - 12) * 256;
#pragma unroll
            for (int ai = 0; ai < 2; ++ai)
#pragma unroll
                for (int m = 0; m < 4; ++m) {
                    const int row = row0 + ai * HALF + m * 16;
#pragma unroll
                    for (int bj = 0; bj < 2; ++bj) {
                        const int c = cb + bj * HALF + cl;
                        const f32x4 v0 = acc[ai][bj][m][0], v1 = acc[ai][bj][m][1];
                        u32x4 w; w.x = cvt_pk_bf16(v0[0], v0[1]); w.y = cvt_pk_bf16(v0[2], v0[3]); w.z = cvt_pk_bf16(v1[0], v1[1]); w.w = cvt_pk_bf16(v1[2], v1[3]);
                        *(u32x4*)(XBC + (size_t)row * 3072 + c) = w;
                        if (row < MP - 3 && (row & 63) >= 61) *(u32x4*)(HALO + ((size_t)((row >> 6) + 1) * 3 + ((row & 63) - 61)) * 3072 + c) = w;
                        float* fo = nullptr;
                        if (row >= MP - 3 && row < MP) fo = dout + o_cp + (size_t)(row - (MP - 3)) * 3072 + c;
                        else if (row >= MP && ((row - MP) & 15) >= 13) fo = dout + o_cs + (size_t)((row - MP) >> 4) * 9216 + (size_t)(((row - MP) & 15) - 13) * 3072 + c;
                        if (fo) { *(f32x4*)fo = v0; *(f32x4*)(fo + 4) = v1; }
                    }
                    asm volatile("" ::: "memory"); __builtin_amdgcn_sched_barrier(0);
                }
        } else {
            if (cl < 48) {
#pragma unroll
                for (int ai = 0; ai < 2; ++ai)
#pragma unroll
                    for (int m = 0; m < 4; ++m) {
                        const int row = row0 + ai * HALF + m * 16;
#pragma unroll
                        for (int n = 0; n < 2; ++n) {
                            const f32x4 v = acc[ai][0][m][n];
#pragma unroll
                            for (int i = 0; i < 4; ++i) {
                                const int c = cl + 4 * n + i;
                                if (c < 16) { const float lf = -softplusf_(-(v[i] + b_f[c])); dout[(row < MP ? o_lp + (size_t)row * 16 : o_ls + (size_t)(row - MP) * 16) + c] = lf; }
                                else DT[(size_t)row * 32 + (c - 16)] = softplusf_(v[i] + dt_bias[c - 16]);
                            }
                        }
                    }
            }
        }
    }
};
struct EpiI2 {
    static constexpr bool PERM = true, AFTER_DRAIN = false;
    bf16_t* Y; bf16_t* GATE; float* SSQ;
    __device__ __forceinline__ void elem(int row, int c, float v) const {
        if (c < 2048) { bf16_t* yp = Y + (size_t)row * 2048 + c; *yp = (bf16_t)(cvt_pk_bf16(bf2f(*yp) * silu(v), 0.f) & 0xffffu); }
        else GATE[(size_t)row * 2048 + (c - 2048)] = (bf16_t)(cvt_pk_bf16(sigm(v), 0.f) & 0xffffu); }
    __device__ __forceinline__ void operator()(const f32x4 (&acc)[2][2][4][2], const Unit& u, int wr, int wc, int fr_in, int fq_in) const {
        const int ln_ = lane_now(); const int fr = ln_ & 15, fq = ln_ >> 4; (void)fr_in; (void)fq_in;
        const int pn = u.pn, row0 = u.pm * BM + wr * 64 + fr, cl = wc * 32 + 8 * fq;
        if (pn < 8) {
            float nl2 = -1.4426950408889634f; asm volatile("" : "+v"(nl2));
            u32x4 yq[2][2];
#pragma unroll
            for (int bj = 0; bj < 2; ++bj) yq[0][bj] = *(const u32x4*)(Y + (size_t)row0 * 2048 + pn * 256 + bj * HALF + cl);
#pragma unroll
            for (int grp = 0; grp < 8; ++grp) {
                const int ai = grp >> 2, m = grp & 3, row = row0 + ai * HALF + m * 16, cur = grp & 1, nxt = cur ^ 1; float ss = 0.f;
                if (grp + 1 < 8) { const int row2 = row0 + ((grp + 1) >> 2) * HALF + ((grp + 1) & 3) * 16;
#pragma unroll
                    for (int bj = 0; bj < 2; ++bj) yq[nxt][bj] = *(const u32x4*)(Y + (size_t)row2 * 2048 + pn * 256 + bj * HALF + cl); }
#pragma unroll
                for (int bj = 0; bj < 2; ++bj) {
                    bf16_t* yp = Y + (size_t)row * 2048 + pn * 256 + bj * HALF + cl;
                    const u32x4 yv = yq[cur][bj]; const f32x4 z0 = acc[ai][bj][m][0], z1 = acc[ai][bj][m][1];
                    const float o0 = bflo(yv.x) * silu_c(z0[0], nl2), o1 = bfhi(yv.x) * silu_c(z0[1], nl2), o2 = bflo(yv.y) * silu_c(z0[2], nl2), o3 = bfhi(yv.y) * silu_c(z0[3], nl2);
                    const float o4 = bflo(yv.z) * silu_c(z1[0], nl2), o5 = bfhi(yv.z) * silu_c(z1[1], nl2), o6 = bflo(yv.w) * silu_c(z1[2], nl2), o7 = bfhi(yv.w) * silu_c(z1[3], nl2);
                    ss += (o0 * o0 + o1 * o1) + (o2 * o2 + o3 * o3) + (o4 * o4 + o5 * o5) + (o6 * o6 + o7 * o7);
                    u32x4 w; w.x = cvt_pk_bf16(o0, o1); w.y = cvt_pk_bf16(o2, o3); w.z = cvt_pk_bf16(o4, o5); w.w = cvt_pk_bf16(o6, o7);
                    *(u32x4*)yp = w;
                }
                ss += xor_lane(ss, ln_, 16); ss += xor_lane(ss, ln_, 32);
                if (fq == 0) SSQ[(size_t)row * 32 + pn * 4 + wc] = ss;
                __builtin_amdgcn_sched_barrier(0);
            }
        } else {
            float nl2 = -1.4426950408889634f; asm volatile("" : "+v"(nl2));
            const int cb = (pn - 8) * 256;
#pragma unroll
            for (int ai = 0; ai < 2; ++ai)
#pragma unroll
                for (int m = 0; m < 4; ++m) {
                    const int row = row0 + ai * HALF + m * 16;
#pragma unroll
                    for (int bj = 0; bj < 2; ++bj) {
                        const f32x4 v0 = acc[ai][bj][m][0], v1 = acc[ai][bj][m][1];
                        u32x4 w; w.x = cvt_pk_bf16(sigm_c(v0[0], nl2), sigm_c(v0[1], nl2)); w.y = cvt_pk_bf16(sigm_c(v0[2], nl2), sigm_c(v0[3], nl2)); w.z = cvt_pk_bf16(sigm_c(v1[0], nl2), sigm_c(v1[1], nl2)); w.w = cvt_pk_bf16(sigm_c(v1[2], nl2), sigm_c(v1[3], nl2));
                        *(u32x4*)(GATE + (size_t)row * 2048 + cb + bj * HALF + cl) = w;
                    }
                    asm volatile("" ::: "memory"); __builtin_amdgcn_sched_barrier(0);
                }
        }
    }
};
struct EpiOA {
    static constexpr bool PERM = true, AFTER_DRAIN = false;
    bf16_t* MA; const bf16_t* GATE;
    __device__ __forceinline__ void elem(int row, int c, float v) const { const float o = bf2f(GATE[(size_t)row * 2048 + c]) * v; MA[(size_t)row * DM_ + c] = (bf16_t)(cvt_pk_bf16(o, 0.f) & 0xffffu); }
    __device__ __forceinline__ void operator()(const f32x4 (&acc)[2][2][4][2], const Unit& u, int wr, int wc, int fr_in, int fq_in) const {
        const int ln_ = lane_now(); const int fr = ln_ & 15, fq = ln_ >> 4; (void)fr_in; (void)fq_in;
        const int row0 = u.pm * BM + wr * 64 + fr, col0 = u.pn * BM + wc * 32 + 8 * fq;
        u32x4 gq[2][2];
#pragma unroll
        for (int bj = 0; bj < 2; ++bj) gq[0][bj] = *(const u32x4*)(GATE + (size_t)row0 * 2048 + col0 + bj * HALF);
#pragma unroll
        for (int grp = 0; grp < 8; ++grp) {
            const int ai = grp >> 2, m = grp & 3, row = row0 + ai * HALF + m * 16, cur = grp & 1, nxt = cur ^ 1;
            if (grp + 1 < 8) { const int row2 = row0 + ((grp + 1) >> 2) * HALF + ((grp + 1) & 3) * 16;
#pragma unroll
                for (int bj = 0; bj < 2; ++bj) gq[nxt][bj] = *(const u32x4*)(GATE + (size_t)row2 * 2048 + col0 + bj * HALF); }
#pragma unroll
            for (int bj = 0; bj < 2; ++bj) {
                const int c = col0 + bj * HALF;
                const u32x4 g = gq[cur][bj]; const f32x4 v0 = acc[ai][bj][m][0], v1 = acc[ai][bj][m][1];
                u32x4 w; w.x = cvt_pk_bf16(bflo(g.x) * v0[0], bfhi(g.x) * v0[1]); w.y = cvt_pk_bf16(bflo(g.y) * v0[2], bfhi(g.y) * v0[3]);
                w.z = cvt_pk_bf16(bflo(g.z) * v1[0], bfhi(g.z) * v1[1]); w.w = cvt_pk_bf16(bflo(g.w) * v1[2], bfhi(g.w) * v1[3]);
                *(u32x4*)(MA + (size_t)row * DM_ + c) = w;
            }
            __builtin_amdgcn_sched_barrier(0);
        }
    }
};
struct EpiOS {
    static constexpr bool PERM = true, AFTER_DRAIN = false;
    bf16_t* MERGED; const bf16_t* MA; const bf16_t* GATE; const float* RSTD;
    __device__ __forceinline__ void elem(int row, int c, float v) const {
        const float o = bf2f(MA[(size_t)row * DM_ + c]) + bf2f(GATE[(size_t)row * 2048 + 1024 + c]) * RSTD[row] * v; MERGED[(size_t)row * DM_ + c] = (bf16_t)(cvt_pk_bf16(o, 0.f) & 0xffffu); }
    __device__ __forceinline__ void operator()(const f32x4 (&acc)[2][2][4][2], const Unit& u, int wr, int wc, int fr_in, int fq_in) const {
        const int ln_ = lane_now(); const int fr = ln_ & 15, fq = ln_ >> 4; (void)fr_in; (void)fq_in;
        const int row0 = u.pm * BM + wr * 64 + fr, col0 = u.pn * BM + wc * 32 + 8 * fq;
        u32x4 gq[2][2], aq[2][2]; float rq[2];
        { const int row = row0;
#pragma unroll
          for (int bj = 0; bj < 2; ++bj) { const int c = col0 + bj * HALF; gq[0][bj] = *(const u32x4*)(GATE + (size_t)row * 2048 + 1024 + c); aq[0][bj] = *(const u32x4*)(MA + (size_t)row * DM_ + c); }
          rq[0] = RSTD[row]; }
#pragma unroll
        for (int grp = 0; grp < 8; ++grp) {
            const int ai = grp >> 2, m = grp & 3, row = row0 + ai * HALF + m * 16, cur = grp & 1, nxt = cur ^ 1;
            if (grp + 1 < 8) { const int row2 = row0 + ((grp + 1) >> 2) * HALF + ((grp + 1) & 3) * 16;
#pragma unroll
                for (int bj = 0; bj < 2; ++bj) { const int c = col0 + bj * HALF; gq[nxt][bj] = *(const u32x4*)(GATE + (size_t)row2 * 2048 + 1024 + c); aq[nxt][bj] = *(const u32x4*)(MA + (size_t)row2 * DM_ + c); }
                rq[nxt] = RSTD[row2]; }
            const float rstd = rq[cur];
#pragma unroll
            for (int bj = 0; bj < 2; ++bj) {
                const int c = col0 + bj * HALF; const u32x4 g = gq[cur][bj], a = aq[cur][bj];
                const f32x4 v0 = acc[ai][bj][m][0] * rstd, v1 = acc[ai][bj][m][1] * rstd;
                u32x4 w; w.x = cvt_pk_bf16(bflo(a.x) + bflo(g.x) * v0[0], bfhi(a.x) + bfhi(g.x) * v0[1]); w.y = cvt_pk_bf16(bflo(a.y) + bflo(g.y) * v0[2], bfhi(a.y) + bfhi(g.y) * v0[3]);
                w.z = cvt_pk_bf16(bflo(a.z) + bflo(g.z) * v1[0], bfhi(a.z) + bfhi(g.z) * v1[1]); w.w = cvt_pk_bf16(bflo(a.w) + bflo(g.w) * v1[2], bfhi(a.w) + bfhi(g.w) * v1[3]);
                *(u32x4*)(MERGED + (size_t)row * DM_ + c) = w;
            }
            __builtin_amdgcn_sched_barrier(0);
        }
    }
};
template <class Epi, class Sched, bool ALIGN_EPI = false, bool SP2 = false>
__device__ __forceinline__ void gemm_phase(PG8_LAS unsigned char* lds, const Gemm g, const Sched& S, const Epi& E, int wid_in) {
    const int wid = wid_in, lane = lane_now(), tid = wid * 64 + lane, wr = wid >> 2, wc = wid & 3, fr = lane & 15, fq = lane >> 4;
    const int K = g.K, nt = K / BK;
    unsigned voffA[2], voffB[2];
#pragma unroll
    for (int i = 0; i < 2; ++i) { int R, C; stage_rc(tid * 16 + i * 8192, R, C); const int Rb = Epi::PERM ? ((R & ~31) + perm32(R & 31)) : R;
        voffA[i] = (unsigned)(R * g.lda + C) * 2u; voffB[i] = (unsigned)(Rb * K + C) * 2u; }
    const size_t kstep = (size_t)(BK * 2);
    const size_t hstepA = (size_t)HALF * g.lda * 2, hstepB = (size_t)HALF * K * 2;
    const size_t tstepA = 2 * hstepA, tstepB = 2 * hstepB;
    const unsigned ldsw = (unsigned)wid * 1024u;
    const int aoff = lds_byte(wr * 64 + fr, fq * 8), boff = lds_byte(wc * 32 + fr, fq * 8);
#define PG8_SA(b, h) (((b) * 2 + (h)) * HTB)
#define PG8_SB(b, h) ((4 + (b) * 2 + (h)) * HTB)
#define PG8_STAGE(bufoff, gbase, voff) do { _Pragma("unroll") for (int _i = 0; _i < 2; ++_i) \
        __builtin_amdgcn_global_load_lds((const unsigned*)((const char*)(gbase) + (voff)[_i]), (PG8_LAS unsigned*)(lds + (bufoff) + ldsw + _i * 8192), 16, 0, 0); } while (0)
#define PG8_LDA(dst, b, h) do { _Pragma("unroll") for (int m = 0; m < 4; ++m) _Pragma("unroll") for (int k = 0; k < 2; ++k) dst[m][k] = *(const PG8_LAS bf16x8*)(lds + PG8_SA(b, h) + aoff + m * 2048 + k * 1024); } while (0)
#define PG8_LDB(dst, b, h) do { _Pragma("unroll") for (int n = 0; n < 2; ++n) _Pragma("unroll") for (int k = 0; k < 2; ++k) dst[n][k] = *(const PG8_LAS bf16x8*)(lds + PG8_SB(b, h) + boff + n * 2048 + k * 1024); } while (0)
#define PG8_MMA(ai, bj, At, Bt) do { __builtin_amdgcn_s_setprio(1); _Pragma("unroll") for (int m = 0; m < 4; ++m) _Pragma("unroll") for (int n = 0; n < 2; ++n) _Pragma("unroll") for (int k = 0; k < 2; ++k) \
        acc[ai][bj][m][n] = __builtin_amdgcn_mfma_f32_16x16x32_bf16(Bt[n][k], At[m][k], acc[ai][bj][m][n], 0, 0, 0); __builtin_amdgcn_s_setprio(0); } while (0)
#define PG8_WAIT_V(n) asm volatile("s_waitcnt vmcnt(" #n ")" ::: "memory")
#define PG8_WAIT_L(n) asm volatile("s_waitcnt lgkmcnt(" #n ")" ::: "memory")
#define PG8_BAR __builtin_amdgcn_s_barrier()
#define PG8_SCHED __builtin_amdgcn_sched_barrier(0)
    Unit cur, nxt; int ui = 0;
    if (!S.next(0, cur)) return;
    f32x4 acc[2][2][4][2];
#pragma unroll
    for (int a = 0; a < 2; ++a)
#pragma unroll
        for (int b = 0; b < 2; ++b)
#pragma unroll
            for (int m = 0; m < 4; ++m)
#pragma unroll
                for (int n = 0; n < 2; ++n) acc[a][b][m][n] = (f32x4){0.f, 0.f, 0.f, 0.f};
    bf16x8 At[4][2], B0[2][2], B1[2][2];
    const char* cA = (const char*)g.A + (size_t)cur.pm * tstepA; const char* cB = (const char*)g.Bt + (size_t)cur.pn * tstepB;
    S.a_ready(cur);
    if constexpr (SP2) {
        PG8_STAGE(PG8_SB(0, 0), cB, voffB); PG8_STAGE(PG8_SB(0, 1), cB + hstepB, voffB); PG8_STAGE(PG8_SA(0, 0), cA, voffA); PG8_STAGE(PG8_SA(0, 1), cA + hstepA, voffA);
        if (wr == 1) PG8_BAR;
        PG8_WAIT_V(2); PG8_BAR;
        PG8_STAGE(PG8_SB(1, 0), cB + kstep, voffB); PG8_STAGE(PG8_SA(1, 0), cA + kstep, voffA); PG8_STAGE(PG8_SB(1, 1), cB + hstepB + kstep, voffB);
        PG8_WAIT_V(6); PG8_BAR;
    } else {
        PG8_STAGE(PG8_SB(0, 0), cB, voffB); PG8_STAGE(PG8_SA(0, 0), cA, voffA); PG8_STAGE(PG8_SB(0, 1), cB + hstepB, voffB); PG8_STAGE(PG8_SA(0, 1), cA + hstepA, voffA);
        if (wr == 1) PG8_BAR;
        PG8_WAIT_V(4); PG8_BAR;
        PG8_STAGE(PG8_SB(1, 0), cB + kstep, voffB); PG8_STAGE(PG8_SA(1, 0), cA + kstep, voffA); PG8_STAGE(PG8_SB(1, 1), cB + hstepB + kstep, voffB);
        PG8_WAIT_V(6); PG8_BAR;
    }
    for (;;) {
        const bool has_next = S.next(ui + 1, nxt);
        const char* nA = has_next ? (const char*)g.A + (size_t)nxt.pm * tstepA : cA; const char* nB = has_next ? (const char*)g.Bt + (size_t)nxt.pn * tstepB : cB;
        for (int t = 0; t < nt; t += 2) {
            const bool last = (t == nt - 2);
            const char* a1 = cA + (size_t)(t + 1) * kstep;
            const char* a2 = last ? nA : cA + (size_t)(t + 2) * kstep; const char* b2 = last ? nB : cB + (size_t)(t + 2) * kstep;
            const char* a3 = a2 + kstep; const char* b3 = b2 + kstep;
            if (last && has_next) S.a_ready(nxt);
            if constexpr (SP2) {
            PG8_LDB(B0, 0, 0); PG8_LDB(B1, 0, 1); PG8_SCHED; PG8_LDA(At, 0, 0); PG8_STAGE(PG8_SA(1, 1), a1 + hstepA, voffA);
            PG8_WAIT_V(8); PG8_WAIT_L(0); PG8_BAR; PG8_MMA(0, 0, At, B0); PG8_MMA(0, 1, At, B1); PG8_BAR; PG8_SCHED;
            PG8_LDA(At, 0, 1); PG8_STAGE(PG8_SB(0, 0), b2, voffB); PG8_STAGE(PG8_SB(0, 1), b2 + hstepB, voffB); PG8_STAGE(PG8_SA(0, 0), a2, voffA);
            PG8_WAIT_V(8); PG8_WAIT_L(0); PG8_BAR; PG8_MMA(1, 0, At, B0); PG8_MMA(1, 1, At, B1); PG8_BAR; PG8_SCHED;
            PG8_LDB(B0, 1, 0); PG8_LDB(B1, 1, 1); PG8_SCHED; PG8_LDA(At, 1, 0); PG8_STAGE(PG8_SA(0, 1), a2 + hstepA, voffA);
            PG8_WAIT_V(8); PG8_WAIT_L(0); PG8_BAR; PG8_MMA(0, 0, At, B0); PG8_MMA(0, 1, At, B1); PG8_BAR; PG8_SCHED;
            PG8_LDA(At, 1, 1); PG8_STAGE(PG8_SB(1, 0), b3, voffB); PG8_STAGE(PG8_SB(1, 1), b3 + hstepB, voffB); PG8_STAGE(PG8_SA(1, 0), a3, voffA);
            PG8_WAIT_V(8); PG8_WAIT_L(0); PG8_BAR; PG8_MMA(1, 0, At, B0); PG8_MMA(1, 1, At, B1); PG8_BAR; PG8_SCHED;
            } else {
            PG8_LDB(B0, 0, 0); PG8_SCHED; PG8_LDA(At, 0, 0); PG8_STAGE(PG8_SA(1, 1), a1 + hstepA, voffA);
            PG8_WAIT_L(8); PG8_BAR; PG8_WAIT_L(0); PG8_MMA(0, 0, At, B0); PG8_BAR; PG8_SCHED;
            PG8_LDB(B1, 0, 1); PG8_STAGE(PG8_SB(0, 0), b2, voffB);
            PG8_BAR; PG8_WAIT_L(0); PG8_MMA(0, 1, At, B1); PG8_BAR;
            PG8_LDA(At, 0, 1); PG8_STAGE(PG8_SA(0, 0), a2, voffA);
            PG8_BAR; PG8_WAIT_L(0); PG8_MMA(1, 0, At, B0); PG8_BAR; PG8_SCHED;
            PG8_STAGE(PG8_SB(0, 1), b2 + hstepB, voffB);
            PG8_WAIT_V(6); PG8_BAR; PG8_MMA(1, 1, At, B1); PG8_BAR;
            PG8_LDB(B0, 1, 0); PG8_SCHED; PG8_LDA(At, 1, 0); PG8_STAGE(PG8_SA(0, 1), a2 + hstepA, voffA);
            PG8_WAIT_L(8); PG8_BAR; PG8_WAIT_L(0); PG8_MMA(0, 0, At, B0); PG8_BAR; PG8_SCHED;
            PG8_LDB(B1, 1, 1); PG8_STAGE(PG8_SB(1, 0), b3, voffB);
            PG8_BAR; PG8_WAIT_L(0); PG8_MMA(0, 1, At, B1); PG8_BAR;
            PG8_LDA(At, 1, 1); PG8_STAGE(PG8_SA(1, 0), a3, voffA);
            PG8_BAR; PG8_WAIT_L(0); PG8_MMA(1, 0, At, B0); PG8_BAR; PG8_SCHED;
            PG8_STAGE(PG8_SB(1, 1), b3 + hstepB, voffB);
            PG8_WAIT_V(6); PG8_BAR; PG8_MMA(1, 1, At, B1); PG8_BAR;
            }
        }
        if constexpr (ALIGN_EPI) { if (wr == 0) PG8_BAR; }
        if constexpr (!Epi::AFTER_DRAIN) { E(acc, cur, wr, wc, fr, fq); S.done(cur); }
        if (!has_next) break;
#pragma unroll
        for (int a = 0; a < 2; ++a)
#pragma unroll
            for (int b = 0; b < 2; ++b)
#pragma unroll
                for (int m = 0; m < 4; ++m)
#pragma unroll
                    for (int n = 0; n < 2; ++n) acc[a][b][m][n] = (f32x4){0.f, 0.f, 0.f, 0.f};
        cur = nxt; cA = nA; cB = nB; ++ui;
        if constexpr (ALIGN_EPI) { if (wr == 1) PG8_BAR; }
    }
    PG8_WAIT_V(0);
    if constexpr (!ALIGN_EPI) { if (wr == 0) PG8_BAR; }
    PG8_BAR;
    if constexpr (Epi::AFTER_DRAIN) { E.fused(acc, cur, wr, wc, fr, fq, lds, wid, lane); S.done(cur); }
#undef PG8_SA
#undef PG8_SB
#undef PG8_STAGE
#undef PG8_LDA
#undef PG8_LDB
#undef PG8_MMA
#undef PG8_WAIT_V
#undef PG8_WAIT_L
#undef PG8_BAR
#undef PG8_SCHED
}
}

#ifndef PG8_SP2
#define PG8_SP2 true
#endif
#ifndef PG8_ALIGN
#define PG8_ALIGN true
#endif
#include <hip/hip_bf16.h>
#include <cmath>
namespace attn_body {
using bf16=__hip_bfloat16;
using bf16x8=__attribute__((ext_vector_type(8)))short;
using s16x4=__attribute__((ext_vector_type(4)))short;
using f32x16=__attribute__((ext_vector_type(16)))float;
using u32x4=__attribute__((ext_vector_type(4)))unsigned;
constexpr int BATCH=1,NHEAD=16,SEQ=16384,D=64,DM=NHEAD*D;
constexpr int NW=8,QBLK=32,QB=QBLK*NW,KVBLK=64,NQB=SEQ/QB;
constexpr int ATTN_PITCH=DM, ATTN_UNIT_ROWS=QB;
__device__ __forceinline__ int crow(int r,int hi){return (r&3)+8*(r>>2)+4*hi;}
#define SBAR() __builtin_amdgcn_sched_barrier(0)
__device__ __forceinline__ void cmask(f32x16&p0,f32x16&p1,int jb,int qrel,int hi){
  const float NEG=-INFINITY; int kb=64*jb+4*hi;
  #pragma unroll
  for(int r=0;r<16;++r){int kv=kb+(r&3)+8*(r>>2); if(kv>qrel)p0[r]=NEG; if(kv+32>qrel)p1[r]=NEG;}
}

constexpr int NSLOT=3, SLOTB=8192;
constexpr int LDS_K=0, LDS_V=NSLOT*SLOTB, LDS_WS=2*NSLOT*SLOTB, LDS_OST=LDS_WS+NW*64*4, LDS_FK=LDS_OST+NW*4096, LDS_BYTES=LDS_FK+NW*NSLOT*256;
constexpr float C2=0.125f*1.4426950408889634f;
__device__ __forceinline__ void glds16(const void*gsrc,unsigned lds_dst){unsigned keep;
  asm volatile("s_mov_b32 %0, m0\n\ts_mov_b32 m0, %2\n\ts_nop 0\n\tglobal_load_lds_dwordx4 %1, off\n\ts_mov_b32 m0, %0":"=&s"(keep):"v"(gsrc),"s"(lds_dst):"memory");}
__device__ __forceinline__ float max3f(float a,float b,float c){float r;asm("v_max3_f32 %0, %1, %2, %3":"=v"(r):"v"(a),"v"(b),"v"(c));return r;}
__device__ __forceinline__ float max2f(float a,float b){float r;asm("v_max_f32_e32 %0, %1, %2":"=v"(r):"v"(a),"v"(b));return r;}
__device__ __forceinline__ float fadd_s(float a,float b){float r;asm("v_add_f32_e32 %0, %1, %2":"=v"(r):"v"(a),"v"(b));return r;}
__device__ __forceinline__ float fsub_s(float a,float b){float r;asm("v_sub_f32_e32 %0, %1, %2":"=v"(r):"v"(a),"v"(b));return r;}
typedef float f32x2_t __attribute__((ext_vector_type(2))); typedef float f32x4_t __attribute__((ext_vector_type(4))); typedef __bf16 bf16x2_t __attribute__((ext_vector_type(2)));
__device__ __forceinline__ unsigned cvtpk_s(float lo,float hi){f32x2_t v={lo,hi};bf16x2_t b=__builtin_convertvector(v,bf16x2_t);return __builtin_bit_cast(unsigned,b);}
__device__ __forceinline__ void glds4(const void*gsrc,unsigned lds_dst){unsigned keep;
  asm volatile("s_mov_b32 %0, m0\n\ts_mov_b32 m0, %2\n\ts_nop 0\n\tglobal_load_lds_dword %1, off\n\ts_mov_b32 m0, %0":"=&s"(keep):"v"(gsrc),"s"(lds_dst):"memory");}
#define WAIT_BAR(N) asm volatile("s_waitcnt vmcnt(" #N ") lgkmcnt(0)\n\ts_barrier":::"memory")

__device__ __forceinline__ void qkt(f32x16&p0,f32x16&p1,const char*Kslot,const bf16x8*qr,int r32,int hi){
  const char*kb=Kslot+hi*1024+r32*16;
  #pragma unroll
  for(int d0=0;d0<4;++d0){
    const bf16x8 b0=*reinterpret_cast<const bf16x8*>(kb+d0*2048);
    const bf16x8 b1=*reinterpret_cast<const bf16x8*>(kb+d0*2048+512);
    p0=__builtin_amdgcn_mfma_f32_32x32x16_bf16(b0,qr[d0],p0,0,0,0);p1=__builtin_amdgcn_mfma_f32_32x32x16_bf16(b1,qr[d0],p1,0,0,0);}
}
typedef __attribute__((address_space(3))) const char* lds_cptr;
typedef short v4i16_t __attribute__((ext_vector_type(4)));
__device__ __forceinline__ void kload8(bf16x8*kf,lds_cptr kp){
  kf[0]=*(const __attribute__((address_space(3))) bf16x8*)(kp);      kf[1]=*(const __attribute__((address_space(3))) bf16x8*)(kp+512);
  kf[2]=*(const __attribute__((address_space(3))) bf16x8*)(kp+2048); kf[3]=*(const __attribute__((address_space(3))) bf16x8*)(kp+2560);
  kf[4]=*(const __attribute__((address_space(3))) bf16x8*)(kp+4096); kf[5]=*(const __attribute__((address_space(3))) bf16x8*)(kp+4608);
  kf[6]=*(const __attribute__((address_space(3))) bf16x8*)(kp+6144); kf[7]=*(const __attribute__((address_space(3))) bf16x8*)(kp+6656);
}
__device__ __forceinline__ void kload2(bf16x8*kf,lds_cptr kp,int j){ kf[2*j]=*(const __attribute__((address_space(3))) bf16x8*)(kp+j*2048); kf[2*j+1]=*(const __attribute__((address_space(3))) bf16x8*)(kp+j*2048+512); }
__device__ __forceinline__ s16x4 vtr(lds_cptr p){ return __builtin_bit_cast(s16x4,__builtin_amdgcn_ds_read_tr16_b64_v4i16((__attribute__((address_space(3))) v4i16_t*)p)); }
__device__ __forceinline__ float rowmax(const f32x16&p0,const f32x16&p1){
  float a=max3f(p0[0],p0[1],p1[0]),b=max3f(p0[2],p0[3],p1[1]);a=max3f(a,p1[2],p1[3]);
  #pragma unroll
  for(int r=4;r<16;r+=4){a=max3f(a,p0[r],p0[r+1]);b=max3f(b,p0[r+2],p0[r+3]);a=max3f(a,p1[r],p1[r+1]);b=max3f(b,p1[r+2],p1[r+3]);}
  const float m=max2f(a,b);
  auto rr=__builtin_amdgcn_permlane32_swap(__float_as_uint(m),__float_as_uint(m),false,false);
  return max2f(__uint_as_float(rr[0]),__uint_as_float(rr[1]));
}
__device__ __forceinline__ void pv(f32x16*o,int vb,bf16x8 pa0,bf16x8 pa1,bf16x8 pa2,bf16x8 pa3){
  #pragma unroll
  for(int d0=0;d0<2;++d0){s16x4 lo[4],hi[4];
    #pragma unroll
    for(int ks=0;ks<4;++ks){
      asm volatile("ds_read_b64_tr_b16 %0,%1 offset:%c2":"=&v"(lo[ks]):"v"(vb),"i"(d0*4096+ks*1024):"memory");
      asm volatile("ds_read_b64_tr_b16 %0,%1 offset:%c2":"=&v"(hi[ks]):"v"(vb),"i"(d0*4096+ks*1024+512):"memory");}
    asm volatile("s_waitcnt lgkmcnt(0)":::"memory");SBAR();
    #define PK(k) (bf16x8){lo[k][0],lo[k][1],lo[k][2],lo[k][3],hi[k][0],hi[k][1],hi[k][2],hi[k][3]}
    o[d0]=__builtin_amdgcn_mfma_f32_32x32x16_bf16(pa0,PK(0),o[d0],0,0,0);
    o[d0]=__builtin_amdgcn_mfma_f32_32x32x16_bf16(pa1,PK(1),o[d0],0,0,0);
    o[d0]=__builtin_amdgcn_mfma_f32_32x32x16_bf16(pa2,PK(2),o[d0],0,0,0);
    o[d0]=__builtin_amdgcn_mfma_f32_32x32x16_bf16(pa3,PK(3),o[d0],0,0,0);
    #undef PK
  }
}

#ifndef ATTN_STORE16
#define ATTN_STORE16(p,v) (*(u32x4*)(p)=(v))
#endif
template<int THRL> __device__ __forceinline__ void attn_unit(int b,int h,int qb,const bf16*Q,const bf16*__restrict__ K,const bf16*__restrict__ V,bf16*O,const float*__restrict__ F2h,char*shm,int wid_in,int t_start){
  const int wid=wid_in,lane=pg8::lane_now(),tid=wid*64+lane,r32=lane&31,hi=lane>>5; (void)tid;
  const long rowbase=(long)b*SEQ; const int q0=qb*QB;
  const bf16*Qw=Q+(rowbase+q0+wid*QBLK)*DM+h*D;
  const bf16*Kh=K+(rowbase+(long)t_start*KVBLK)*DM+h*D,*Vh=V+(rowbase+(long)t_start*KVBLK)*DM+h*D; const float*F2k=F2h+(long)t_start*KVBLK;
  const unsigned lds0=(unsigned)(uintptr_t)shm;
  float*wsf=(float*)(shm+LDS_WS)+wid*64;
  const bf16*ksrc=Kh+(long)lane*DM+wid*8;
  const bf16*vsrc=Vh+(long)(16*(wid&3)+(lane>>2))*DM+(wid>>2)*32+(lane&3)*8;
  const unsigned kdst=lds0+LDS_K+wid*1024, vdst=lds0+LDS_V+wid*1024;
  #define DMA_K(t,slot) glds16(ksrc+(long)(t)*KVBLK*DM,(unsigned)__builtin_amdgcn_readfirstlane(kdst+(slot)))
  #define DMA_V(t,slot) glds16(vsrc+(long)(t)*KVBLK*DM,(unsigned)__builtin_amdgcn_readfirstlane(vdst+(slot)))
  const unsigned fdst=lds0+LDS_FK+wid*(NSLOT*256); const float*fsrc=F2k+lane;
  #define DMA_F(t,slot) glds4(fsrc+(long)(t)*KVBLK,(unsigned)__builtin_amdgcn_readfirstlane(fdst+((slot)>>5)))
  const int vb0=(int)(lds0+LDS_V)+((lane>>4)&1)*32+(lane&3)*8+(4*hi+((lane&15)>>2))*64;
  const char*Kbase=shm+LDS_K; bf16x8 kf[8];
  const lds_cptr shm3=(lds_cptr)shm; const lds_cptr kp0=shm3+LDS_K+hi*1024+r32*16; const lds_cptr vp0=shm3+LDS_V+((lane>>4)&1)*32+(lane&3)*8+(4*hi+((lane&15)>>2))*64;
  const int NT=(q0+QB)/KVBLK-t_start;
  DMA_K(0,0);DMA_F(0,0);DMA_V(0,0);DMA_K(1,SLOTB);DMA_F(1,SLOTB);
  bf16x8 qr[4];
  #pragma unroll
  for(int d0=0;d0<4;++d0)qr[d0]=*reinterpret_cast<const bf16x8*>(&Qw[(long)r32*DM+d0*16+hi*8]);
  float mhat=0.f,l_reg=0.f;f32x16 o[2];o[0]=f32x16{};o[1]=f32x16{};
  const int qrel=wid*QBLK+r32;
  const float Gq=F2h[q0+qrel];
  float negs=Gq;
  const __attribute__((address_space(3))) char* fk3=(const __attribute__((address_space(3))) char*)shm+LDS_FK+wid*(NSLOT*256)+hi*16;
  #define CINIT(C0_,C1_,slot_) do{ const __attribute__((address_space(3))) f32x4_t*fp_=(const __attribute__((address_space(3))) f32x4_t*)(fk3+((slot_)>>5)); \
    _Pragma("unroll") for(int j_=0;j_<4;++j_){ const f32x4_t a_=fp_[2*j_], b_=fp_[8+2*j_]; \
      C0_[4*j_]=negs-a_[0];C0_[4*j_+1]=negs-a_[1];C0_[4*j_+2]=negs-a_[2];C0_[4*j_+3]=negs-a_[3]; \
      C1_[4*j_]=negs-b_[0];C1_[4*j_+1]=negs-b_[1];C1_[4*j_+2]=negs-b_[2];C1_[4*j_+3]=negs-b_[3]; } }while(0)
  #define CMASK(P0,P1,t) do{int jb_=(t)-(NT-4); if(jb_>=0)cmask(P0,P1,jb_,qrel,hi);}while(0)
  bool resc=false;
  float sdiag=0.f;
  { const bf16*Kd=K+(rowbase+q0+qrel)*DM+h*D+hi*8;
    #pragma unroll
    for(int d0=0;d0<4;++d0){ const bf16x8 kd=*reinterpret_cast<const bf16x8*>(Kd+d0*16);
      #pragma unroll
      for(int j=0;j<8;++j)sdiag+=__uint_as_float(((unsigned)(unsigned short)qr[d0][j])<<16)*__uint_as_float(((unsigned)(unsigned short)kd[j])<<16); }
    auto rr_=__builtin_amdgcn_permlane32_swap(__float_as_uint(sdiag),__float_as_uint(sdiag),false,false); sdiag=__uint_as_float(rr_[0])+__uint_as_float(rr_[1]); }
  #define START(P0,P1) do{ const float rm=sdiag; resc=false; \
    { const float dl=rm; mhat=fadd_s(mhat,dl); \
      _Pragma("unroll") for(int r=0;r<16;++r){P0[r]=fsub_s(P0[r],dl);P1[r]=fsub_s(P1[r],dl);} \
      negs=Gq-mhat; } \
    _Pragma("unroll") for(int r=0;r<16;++r)P0[r]=__builtin_amdgcn_exp2f(P0[r]); }while(0)
  #define RESC() do{ if(resc){ asm volatile("s_waitcnt lgkmcnt(0)":::"memory"); \
      _Pragma("unroll") for(int d_=0;d_<2;++d_) _Pragma("unroll") for(int r=0;r<16;++r)o[d_][r]*=wsf[crow(r,hi)]; } }while(0)
  f32x16 pA0,pA1,pB0,pB1;
  int sl_prev=0,sl_cur=0,sl_next=SLOTB;
  #define ROT() do{sl_prev=sl_cur;sl_cur=sl_next;sl_next=(sl_next==(NSLOT-1)*SLOTB)?0:sl_next+SLOTB;}while(0)
  DMA_K(2,2*SLOTB);DMA_F(2,2*SLOTB);
  WAIT_BAR(3);
  CINIT(pA0,pA1,0); qkt(pA0,pA1,Kbase,qr,r32,hi);asm volatile("s_nop 15\n\ts_nop 7":"+v"(pA0),"+v"(pA1));CMASK(pA0,pA1,0);
  START(pA0,pA1);
  _Pragma("unroll") for(int r=0;r<16;++r)pA1[r]=__builtin_amdgcn_exp2f(pA1[r]);
  WAIT_BAR(0);
  DMA_K(3,0);DMA_F(3,0);DMA_V(1,SLOTB);
  ROT();
  kload8(kf,kp0+sl_cur);
  WAIT_BAR(3);
  s16x4 vlo[8],vhi[8]; u32x4 pw0,pw1,pw2,pw3;
  #define PKW(P,B) cvtpk_s(P[B],P[B+1])
  #define PAF(k) __builtin_bit_cast(bf16x8,pw##k)
  #define VFR(i) (bf16x8){vlo[i][0],vlo[i][1],vlo[i][2],vlo[i][3],vhi[i][0],vhi[i][1],vhi[i][2],vhi[i][3]}
  #define PIN(x) asm volatile("":"+v"(x))
  #define MX3(a,b,c) __builtin_fmaxf(__builtin_fmaxf((a),(b)),(c))
  #define GAPA(MF,A0,A1,A2,A3,W0,W1,PW) do{ MF; sacc+=A0; sacc+=A1; sacc+=A2; sacc+=A3; PIN(sacc); W0; W1; PIN(PW); SBAR(); }while(0)
  #define EX(v) __builtin_amdgcn_exp2f(v)
  #define GAPB(MF,X,B) do{ MF; X[B]=EX(X[B]); X[B+1]=EX(X[B+1]); X[B+2]=EX(X[B+2]); X[B+3]=EX(X[B+3]); PIN(X); SBAR(); }while(0)
  #define VRD(i) do{ vlo[i]=vtr(vp_+(((i)>>2)*4096+((i)&3)*1024)); vhi[i]=vtr(vp_+(((i)>>2)*4096+((i)&3)*1024+512)); }while(0)
  #define KRD(G,j) do{ if(G){ kload2(kf,kp0+sl_next,j); SBAR(); } }while(0)
  #define STEP(C0,C1,P0,P1,t,GK,GV,GL) do{ SBAR(); \
    CINIT(C0,C1,sl_cur); \
    const lds_cptr vp_=vp0+sl_prev; \
    VRD(0); SBAR(); float sacc=(P0[0]+P0[1]); \
    GAPA(C0=__builtin_amdgcn_mfma_f32_32x32x16_bf16(kf[0],qr[0],C0,0,0,0), P0[2],P0[3],P0[4],P0[5],     pw0[0]=PKW(P0,0), pw0[1]=PKW(P0,2), pw0); \
    VRD(4); SBAR(); GAPA(C1=__builtin_amdgcn_mfma_f32_32x32x16_bf16(kf[1],qr[0],C1,0,0,0), P0[6],P0[7],P0[8],P0[9],     pw0[2]=PKW(P0,4), pw0[3]=PKW(P0,6), pw0); \
    VRD(1); SBAR(); GAPA(C0=__builtin_amdgcn_mfma_f32_32x32x16_bf16(kf[2],qr[1],C0,0,0,0),   P0[10],P0[11],P0[12],P0[13], pw1[0]=PKW(P0,8), pw1[1]=PKW(P0,10), pw1); \
    VRD(5); SBAR(); GAPA(C1=__builtin_amdgcn_mfma_f32_32x32x16_bf16(kf[3],qr[1],C1,0,0,0),   P0[14],P0[15],P1[0],P1[1],   pw1[2]=PKW(P0,12),pw1[3]=PKW(P0,14), pw1); \
    VRD(2); SBAR(); GAPA(C0=__builtin_amdgcn_mfma_f32_32x32x16_bf16(kf[4],qr[2],C0,0,0,0),   P1[2],P1[3],P1[4],P1[5],     pw2[0]=PKW(P1,0), pw2[1]=PKW(P1,2), pw2); \
    VRD(6); SBAR(); GAPA(C1=__builtin_amdgcn_mfma_f32_32x32x16_bf16(kf[5],qr[2],C1,0,0,0),   P1[6],P1[7],P1[8],P1[9],     pw2[2]=PKW(P1,4), pw2[3]=PKW(P1,6), pw2); \
    VRD(3); SBAR(); GAPA(C0=__builtin_amdgcn_mfma_f32_32x32x16_bf16(kf[6],qr[3],C0,0,0,0),   P1[10],P1[11],P1[12],P1[13], pw3[0]=PKW(P1,8), pw3[1]=PKW(P1,10), pw3); \
    VRD(7); SBAR(); GAPA(C1=__builtin_amdgcn_mfma_f32_32x32x16_bf16(kf[7],qr[3],C1,0,0,0),   P1[14],P1[15],0.f,0.f,       pw3[2]=PKW(P1,12),pw3[3]=PKW(P1,14), pw3); \
    l_reg+=sacc; \
    if(GK){DMA_K((t)+3,sl_cur);DMA_F((t)+3,sl_cur);} if(GV){DMA_V((t)+1,sl_next);} \
    CMASK(C0,C1,t); \
    { float a=MX3(C0[0],C0[1],C1[0]),b=MX3(C0[2],C0[3],C1[1]); a=MX3(a,C1[2],C1[3]); \
      _Pragma("unroll") for(int r=4;r<16;r+=4){a=MX3(a,C0[r],C0[r+1]);b=MX3(b,C0[r+2],C0[r+3]);a=MX3(a,C1[r],C1[r+1]);b=MX3(b,C1[r+2],C1[r+3]);} \
      float rm=__builtin_fmaxf(a,b); { auto rr=__builtin_amdgcn_permlane32_swap(__float_as_uint(rm),__float_as_uint(rm),false,false); rm=__builtin_fmaxf(__uint_as_float(rr[0]),__uint_as_float(rr[1])); } \
      resc=false; \
      if(__builtin_expect(__any(rm>(float)THRL),0)){ const float dl=__builtin_fmaxf(rm,0.f); mhat+=dl; \
        _Pragma("unroll") for(int r=0;r<16;++r){C0[r]-=dl;C1[r]-=dl;} \
        negs=Gq-mhat; \
        const float f=__builtin_amdgcn_exp2f(-dl); l_reg*=f; if(hi==0)wsf[r32]=f; resc=true; } } \
    SBAR(); \
    GAPB(o[0]=__builtin_amdgcn_mfma_f32_32x32x16_bf16(PAF(0),VFR(0),o[0],0,0,0), C0,0); \
    GAPB(o[1]=__builtin_amdgcn_mfma_f32_32x32x16_bf16(PAF(0),VFR(4),o[1],0,0,0), C0,4); \
    KRD(GL,0); GAPB(o[0]=__builtin_amdgcn_mfma_f32_32x32x16_bf16(PAF(1),VFR(1),o[0],0,0,0), C0,8); \
    KRD(GL,1); GAPB(o[1]=__builtin_amdgcn_mfma_f32_32x32x16_bf16(PAF(1),VFR(5),o[1],0,0,0), C0,12); \
    KRD(GL,2); GAPB(o[0]=__builtin_amdgcn_mfma_f32_32x32x16_bf16(PAF(2),VFR(2),o[0],0,0,0), C1,0); \
    KRD(GL,3); GAPB(o[1]=__builtin_amdgcn_mfma_f32_32x32x16_bf16(PAF(2),VFR(6),o[1],0,0,0), C1,4); \
    GAPB(o[0]=__builtin_amdgcn_mfma_f32_32x32x16_bf16(PAF(3),VFR(3),o[0],0,0,0), C1,8); \
    GAPB(o[1]=__builtin_amdgcn_mfma_f32_32x32x16_bf16(PAF(3),VFR(7),o[1],0,0,0), C1,12); \
    }while(0)
  int t=1;
  #undef CMASK
  #define CMASK(P0,P1,t) do{}while(0)
  for(;t+5<NT;t+=2){
    STEP(pB0,pB1,pA0,pA1,t,true,true,true);     WAIT_BAR(3); RESC(); ROT();
    STEP(pA0,pA1,pB0,pB1,t+1,true,true,true);   WAIT_BAR(3); RESC(); ROT();
  }
  #undef CMASK
  #define CMASK(P0,P1,t) do{int jb_=(t)-(NT-4); if(jb_>=0)cmask(P0,P1,jb_,qrel,hi);}while(0)
  #define ENDW(tt) do{ if((tt)+3<NT){WAIT_BAR(3);} else if((tt)+2<NT){WAIT_BAR(1);} else {WAIT_BAR(0);} }while(0)
  for(;t+1<NT;t+=2){
    STEP(pB0,pB1,pA0,pA1,t,(t+3<NT),(t+1<NT),(t+1<NT));       ENDW(t);   RESC(); ROT();
    STEP(pA0,pA1,pB0,pB1,t+1,(t+4<NT),(t+2<NT),(t+2<NT));     ENDW(t+1); RESC(); ROT();
  }
  STEP(pB0,pB1,pA0,pA1,NT-1,false,false,false); RESC();
  { float sacc=pB0[0]+pB0[1]; _Pragma("unroll") for(int r=2;r<16;++r)sacc+=pB0[r]; _Pragma("unroll") for(int r=0;r<16;++r)sacc+=pB1[r]; l_reg+=sacc;
    pw0=(u32x4){PKW(pB0,0),PKW(pB0,2),PKW(pB0,4),PKW(pB0,6)};pw1=(u32x4){PKW(pB0,8),PKW(pB0,10),PKW(pB0,12),PKW(pB0,14)};pw2=(u32x4){PKW(pB1,0),PKW(pB1,2),PKW(pB1,4),PKW(pB1,6)};pw3=(u32x4){PKW(pB1,8),PKW(pB1,10),PKW(pB1,12),PKW(pB1,14)};
    SBAR(); pv(o,vb0+sl_cur,PAF(0),PAF(1),PAF(2),PAF(3)); }
  #undef PKW
  #undef PAF
  #undef VFR
  #undef PIN
  #undef MX3
  #undef GAPA
  #undef GAPB
  #undef EX
  #undef VRD
  #undef KRD
  #undef STEP
  #undef ENDW
  {auto rr=__builtin_amdgcn_permlane32_swap(__float_as_uint(l_reg),__float_as_uint(l_reg),false,false);l_reg=__uint_as_float(rr[0])+__uint_as_float(rr[1]);}
  if(hi==0)wsf[32+r32]=l_reg;asm volatile("s_waitcnt lgkmcnt(0)":::"memory");
  float rli[16];
  #pragma unroll
  for(int r=0;r<16;++r)rli[r]=__builtin_amdgcn_rcpf(wsf[32+crow(r,hi)]);
  bf16*Ow=O+(rowbase+q0+wid*QBLK)*DM+h*D;
  { bf16*stg=(bf16*)(shm+LDS_OST)+wid*2048;
    #pragma unroll
    for(int r=0;r<16;++r){const int orow=crow(r,hi);
      #pragma unroll
      for(int d0=0;d0<2;++d0)stg[orow*64+d0*32+r32]=__float2bfloat16(o[d0][r]*rli[r]);}
    asm volatile("s_waitcnt lgkmcnt(0)":::"memory");
    #pragma unroll
    for(int i=0;i<4;++i){const int row=i*8+(lane>>3),ch=lane&7; const u32x4 v=*(const u32x4*)(stg+row*64+ch*8); ATTN_STORE16(Ow+(long)row*DM+ch*8,v);} }
  asm volatile("s_waitcnt lgkmcnt(0)\n\ts_barrier":::"memory");
  #undef DMA_K
  #undef DMA_V
  #undef DMA_F
  #undef CMASK
  #undef CINIT
  #undef START
  #undef RESC
  #undef ROT
}
constexpr int ATTN_LDS_BYTES=LDS_BYTES;
struct AttnTensors { const bf16* Q; const bf16* K; const bf16* V; bf16* O; const float* F2; };
struct AttnUnit { int bh; int qb; };
struct StaticOrder {
  int vcu;
  __device__ __forceinline__ explicit StaticOrder(int grid,int block):vcu((block%8)*(grid/8)+block/8){}
  __device__ __forceinline__ bool next(int i,AttnUnit&u)const{ if(i>=4)return false; const int s=vcu&15; u.bh=vcu>>4; u.qb=(i==0)?63-s:(i==1)?32+s:(i==2)?31-s:s; return true; }
  __device__ __forceinline__ void a_ready(const AttnUnit&)const{}
  __device__ __forceinline__ void done(const AttnUnit&)const{}
};
template<class Sched,int THRL=8> __device__ __forceinline__ void attn_phase(char*lds,const AttnTensors&T,const Sched&S,int wid_in){
  AttnUnit u;
  for(int i=0;S.next(i,u);++i){ S.a_ready(u); attn_unit<THRL>(0,u.bh,u.qb,T.Q,T.K,T.V,T.O,T.F2+(size_t)u.bh*SEQ,lds,wid_in,0); S.done(u); }
}
constexpr float PRUNE_LOG2=30.f;
struct AttnQueue { const float* kqmax; unsigned* ticket; };
template<int THRL=8> __device__ __forceinline__ void attn_phase_queue(char*lds,const AttnTensors&T,const AttnQueue&Q,int wid_in){
  const int lane=pg8::lane_now(),tid=wid_in*64+lane;
  typedef __attribute__((address_space(3))) unsigned short lu16; typedef __attribute__((address_space(3))) unsigned lu32;
  lu16*tst=(lu16*)lds;
  lu16*ord=tst+1024;
  lu32*tk=(lu32*)(ord+1024);
  { typedef __attribute__((address_space(3))) float lf32; lf32*fe=(lf32*)(lds+16384);
    for(int i=tid;i<NHEAD*(SEQ/KVBLK);i+=NW*64) fe[i]=T.F2[(size_t)(i>>8)*SEQ+64*(i&255)+63];
    asm volatile("s_waitcnt vmcnt(0) lgkmcnt(0)\n\ts_barrier":::"memory");
    for(int u=tid;u<NHEAD*NQB;u+=NW*64){ const int h=u>>6,qb=u&63;
      const float U=sqrtf(Q.kqmax[h]*Q.kqmax[16+h]); const int dk_=((const int*)Q.kqmax)[64+h*64+qb]; const float dmin=__int_as_float(dk_^((dk_>>31)&0x7fffffff));
      const float lim=T.F2[(size_t)h*SEQ+qb*QB]+U-dmin+PRUNE_LOG2;
      int lo=0,hi=4*qb;
      while(lo<hi){ const int mid=(lo+hi)>>1; if(fe[h*256+mid]>lim)lo=mid+1; else hi=mid; }
      tst[u]=(unsigned short)(lo&~1); } }
  asm volatile("s_waitcnt lgkmcnt(0)\n\ts_barrier":::"memory");
  { lu32*key=(lu32*)(lds+8192);
    for(int u=tid;u<NHEAD*NQB;u+=NW*64) key[u]=((unsigned)(4*(u&63)+4-(int)tst[u])<<10)|(unsigned)(1023-u);
    asm volatile("s_waitcnt lgkmcnt(0)\n\ts_barrier":::"memory");
    for(int k=2;k<=NHEAD*NQB;k<<=1) for(int j=k>>1;j>0;j>>=1){
      const int i=((tid&~(j-1))<<1)|(tid&(j-1)),l=i|j; const unsigned a_=key[i],b_=key[l]; const bool desc=((i&k)==0);
      if((a_<b_)==desc){ key[i]=b_; key[l]=a_; }
      asm volatile("s_waitcnt lgkmcnt(0)\n\ts_barrier":::"memory"); }
    for(int r=tid;r<NHEAD*NQB;r+=NW*64) ord[r]=(unsigned short)(1023u-(key[r]&1023u)); }
  asm volatile("s_waitcnt lgkmcnt(0)\n\ts_barrier":::"memory");
  char*shm=lds+8192;
  for(;;){
    if(tid==0)tk[0]=__hip_atomic_fetch_add(Q.ticket,1u,__ATOMIC_RELAXED,__HIP_MEMORY_SCOPE_AGENT);
    asm volatile("s_waitcnt vmcnt(0) lgkmcnt(0)\n\ts_barrier":::"memory");
    const unsigned t=tk[0];
    asm volatile("s_waitcnt lgkmcnt(0)\n\ts_barrier":::"memory");
    if(t>=(unsigned)(NHEAD*NQB))break;
    const int u=ord[t],h=u>>6,qb=u&63,ts=tst[u];
    attn_unit<THRL>(0,h,qb,T.Q,T.K,T.V,T.O,T.F2+(size_t)h*SEQ,shm,wid_in,ts);
  }
}
#undef SBAR
#undef WAIT_BAR
}
#define GAS __attribute__((address_space(1)))
#define LAS __attribute__((address_space(3)))
typedef unsigned short bf16;
typedef unsigned v4u __attribute__((ext_vector_type(4)));
typedef float f32x4 __attribute__((ext_vector_type(4)));
typedef short bf16x8 __attribute__((ext_vector_type(8)));
typedef GAS unsigned gu32;
typedef GAS unsigned long long gu64;
#define RLX_AGENT __ATOMIC_RELAXED, __HIP_MEMORY_SCOPE_AGENT
#define LDS_WAIT() asm volatile("s_waitcnt lgkmcnt(0)" ::: "memory")
#define VM_WAIT() asm volatile("s_waitcnt vmcnt(0)" ::: "memory")
__device__ __forceinline__ unsigned long long rt() { return __builtin_amdgcn_s_memrealtime(); }
__device__ __forceinline__ unsigned f2bf(float f) { unsigned u = __builtin_bit_cast(unsigned, f); return (u + 0x7fffu + ((u >> 16) & 1u)) >> 16; }
__device__ __forceinline__ unsigned pk2(float lo, float hi) { return pg8::cvt_pk_bf16(lo, hi); }

#define XB_TMO      128
#define XB_XCNT(j)  (256  + 64 * (j))
#define XB_XSUB(j)  (1280 + 64 * (j))
#define XB_XGEN(j)  (2304 + 64 * (j))
#define XB_TOP      3328
#define XB_TOPGEN   3392
#define XCD_BAR_WORDS 3456
#define XB_SPIN_CAP (1u << 18)

__device__ __forceinline__ unsigned xb_ld(unsigned* p)              { return __hip_atomic_load(p, __ATOMIC_RELAXED, __HIP_MEMORY_SCOPE_AGENT); }
__device__ __forceinline__ unsigned xb_add(unsigned* p, unsigned v) { return __hip_atomic_fetch_add(p, v, __ATOMIC_RELAXED, __HIP_MEMORY_SCOPE_AGENT); }
__device__ __forceinline__ unsigned xb_xcc_id() { return (unsigned)__builtin_amdgcn_s_getreg((3 << 11) | 20) & 0xFu; }
#define XB_SPIN(cond, bar) do { unsigned _sp = 0; while (cond) { __builtin_amdgcn_s_sleep(1); \
    if ((++_sp & 255u) == 0u) { if (xb_ld(&(bar)[XB_TMO])) break; if (_sp > XB_SPIN_CAP) { atomicAdd(&(bar)[XB_TMO], 1u); break; } } } } while (0)

struct XcdBarrier {
    int wave;
    unsigned* bar; unsigned x;
    volatile LAS unsigned* st;
};

__device__ __forceinline__ XcdBarrier xcd_barrier_post(unsigned* bar, volatile LAS unsigned* st, int wave) {
    XcdBarrier b; b.wave = wave; b.bar = bar; b.x = xb_xcc_id(); b.st = st;
    if (wave == 0 && pg8::lane_now() == 0) (void)xb_add(&bar[XB_XCNT(b.x)], 1u);
    return b;
}
__device__ __forceinline__ void xcd_barrier_complete(unsigned* bar, unsigned x, unsigned& nloc, unsigned& nx) {
    const unsigned G = gridDim.x * gridDim.y * gridDim.z;
    unsigned sum, cnt, mine, sp = 0u;
    for (;;) {
        sum = 0u; cnt = 0u; mine = 0u;
#pragma unroll
        for (unsigned j = 0; j < 16; ++j) { const unsigned c = xb_ld(&bar[XB_XCNT(j)]); sum += c; cnt += (c > 0u) ? 1u : 0u; mine = (j == x) ? c : mine; }
        if (sum == G) break;
        __builtin_amdgcn_s_sleep(1);
        if ((++sp & 255u) == 0u) { if (xb_ld(&bar[XB_TMO])) break; if (sp > XB_SPIN_CAP) { atomicAdd(&bar[XB_TMO], 1u); break; } }
    }
    nloc = mine > 0u ? mine : 1u; nx = cnt > 0u ? cnt : 1u;
}

__device__ __forceinline__ void xcd_barrier(const XcdBarrier& b) {
    asm volatile("s_waitcnt vmcnt(0)" ::: "memory");
    __syncthreads();
    if (b.wave == 0 && pg8::lane_now() == 0) {
        unsigned* bar = b.bar;
        __builtin_amdgcn_s_waitcnt(0);
        unsigned nloc = b.st[0], nx = b.st[1];
        if (nloc == 0u) { xcd_barrier_complete(bar, b.x, nloc, nx); b.st[0] = nloc; b.st[1] = nx; }
        const unsigned old = xb_add(&bar[XB_XSUB(b.x)], 1u);
        const unsigned gen = old / nloc;
        if (old + 1u == (gen + 1u) * nloc) {
            __builtin_amdgcn_fence(__ATOMIC_RELEASE, "agent");
            asm volatile("s_waitcnt vmcnt(0)" ::: "memory");
            const unsigned og = xb_add(&bar[XB_TOP], 1u);
            const unsigned tg = og / nx;
            if (og + 1u == (tg + 1u) * nx) xb_add(&bar[XB_TOPGEN], 1u);
            else XB_SPIN(xb_ld(&bar[XB_TOPGEN]) == tg, bar);
            __builtin_amdgcn_fence(__ATOMIC_ACQUIRE, "agent");
            xb_add(&bar[XB_XGEN(b.x)], 1u);
            asm volatile("s_waitcnt vmcnt(0)" ::: "memory");
        } else {
            XB_SPIN(xb_ld(&bar[XB_XGEN(b.x)]) == gen, bar);
            __builtin_amdgcn_fence(__ATOMIC_ACQUIRE, "agent");
            asm volatile("s_waitcnt vmcnt(0)" ::: "memory");
        }
    }
    __syncthreads();
}
constexpr int NWAVES = 8;
constexpr int MP = pg8::MP, MS = pg8::MS, MT = pg8::MT, D = 1024, FF = 2816, NMODC = 9216;
constexpr int H_A = 16, HD = 64, DEC_B = 16, DEC_T = 16, PAST = 1024;
constexpr int D_INNER = 2048, SSD_H = 32, SSD_P = 64, SSD_N = 128, SSD_G = 4, CONV_DIM = 3072, D_IN = 10288;
constexpr int N_I1 = 25 * 256, N_I2 = 16 * 256;
constexpr float EPS = 1e-6f;
constexpr float LOG2E = 1.4426950408889634f;
constexpr int CQ = 0, CK = 1024, CV = 2048, CF = 3072, CZ = 3088, CX = 5136, CDT = 8208, CGA = 8240, CGS = 9264;
constexpr size_t O_Y = 0, O_KP = 17039360, O_VP = 33816576, O_LP = 50593792, O_SP = 50855936, O_CP = 51118080, O_KS = 51127296, O_VS = 51389440, O_LS = 51651584, O_SS = 51655680, O_CS = 55849984, O_END = 55997440;
constexpr size_t MiB = 1u << 20;
constexpr size_t WS_CTL = 0, CTL_ZERO_BYTES = 128 * 1024;
constexpr size_t WS_MOD = 1 * MiB, WS_F2 = 2 * MiB, WS_DT = 3 * MiB, WS_SSQ = 6 * MiB, WS_HALO = 9 * MiB;
constexpr size_t WS_W13A = 14 * MiB, WS_W2A = 25 * MiB, WS_WIN1 = 31 * MiB, WS_WIN2 = 44 * MiB, WS_WA = 52 * MiB, WS_WS = 54 * MiB, WS_WO = 58 * MiB, WS_W13B = 60 * MiB, WS_W2B = 71 * MiB;
constexpr size_t WS_HN = 77 * MiB, WS_QO = 110 * MiB, WS_KB = 143 * MiB, WS_VB = 176 * MiB, WS_XBC = 209 * MiB, WS_XCH = 307 * MiB, WS_XB = 309 * MiB, WS_END = 341 * MiB;
constexpr size_t WS_YB = WS_KB;
constexpr size_t WS_GATE = WS_XBC;
constexpr size_t WS_SSEG = WS_W13A, WS_DSEG = WS_W13A + 10 * MiB;
constexpr size_t WS_MA = WS_HN;
constexpr size_t WS_RSTD = WS_SSQ + 2560 * 1024;
static_assert(WS_SSQ + (size_t)16640 * 32 * 4 <= WS_RSTD && WS_RSTD + 16640 * 4 <= WS_HALO, "RSTD placement");
constexpr size_t WS_MERGED = WS_QO;
constexpr size_t WS_ACT2 = WS_XBC;
static_assert(WS_KB + (size_t)MT * 2048 * 2 <= WS_XBC && WS_XBC + (size_t)MT * 3072 * 2 <= WS_END && WS_HALO + 256 * 3 * 3072 * 2 <= WS_W13A && WS_W2B + (size_t)1024 * FF * 2 <= WS_HN, "ws map");
constexpr int CW_BAR = 4096, CW_KQ = 8192, CW_TICKET = 10240, CW_SEAM = 16384, SEAM_BANK = 64 * 64;
constexpr int RING_OFF = 0, RING_BYTES = 131072;
constexpr int LDSCTL_OFF = RING_BYTES, MISC_OFF = LDSCTL_OFF + 320;
constexpr int LDS_BYTES = 147456;

struct Frame {
    LAS unsigned char* lds; volatile LAS unsigned* MISC; gu32* ctl;
    int tid, lane, wave, vcu, G;
};
typedef const __attribute__((address_space(4))) unsigned long long* karg_p;
__device__ __forceinline__ karg_p kbase() { karg_p p = (karg_p)__builtin_amdgcn_kernarg_segment_ptr(); asm volatile("" : "+s"(p)); return p; }
__device__ __forceinline__ const float* kin(int i) { return (const float*)(const GAS float*)kbase()[i]; }
__device__ __forceinline__ float* kout() { return (float*)(GAS float*)kbase()[32]; }
__device__ __forceinline__ unsigned char* kws() { return (unsigned char*)(GAS unsigned char*)kbase()[33]; }
#define REFRESH(F) do { (F).lane = pg8::lane_now(); (F).tid = (F).wave * 64 + (F).lane; } while (0)
__device__ __forceinline__ float wave_sum(float v) {
#pragma unroll
    for (int o = 1; o < 64; o <<= 1) v += __shfl_xor(v, o);
    return v;
}
__device__ __forceinline__ float wave_max(float v) {
#pragma unroll
    for (int o = 1; o < 64; o <<= 1) v = fmaxf(v, __shfl_xor(v, o));
    return v;
}
__device__ __forceinline__ void p0_tr_item(const float* W, int ldw, int K, int srccol, bf16* WT, int drow, int nvalid, const float* kscale, LAS float* scr, int kb, int lane) {
    const int k0 = 64 * kb;
#pragma unroll
    for (int i = 0; i < 8; ++i) { const int kk = 8 * i + (lane >> 3), n4 = 4 * (lane & 7);
        f32x4 v = (n4 < nvalid) ? *(const GAS f32x4*)(W + (size_t)(k0 + kk) * ldw + srccol + n4) : (f32x4){0.f, 0.f, 0.f, 0.f};
        if (kscale) v = v * kscale[k0 + kk];
        LAS float* d = scr + kk * 33 + n4; d[0] = v.x; d[1] = v.y; d[2] = v.z; d[3] = v.w; }
    LDS_WAIT(); asm volatile("" ::: "memory");
    const int c = lane & 7;
#pragma unroll
    for (int j = 0; j < 4; ++j) { const int n = (lane >> 3) + 8 * j; const LAS float* s = scr + (8 * c) * 33 + n;
        v4u o; o.x = pk2(s[0 * 33], s[1 * 33]); o.y = pk2(s[2 * 33], s[3 * 33]); o.z = pk2(s[4 * 33], s[5 * 33]); o.w = pk2(s[6 * 33], s[7 * 33]);
        if (n < nvalid) *(GAS v4u*)(WT + (size_t)(drow + n) * K + k0 + 8 * c) = o; }
    LDS_WAIT(); asm volatile("" ::: "memory");
}
constexpr int IT_W13 = 2 * (D / 64) * (FF / 32), IT_W2 = (FF / 64) * (D / 32), IT_FFN = IT_W13 + IT_W2;
__device__ __forceinline__ void p0_ffn_item(const float* w1, const float* w3, const float* w2, bf16* W13, bf16* W2t, LAS float* scr, int r, int lane) {
    if (r < IT_W13) { const int which = r / (IT_W13 / 2), q = r % (IT_W13 / 2), kb = q / (FF / 32), nb = q % (FF / 32), j0 = 32 * nb;
        p0_tr_item(which ? w3 : w1, FF, D, j0, W13, 256 * (j0 / 128) + (j0 % 128) + 128 * which, 32, nullptr, scr, kb, lane); }
    else { r -= IT_W13; const int kb = r / (D / 32), nb = r % (D / 32); p0_tr_item(w2, D, FF, 32 * nb, W2t, 32 * nb, 32, nullptr, scr, kb, lane); }
}
template <int CLS>
__device__ __forceinline__ void p0_prologue(Frame& F) {
    REFRESH(F);
    LAS float* scr = (LAS float*)(F.lds + RING_OFF + F.wave * 16384);
    const bool split0 = CLS == 0 && F.G == 256; const bool ada_wg = F.vcu < NMODC / 64;
    const int gw = split0 ? (F.vcu - NMODC / 64) * NWAVES + F.wave : F.vcu * NWAVES + F.wave, NGW = split0 ? (256 - NMODC / 64) * NWAVES : F.G * NWAVES;
    bf16* W13A = (bf16*)(kws() + WS_W13A); bf16* W2A = (bf16*)(kws() + WS_W2A); bf16* W13B = (bf16*)(kws() + WS_W13B); bf16* W2B = (bf16*)(kws() + WS_W2B);
    bf16* WIN1 = (bf16*)(kws() + WS_WIN1); bf16* WIN2 = (bf16*)(kws() + WS_WIN2); bf16* WA = (bf16*)(kws() + WS_WA); bf16* WSs = (bf16*)(kws() + WS_WS); bf16* WO = (bf16*)(kws() + WS_WO);
    const float* w_in = kin(16);
    constexpr int KB16 = D / 64;
    constexpr int IT_IN1 = KB16 * ((3072 + 3072) / 32), IT_F = KB16, IT_DT = KB16, IT_IN2 = KB16 * (4096 / 32), IT_A = KB16 * 32, IT_S = 32 * 32, IT_O = KB16 * 32;
    constexpr int NITEMS = 2 * IT_FFN + IT_IN1 + IT_F + IT_DT + IT_IN2 + IT_A + IT_S + IT_O;
    for (int it = (split0 && ada_wg) ? NITEMS : gw; it < NITEMS; it += NGW) {
        int r = it;
        { const int cls = it < IT_FFN ? 0 : (it < 2 * IT_FFN ? 2 : (it < 2 * IT_FFN + IT_IN1 + IT_F + IT_DT ? 1 : 2)); if (cls != CLS) continue; }
        if (r < IT_FFN) { p0_ffn_item(kin(12), kin(13), kin(14), W13A, W2A, scr, r, F.lane); continue; } r -= IT_FFN;
        if (r < IT_FFN) { p0_ffn_item(kin(28), kin(29), kin(30), W13B, W2B, scr, r, F.lane); continue; } r -= IT_FFN;
        if (r < IT_IN1) { const int kb = r / 192, nb = r % 192, j0 = 32 * nb;
            p0_tr_item(w_in, D_IN, D, j0 < 3072 ? j0 : CX + (j0 - 3072), WIN1, j0, 32, nullptr, scr, kb, F.lane); continue; } r -= IT_IN1;
        if (r < IT_F) { p0_tr_item(w_in, D_IN, D, CF, WIN1, 6144, 16, nullptr, scr, r, F.lane); continue; } r -= IT_F;
        if (r < IT_DT) { p0_tr_item(w_in, D_IN, D, CDT, WIN1, 6144 + 16, 32, nullptr, scr, r, F.lane); continue; } r -= IT_DT;
        if (r < IT_IN2) { const int kb = r / 128, nb = r % 128, j0 = 32 * nb;
            p0_tr_item(w_in, D_IN, D, j0 < 2048 ? CZ + j0 : (j0 < 3072 ? CGA + (j0 - 2048) : CGS + (j0 - 3072)), WIN2, j0, 32, nullptr, scr, kb, F.lane); continue; } r -= IT_IN2;
        if (r < IT_A) { p0_tr_item(kin(24), D, D, 32 * (r % 32), WA, 32 * (r % 32), 32, nullptr, scr, r / 32, F.lane); continue; } r -= IT_A;
        if (r < IT_S) { p0_tr_item(kin(25), D, D_INNER, 32 * (r % 32), WSs, 32 * (r % 32), 32, kin(23), scr, r / 32, F.lane); continue; } r -= IT_S;
        p0_tr_item(kin(26), D, D, 32 * (r % 32), WO, 32 * (r % 32), 32, nullptr, scr, r / 32, F.lane);
    }
    if (CLS != 0) return;
    { GAS v4u* z = (GAS v4u*)(WIN1 + (size_t)(6144 + 48) * D); const int n16 = 208 * D * 2 / 16; const v4u zero = {0u, 0u, 0u, 0u};
      for (int i = (split0 && ada_wg) ? n16 : gw * 64 + F.lane; i < n16; i += NGW * 64) z[i] = zero; }
    if (split0 && !ada_wg) return;
    __syncthreads();
    LAS float* sc = (LAS float*)(F.lds + RING_OFF);
    LAS float* red = (LAS float*)(F.lds + RING_OFF + 69632);
    for (int i = F.tid; i < 17 * 1024; i += NWAVES * 64) { const int rr = i >> 10, k = i & 1023; const float c = rr == 0 ? kin(2)[k] : kin(3)[(size_t)(rr - 1) * 1024 + k]; sc[i] = pg8::silu(c); }
    __syncthreads();
    const float* w_ada = kin(9); const float* b_ada = kin(10); float* mod = (float*)(kws() + WS_MOD);
    for (int un = F.vcu; un < NMODC / 64; un += F.G) {
        typedef float f32x2v __attribute__((ext_vector_type(2)));
        const int cp = F.lane & 31, kh = F.lane >> 5, kg = F.wave, col = un * 64 + 2 * cp, kb = kg * 128 + kh * 64;
        f32x2v a[17];
#pragma unroll
        for (int rr = 0; rr < 17; ++rr) a[rr] = (f32x2v){0.f, 0.f};
#pragma unroll 1
        for (int k0 = kb; k0 < kb + 64; k0 += 8) {
            f32x2v w[8];
#pragma unroll
            for (int i = 0; i < 8; ++i) w[i] = *(const f32x2v*)(w_ada + (size_t)(k0 + i) * NMODC + col);
#pragma unroll
            for (int i = 0; i < 8; ++i) {
#pragma unroll
                for (int rr = 0; rr < 17; ++rr) a[rr] += sc[rr * 1024 + k0 + i] * w[i];
                if ((i & 1) == 1) __builtin_amdgcn_sched_barrier(0); } }
#pragma unroll
        for (int rr = 0; rr < 17; ++rr) { a[rr].x += pg8::xor_lane(a[rr].x, F.lane, 32); a[rr].y += pg8::xor_lane(a[rr].y, F.lane, 32); }
        if (kh == 0) {
#pragma unroll
            for (int rr = 0; rr < 17; ++rr) *(LAS f32x2v*)(red + (kg * 17 + rr) * 64 + 2 * cp) = a[rr]; }
        __syncthreads();
        int i0_ = F.tid; asm volatile("" : "+v"(i0_));
        for (int i = i0_; i < 17 * 64; i += NWAVES * 64) { const int rr = i >> 6, cc = i & 63; float s = b_ada[un * 64 + cc];
#pragma unroll
            for (int g = 0; g < 8; ++g) s += red[(g * 17 + rr) * 64 + cc];
            mod[(size_t)rr * NMODC + un * 64 + cc] = s; }
        __syncthreads();
    }
}
__device__ __forceinline__ void norm_phase(Frame& F, const float* xp, const float* xs, const float* g, int chunk_shift, bf16* HN, int m_lo = 0) {
    REFRESH(F);
    const int gw = F.vcu * NWAVES + F.wave, NGW = F.G * NWAVES; const float* mod = (const float*)(kws() + WS_MOD);
    for (int m = m_lo + gw; m < MT; m += NGW) {
        const float* xrow = m < MP ? xp + (size_t)m * D : xs + (size_t)(m - MP) * D;
        const float* sh = mod + (size_t)pg8::bidx(m) * NMODC + chunk_shift * 1024; const float* scl = sh + 1024;
        const GAS f32x4* xr = (const GAS f32x4*)xrow + F.lane;
        f32x4 v[4]; float s = 0.f;
#pragma unroll
        for (int j = 0; j < 4; ++j) { v[j] = xr[64 * j]; s += (v[j].x * v[j].x + v[j].y * v[j].y) + (v[j].z * v[j].z + v[j].w * v[j].w); }
        const float rstd = 1.0f / sqrtf(wave_sum(s) * (1.f / D) + EPS);
        GAS unsigned long long* o8 = (GAS unsigned long long*)(HN + (size_t)m * D) + F.lane;
#pragma unroll
        for (int j = 0; j < 4; ++j) { const int c = 4 * (F.lane + 64 * j); const f32x4 gg = *(const f32x4*)(g + c), s1 = *(const f32x4*)(scl + c), s0 = *(const f32x4*)(sh + c);
            const f32x4 o = v[j] * rstd * gg * (s1 + 1.0f) + s0;
            o8[64 * j] = (unsigned long long)pk2(o.x, o.y) | ((unsigned long long)pk2(o.z, o.w) << 32); }
    }
}
__device__ __forceinline__ void final_norm_phase(Frame& F, float* X, const float* g, int m_lo = 0) {
    REFRESH(F);
    const int gw = F.vcu * NWAVES + F.wave, NGW = F.G * NWAVES;
    for (int m = m_lo + gw; m < MT; m += NGW) {
        GAS f32x4* xr = (GAS f32x4*)(X + (size_t)m * D) + F.lane;
        f32x4 v[4]; float s = 0.f;
#pragma unroll
        for (int j = 0; j < 4; ++j) { v[j] = xr[64 * j]; s += (v[j].x * v[j].x + v[j].y * v[j].y) + (v[j].z * v[j].z + v[j].w * v[j].w); }
        const float rstd = 1.0f / sqrtf(wave_sum(s) * (1.f / D) + EPS);
#pragma unroll
        for (int j = 0; j < 4; ++j) { const f32x4 gg = *(const f32x4*)(g + 4 * (F.lane + 64 * j)); xr[64 * j] = v[j] * rstd * gg; }
    }
}
__device__ __forceinline__ void qknorm_phase(Frame& F) {
    REFRESH(F);
    const bf16* QO = (const bf16*)(kws() + WS_QO); const bf16* KB = (const bf16*)(kws() + WS_KB); unsigned* kq = (unsigned*)(kws() + WS_CTL) + CW_KQ;
    const int gw = F.vcu * NWAVES + F.wave, NGW = F.G * NWAVES; float mq = 0.f, mk = 0.f;
#pragma unroll 4
    for (int m = gw; m < MP; m += NGW) {
        const v4u* qp = (const v4u*)(QO + (size_t)m * D + 16 * F.lane); const v4u* kp = (const v4u*)(KB + (size_t)m * D + 16 * F.lane);
        float sq = 0.f, sk = 0.f, sd = 0.f;
#pragma unroll
        for (int i = 0; i < 2; ++i) { const v4u a = qp[i], b = kp[i]; const unsigned* aw = (const unsigned*)&a; const unsigned* bw = (const unsigned*)&b;
#pragma unroll
            for (int j = 0; j < 4; ++j) { const float a0 = pg8::bflo(aw[j]), a1 = pg8::bfhi(aw[j]), b0 = pg8::bflo(bw[j]), b1 = pg8::bfhi(bw[j]); sq += a0 * a0 + a1 * a1; sk += b0 * b0 + b1 * b1; sd += a0 * b0 + a1 * b1; } }
        sq += __shfl_xor(sq, 1); sq += __shfl_xor(sq, 2); sk += __shfl_xor(sk, 1); sk += __shfl_xor(sk, 2); sd += __shfl_xor(sd, 1); sd += __shfl_xor(sd, 2);
        mq = fmaxf(mq, sq); mk = fmaxf(mk, sk);
        if ((F.lane & 3) == 0) { const int b_ = __float_as_int(fminf(sd, 0.f)); atomicMin((int*)kq + 64 + (F.lane >> 2) * 64 + (m >> 8), b_ ^ ((b_ >> 31) & 0x7fffffff)); }
    }
    if ((F.lane & 3) == 0) { atomicMax(kq + (F.lane >> 2), __float_as_uint(mq)); atomicMax(kq + 16 + (F.lane >> 2), __float_as_uint(mk)); }
}
__device__ __forceinline__ void fcum_halo_phase(Frame& F) {
    REFRESH(F);
    const float* logf = kout() + O_LP; float* F2 = (float*)(kws() + WS_F2);
    LAS float* part = (LAS float*)(F.lds + RING_OFF);
    if (F.vcu < H_A) {
        const int h = F.vcu; float loc[32]; float s = 0.f;
#pragma unroll
        for (int i = 0; i < 32; ++i) { loc[i] = logf[(size_t)(32 * F.tid + i) * H_A + h]; s += loc[i]; }
        float v = s;
#pragma unroll
        for (int o = 1; o < 64; o <<= 1) { const float nn = __shfl_up(v, o); if (F.lane >= o) v += nn; }
        if (F.lane == 63) part[F.wave] = v;
        __syncthreads();
        float run = v - s;
#pragma unroll
        for (int w = 0; w < 8; ++w) run += (w < F.wave) ? part[w] : 0.f;
#pragma unroll
        for (int i = 0; i < 32; ++i) { run += loc[i]; F2[(size_t)h * MP + 32 * F.tid + i] = run * LOG2E; }
        __syncthreads();
    }
}
__device__ __forceinline__ void conv_phase(Frame& F) {
    REFRESH(F);
    bf16* XBC = (bf16*)(kws() + WS_XBC); const bf16* HALO = (const bf16*)(kws() + WS_HALO);
    const float* cw = kin(18); const float* cb = kin(19); const float* sconv = kin(8);
    for (int un = F.vcu; un < 256 + DEC_B; un += F.G) {
        const bool smp = un >= 256; const int row0 = smp ? MP + 16 * (un - 256) : 64 * un, nrows = smp ? 16 : 64;
        if (F.tid < CONV_DIM / 8) {
            const int c = 8 * F.tid; float w[4][8], bb[8], p0[8], p1[8], p2[8];
#pragma unroll
            for (int j = 0; j < 8; ++j) { w[0][j] = cw[c + j]; w[1][j] = cw[CONV_DIM + c + j]; w[2][j] = cw[2 * CONV_DIM + c + j]; w[3][j] = cw[3 * CONV_DIM + c + j]; bb[j] = cb[c + j]; }
            if (smp) { const float* s = sconv + (size_t)(un - 256) * 3 * CONV_DIM + c;
#pragma unroll
                for (int j = 0; j < 8; ++j) { p0[j] = s[j]; p1[j] = s[CONV_DIM + j]; p2[j] = s[2 * CONV_DIM + j]; } }
            else if (un == 0) {
#pragma unroll
                for (int j = 0; j < 8; ++j) { p0[j] = 0.f; p1[j] = 0.f; p2[j] = 0.f; } }
            else { const v4u h0 = *(const GAS v4u*)(HALO + (size_t)un * 3 * CONV_DIM + c), h1 = *(const GAS v4u*)(HALO + (size_t)un * 3 * CONV_DIM + CONV_DIM + c), h2 = *(const GAS v4u*)(HALO + (size_t)un * 3 * CONV_DIM + 2 * CONV_DIM + c);
                const unsigned* a0 = (const unsigned*)&h0; const unsigned* a1 = (const unsigned*)&h1; const unsigned* a2 = (const unsigned*)&h2;
#pragma unroll
                for (int j = 0; j < 8; ++j) { p0[j] = (j & 1) ? pg8::bfhi(a0[j >> 1]) : pg8::bflo(a0[j >> 1]); p1[j] = (j & 1) ? pg8::bfhi(a1[j >> 1]) : pg8::bflo(a1[j >> 1]); p2[j] = (j & 1) ? pg8::bfhi(a2[j >> 1]) : pg8::bflo(a2[j >> 1]); } }
            GAS v4u* col = (GAS v4u*)(XBC + (size_t)row0 * CONV_DIM + c);
#pragma unroll 1
            for (int t0 = 0; t0 < nrows; t0 += 16) {
                v4u rvs[16];
#pragma unroll
                for (int i = 0; i < 16; ++i) rvs[i] = col[(size_t)(t0 + i) * (CONV_DIM / 8)];
#pragma unroll
                for (int i = 0; i < 16; ++i) { const unsigned* rw = (const unsigned*)&rvs[i]; float o[8];
#pragma unroll
                    for (int j = 0; j < 8; ++j) { const float v = (j & 1) ? pg8::bfhi(rw[j >> 1]) : pg8::bflo(rw[j >> 1]);
                        o[j] = pg8::silu(bb[j] + w[0][j] * p0[j] + w[1][j] * p1[j] + w[2][j] * p2[j] + w[3][j] * v); p0[j] = p1[j]; p1[j] = p2[j]; p2[j] = v; }
                    v4u ov; ov.x = pk2(o[0], o[1]); ov.y = pk2(o[2], o[3]); ov.z = pk2(o[4], o[5]); ov.w = pk2(o[6], o[7]);
                    col[(size_t)(t0 + i) * (CONV_DIM / 8)] = ov; }
            }
        }
    }
}
__device__ __forceinline__ void ssd_seq(const bf16* XBC, bf16* YB, const float* DT, int row0, int nrows, int h, int p, float a, float dsk, float& h0, float& h1, int lane) {
    const int g = h >> 3; constexpr int U = 8;
    const bf16* xcol = XBC + (size_t)row0 * CONV_DIM + 64 * h + p; bf16* ycol = YB + (size_t)row0 * D_INNER + 64 * h + p;
    const unsigned* Bp = (const unsigned*)(XBC + (size_t)row0 * CONV_DIM + 2048 + 128 * g) + lane;
    const unsigned* Cp = (const unsigned*)(XBC + (size_t)row0 * CONV_DIM + 2560 + 128 * g) + lane;
    const float* dtp = DT + (size_t)row0 * 32 + h;
    unsigned bq[U], cq[U]; float xq[U], dq[U];
#pragma unroll
    for (int i = 0; i < U; ++i) { bq[i] = Bp[(size_t)i * (CONV_DIM / 2)]; cq[i] = Cp[(size_t)i * (CONV_DIM / 2)]; xq[i] = pg8::bf2f(xcol[(size_t)i * CONV_DIM]); dq[i] = dtp[(size_t)i * 32]; }
    for (int t0 = 0; t0 < nrows; t0 += U) {
        unsigned bn[U], cn[U]; float xn[U], dn[U];
        const int tn = (t0 + U < nrows) ? t0 + U : t0;
#pragma unroll
        for (int i = 0; i < U; ++i) { bn[i] = Bp[(size_t)(tn + i) * (CONV_DIM / 2)]; cn[i] = Cp[(size_t)(tn + i) * (CONV_DIM / 2)]; xn[i] = pg8::bf2f(xcol[(size_t)(tn + i) * CONV_DIM]); dn[i] = dtp[(size_t)(tn + i) * 32]; }
        float yv[U];
#pragma unroll
        for (int i = 0; i < U; ++i) {
            const float dA = __expf(dq[i] * a), cf = dq[i] * xq[i];
            h0 = dA * h0 + cf * pg8::bflo(bq[i]); h1 = dA * h1 + cf * pg8::bfhi(bq[i]);
            yv[i] = wave_sum(pg8::bflo(cq[i]) * h0 + pg8::bfhi(cq[i]) * h1) + dsk * xq[i];
        }
        if (lane == 0) {
#pragma unroll
            for (int i = 0; i < U; ++i) ycol[(size_t)(t0 + i) * D_INNER] = (bf16)f2bf(yv[i]);
        }
#pragma unroll
        for (int i = 0; i < U; ++i) { bq[i] = bn[i]; cq[i] = cn[i]; xq[i] = xn[i]; dq[i] = dn[i]; }
    }
}
__device__ __forceinline__ void ssd_sample_rec(Frame& F) {
    const bf16* XBC = (const bf16*)(kws() + WS_XBC); bf16* YB = (bf16*)(kws() + WS_YB); const float* DT = (const float*)(kws() + WS_DT);
    const float* a_log = kin(21); const float* dskip = kin(22); const float* sssm = kin(7);
    for (int un = F.vcu; un < DEC_B * SSD_H / 2; un += F.G) {
        const int pi = 2 * un + (F.tid >> 8), b = pi >> 5, h = pi & 31, g = h >> 3, p = (F.tid & 255) >> 2, q = F.tid & 3;
        const float a = -__expf(a_log[h]), dsk = dskip[h];
        typedef float f32x2v __attribute__((ext_vector_type(2)));
        f32x2v hs[16];
        { const f32x4* sp = (const f32x4*)(sssm + (((size_t)b * SSD_H + h) * SSD_P + p) * SSD_N + 32 * q);
#pragma unroll
          for (int j = 0; j < 8; ++j) { const f32x4 v = sp[j]; hs[2 * j] = (f32x2v){v.x, v.y}; hs[2 * j + 1] = (f32x2v){v.z, v.w}; } }
        LAS unsigned char* SL = F.lds + RING_OFF + (F.tid >> 8) * 18688;
        { const int ht = F.tid & 255, tok = ht >> 4, pc = ht & 15; const size_t row = (size_t)MP + 16 * b + tok;
          const v4u bv = *(const v4u*)(XBC + row * CONV_DIM + 2048 + 128 * g + 8 * pc), cv = *(const v4u*)(XBC + row * CONV_DIM + 2560 + 128 * g + 8 * pc);
          LAS f32x4* bd = (LAS f32x4*)(SL + tok * 512 + pc * 32); LAS f32x4* cd = (LAS f32x4*)(SL + 8192 + tok * 512 + pc * 32);
          bd[0] = (f32x4){pg8::bflo(bv.x), pg8::bfhi(bv.x), pg8::bflo(bv.y), pg8::bfhi(bv.y)}; bd[1] = (f32x4){pg8::bflo(bv.z), pg8::bfhi(bv.z), pg8::bflo(bv.w), pg8::bfhi(bv.w)};
          cd[0] = (f32x4){pg8::bflo(cv.x), pg8::bfhi(cv.x), pg8::bflo(cv.y), pg8::bfhi(cv.y)}; cd[1] = (f32x4){pg8::bflo(cv.z), pg8::bfhi(cv.z), pg8::bflo(cv.w), pg8::bfhi(cv.w)};
          if (pc < 8) *(LAS v4u*)(SL + 16384 + tok * 128 + pc * 16) = *(const v4u*)(XBC + row * CONV_DIM + 64 * h + 8 * pc);
          if (pc == 8) *(LAS float*)(SL + 18432 + tok * 4) = DT[row * 32 + h]; }
        __syncthreads();
#pragma unroll 2
        for (int t = 0; t < DEC_T; ++t) {
            const size_t row = (size_t)MP + 16 * b + t;
            const float dtv = *(const LAS float*)(SL + 18432 + t * 4), xv = pg8::bf2f(*(const LAS unsigned short*)(SL + 16384 + t * 128 + p * 2));
            const LAS f32x4* bp = (const LAS f32x4*)(SL + t * 512 + 128 * q); const LAS f32x4* cp = (const LAS f32x4*)(SL + 8192 + t * 512 + 128 * q);
            const float dA = __expf(dtv * a), cf = dtv * xv; f32x2v part2 = (f32x2v){0.f, 0.f};
#pragma unroll
            for (int j = 0; j < 8; ++j) { const f32x4 bv = bp[j], cv = cp[j];
                hs[2 * j] = dA * hs[2 * j] + cf * (f32x2v){bv.x, bv.y}; part2 += (f32x2v){cv.x, cv.y} * hs[2 * j];
                hs[2 * j + 1] = dA * hs[2 * j + 1] + cf * (f32x2v){bv.z, bv.w}; part2 += (f32x2v){cv.z, cv.w} * hs[2 * j + 1]; }
            float part = part2.x + part2.y;
            part += __shfl_xor(part, 1); part += __shfl_xor(part, 2);
            if (q == 0) YB[row * D_INNER + 64 * h + p] = (bf16)f2bf(part + dsk * xv);
        }
        __syncthreads();
        { f32x4* so = (f32x4*)(kout() + O_SS + (((size_t)b * SSD_H + h) * SSD_P + p) * SSD_N + 32 * q);
#pragma unroll
          for (int j = 0; j < 8; ++j) so[j] = (f32x4){hs[2 * j].x, hs[2 * j].y, hs[2 * j + 1].x, hs[2 * j + 1].y}; }
    }
}
template <class Epi>
__device__ __forceinline__ void skinny_gemm(Frame& F, const bf16* A, int lda, const bf16* Bt, int K, const Epi& E, int NB = 32) {
    REFRESH(F);
    typedef short bf16x8 __attribute__((ext_vector_type(8)));
    LAS float* red = (LAS float*)(F.lds + RING_OFF);
    const int lane = F.lane, wave = F.wave, l15 = lane & 15, quad = lane >> 4, kw = K / 8;
    for (int v = F.vcu; v < 8 * NB; v += F.G) {
        const int row0 = MP + 32 * (v / NB), col0 = 32 * (v % NB);
        const bf16* ap = A + (size_t)(row0 + l15) * lda + wave * kw + 8 * quad; const bf16* bp = Bt + (size_t)(col0 + l15) * K + wave * kw + 8 * quad;
        f32x4 acc[2][2];
#pragma unroll
        for (int i = 0; i < 2; ++i)
#pragma unroll
            for (int j = 0; j < 2; ++j) acc[i][j] = (f32x4){0.f, 0.f, 0.f, 0.f};
#pragma unroll 4
        for (int k0 = 0; k0 < kw; k0 += 32) {
            const bf16x8 a0 = *(const bf16x8*)(ap + k0), a1 = *(const bf16x8*)(ap + (size_t)16 * lda + k0), b0 = *(const bf16x8*)(bp + k0), b1 = *(const bf16x8*)(bp + (size_t)16 * K + k0);
            acc[0][0] = __builtin_amdgcn_mfma_f32_16x16x32_bf16(a0, b0, acc[0][0], 0, 0, 0); acc[0][1] = __builtin_amdgcn_mfma_f32_16x16x32_bf16(a0, b1, acc[0][1], 0, 0, 0);
            acc[1][0] = __builtin_amdgcn_mfma_f32_16x16x32_bf16(a1, b0, acc[1][0], 0, 0, 0); acc[1][1] = __builtin_amdgcn_mfma_f32_16x16x32_bf16(a1, b1, acc[1][1], 0, 0, 0);
        }
#pragma unroll
        for (int i = 0; i < 2; ++i)
#pragma unroll
            for (int j = 0; j < 2; ++j)
#pragma unroll
                for (int r = 0; r < 4; ++r) red[(wave * 32 + 16 * i + 4 * quad + r) * 33 + 16 * j + l15] = acc[i][j][r];
        __syncthreads();
        for (int i = F.tid; i < 1024; i += NWAVES * 64) { const int rr = i >> 5, cc = i & 31; float s = 0.f;
#pragma unroll
            for (int w = 0; w < 8; ++w) s += red[(w * 32 + rr) * 33 + cc];
            E.elem(row0 + rr, col0 + cc, s); }
        __syncthreads();
    }
}
__device__ __forceinline__ void ssq_sample_pass(Frame& F) {
    REFRESH(F);
    const bf16* Y = (const bf16*)(kws() + WS_YB); float* SSQ = (float*)(kws() + WS_SSQ);
    const int gw = F.vcu * NWAVES + F.wave, NGW = F.G * NWAVES;
    for (int r = gw; r < MS; r += NGW) {
        const v4u* yp = (const v4u*)(Y + (size_t)(MP + r) * D_INNER) + F.lane; float s = 0.f;
#pragma unroll
        for (int i = 0; i < 4; ++i) { const v4u a = yp[64 * i]; const unsigned* aw = (const unsigned*)&a;
#pragma unroll
            for (int j = 0; j < 4; ++j) { const float a0 = pg8::bflo(aw[j]), a1 = pg8::bfhi(aw[j]); s += a0 * a0 + a1 * a1; } }
        s = wave_sum(s);
        if (F.lane < 32) SSQ[(size_t)(MP + r) * 32 + F.lane] = F.lane == 0 ? s : 0.f;
        if (F.lane == 0) ((float*)(kws() + WS_RSTD))[MP + r] = __builtin_amdgcn_rsqf(s * (1.0f / 2048.0f) + EPS);
    }
    { float* RS = (float*)(kws() + WS_RSTD);
      for (int r = F.vcu * (NWAVES * 64) + F.tid; r < MP; r += F.G * NWAVES * 64) { const f32x4* sp = (const f32x4*)(SSQ + (size_t)r * 32); f32x4 s4 = sp[0];
#pragma unroll
          for (int i = 1; i < 8; ++i) s4 = s4 + sp[i];
          RS[r] = __builtin_amdgcn_rsqf(((s4[0] + s4[1]) + (s4[2] + s4[3])) * (1.0f / 2048.0f) + EPS); } }
}
__device__ __forceinline__ void attn_sample_phase(Frame& F, bf16* OUT = nullptr) {
    REFRESH(F);
    constexpr int NK = PAST + DEC_T, NKP = 1056;
    typedef short bf16x8 __attribute__((ext_vector_type(8)));
    const float* ck = kin(4); const float* cv = kin(5); const float* clf = kin(6);
    bf16* QO = (bf16*)(kws() + WS_QO); const bf16* KB = (const bf16*)(kws() + WS_KB); const bf16* VB = (const bf16*)(kws() + WS_VB);
    LAS unsigned char* L = F.lds + RING_OFF;
    LAS float* fall = (LAS float*)L;
    LAS float* pt = fall + NKP;
    LAS float* red = pt + NKP * 16;
    LAS float* stat = red + 8 * 1024;
    const int lane = F.lane, wave = F.wave, tid = F.tid, l15 = lane & 15, quad = lane >> 4;
    unsigned* stk = (unsigned*)(kws() + WS_CTL) + CW_TICKET + 64;
    for (;;) {
        if (tid == 0) ((LAS unsigned*)stat)[40] = __hip_atomic_fetch_add(stk, 1u, __ATOMIC_RELAXED, __HIP_MEMORY_SCOPE_AGENT);
        __syncthreads();
        const int un = (int)((LAS unsigned*)stat)[40];
        __syncthreads();
        if (un >= DEC_B * H_A) break;
        const int b = un >> 4, h = un & 15;
        { const float l0 = clf[((size_t)b * PAST + 2 * tid) * H_A + h], l1 = clf[((size_t)b * PAST + 2 * tid + 1) * H_A + h];
          float v = l0 + l1;
#pragma unroll
          for (int o = 1; o < 64; o <<= 1) { const float nn = __shfl_up(v, o); if (lane >= o) v += nn; }
          if (lane == 63) stat[32 + wave] = v;
          __syncthreads();
          float base = 0.f;
#pragma unroll
          for (int w = 0; w < 8; ++w) base += (w < wave) ? stat[32 + w] : 0.f;
          const float incl = base + v;
          fall[2 * tid] = (incl - l1) * LOG2E; fall[2 * tid + 1] = incl * LOG2E;
          __syncthreads();
          if (wave == 0) { float nv = lane < DEC_T ? kout()[O_LS + ((size_t)b * DEC_T + lane) * H_A + h] : 0.f;
#pragma unroll
              for (int o = 1; o < 16; o <<= 1) { const float nn = __shfl_up(nv, o); if (lane >= o) nv += nn; }
              if (lane < DEC_T) fall[PAST + lane] = fall[PAST - 1] + nv * LOG2E; else if (lane < 32) fall[PAST + lane] = 0.f; }
          __syncthreads(); }
        { const bf16* qp = QO + (size_t)(MP + 16 * b + l15) * D + 64 * h + 8 * quad;
          const bf16x8 qa0 = *(const bf16x8*)qp, qa1 = *(const bf16x8*)(qp + 32);
          f32x4 kr[8][4];
#pragma unroll
          for (int i = 0; i < 8; ++i) { const f32x4* kp = (const f32x4*)(ck + (((size_t)b * PAST + 16 * (wave + 8 * i) + l15) * H_A + h) * HD + 8 * quad); kr[i][0] = kp[0]; kr[i][1] = kp[1]; kr[i][2] = kp[8]; kr[i][3] = kp[9]; }
#pragma unroll
          for (int i = 0; i < 9; ++i) {
              const int kb = wave + 8 * i; if (kb >= NKP / 16) break;
              const int key = 16 * kb + l15; bf16x8 k0, k1;
              if (i < 8) { const f32x4 a0 = kr[i & 7][0], a1 = kr[i & 7][1], a2 = kr[i & 7][2], a3 = kr[i & 7][3];
                  { const v4u w0 = {pg8::cvt_pk_bf16(a0.x, a0.y), pg8::cvt_pk_bf16(a0.z, a0.w), pg8::cvt_pk_bf16(a1.x, a1.y), pg8::cvt_pk_bf16(a1.z, a1.w)}, w1 = {pg8::cvt_pk_bf16(a2.x, a2.y), pg8::cvt_pk_bf16(a2.z, a2.w), pg8::cvt_pk_bf16(a3.x, a3.y), pg8::cvt_pk_bf16(a3.z, a3.w)};
                    k0 = __builtin_bit_cast(bf16x8, w0); k1 = __builtin_bit_cast(bf16x8, w1); } }
              else if (key < NK) { const bf16* kp = KB + (size_t)(MP + 16 * b + (key - PAST)) * D + 64 * h + 8 * quad; k0 = *(const bf16x8*)kp; k1 = *(const bf16x8*)(kp + 32); }
              else { k0 = (bf16x8){0, 0, 0, 0, 0, 0, 0, 0}; k1 = k0; }
              f32x4 acc = (f32x4){0.f, 0.f, 0.f, 0.f};
              acc = __builtin_amdgcn_mfma_f32_16x16x32_bf16(qa0, k0, acc, 0, 0, 0);
              acc = __builtin_amdgcn_mfma_f32_16x16x32_bf16(qa1, k1, acc, 0, 0, 0);
              const float fk = fall[key];
#pragma unroll
              for (int r = 0; r < 4; ++r) { const int q = 4 * quad + r; const float s = acc[r] + fall[PAST + q] - fk;
                  pt[key * 16 + q] = (key >= NK || key - PAST > q) ? -INFINITY : s; }
          } }
        __syncthreads();
        for (int q = 2 * wave; q < 2 * wave + 2; ++q) {
            float mx = -INFINITY; for (int j = lane; j < NKP; j += 64) mx = fmaxf(mx, pt[j * 16 + q]); mx = wave_max(mx);
            float sm = 0.f; for (int j = lane; j < NKP; j += 64) sm += __builtin_amdgcn_exp2f(pt[j * 16 + q] - mx); sm = wave_sum(sm);
            if (lane == 0) { stat[q] = mx; stat[16 + q] = 1.0f / sm; }
        }
        __syncthreads();
        for (int i = tid; i < NKP * 16; i += NWAVES * 64) { const int q = i & 15; pt[i] = __builtin_amdgcn_exp2f(pt[i] - stat[q]) * stat[16 + q]; }
        __syncthreads();
        { f32x4 o[16];
#pragma unroll
          for (int q = 0; q < 16; ++q) o[q] = (f32x4){0.f, 0.f, 0.f, 0.f};
          const int ks = wave * 4 + quad;
#pragma unroll
          for (int jb = 0; jb < 2; ++jb) {
              f32x4 vr[16];
#pragma unroll
              for (int j = 0; j < 16; ++j) vr[j] = *(const f32x4*)(cv + (((size_t)b * PAST + ks + 32 * (16 * jb + j)) * H_A + h) * HD + 4 * l15);
#pragma unroll
              for (int j = 0; j < 16; ++j) { const f32x4 v = vr[j]; const LAS f32x4* pp = (const LAS f32x4*)(pt + (ks + 32 * (16 * jb + j)) * 16);
#pragma unroll
                  for (int q4 = 0; q4 < 4; ++q4) { const f32x4 p = pp[q4]; o[4 * q4] = o[4 * q4] + v * p.x; o[4 * q4 + 1] = o[4 * q4 + 1] + v * p.y; o[4 * q4 + 2] = o[4 * q4 + 2] + v * p.z; o[4 * q4 + 3] = o[4 * q4 + 3] + v * p.w; } }
          }
          { const int key = ks + PAST;
            if (key < NK) { const bf16* vp = VB + (size_t)(MP + 16 * b + (key - PAST)) * D + 64 * h + 4 * l15; const f32x4 v = (f32x4){pg8::bf2f(vp[0]), pg8::bf2f(vp[1]), pg8::bf2f(vp[2]), pg8::bf2f(vp[3])};
              const LAS f32x4* pp = (const LAS f32x4*)(pt + key * 16);
#pragma unroll
              for (int q4 = 0; q4 < 4; ++q4) { const f32x4 p = pp[q4]; o[4 * q4] = o[4 * q4] + v * p.x; o[4 * q4 + 1] = o[4 * q4 + 1] + v * p.y; o[4 * q4 + 2] = o[4 * q4 + 2] + v * p.z; o[4 * q4 + 3] = o[4 * q4 + 3] + v * p.w; } } }
#pragma unroll
          for (int q = 0; q < 16; ++q)
#pragma unroll
              for (int c = 0; c < 4; ++c) { float t = o[q][c]; t += __shfl_xor(t, 16); t += __shfl_xor(t, 32); o[q][c] = t; }
          if (quad == 0) {
#pragma unroll
              for (int q = 0; q < 16; ++q) *(LAS f32x4*)(red + (wave * 16 + q) * 64 + 4 * l15) = o[q];
          } }
        __syncthreads();
        for (int i = tid; i < 1024; i += NWAVES * 64) { float s = 0.f;
#pragma unroll
            for (int w = 0; w < 8; ++w) s += red[w * 1024 + i];
            (OUT ? OUT : QO)[(size_t)(MP + 16 * b + (i >> 6)) * D + 64 * h + (i & 63)] = (bf16)f2bf(s); }
        __syncthreads();
    }
}
namespace ssd {
constexpr int PC = 136, PS = 72;
constexpr int L_CS = 0, L_BS = L_CS + 64 * PC * 2, L_BT = L_BS + 64 * PC * 2, L_XT = L_BT + 128 * PS * 2, L_XW = L_XT + 64 * PS * 2, L_GS = L_XW + 64 * PS * 2,
              L_HS = L_GS + 64 * PS * 2, L_YS = L_HS + 64 * PC * 2, L_AT = L_YS + 64 * PS * 2, L_DT = L_AT + 2048 * 4, L_WT = L_DT + 2048 * 4, L_END = L_WT + 64;
static_assert(L_END <= 131072, "SSD LDS map");
typedef short bf16x8 __attribute__((ext_vector_type(8)));
typedef float f32x4 __attribute__((ext_vector_type(4)));
typedef unsigned v2u __attribute__((ext_vector_type(2)));
__device__ __forceinline__ bf16x8 frag(const LAS unsigned char* L, int base, int row, int pitch, int k0) { return *(const LAS bf16x8*)(L + base + (row * pitch + k0) * 2); }
__device__ __forceinline__ v4u ld8(const bf16* XBC, int t, int col) { v4u z = {0u, 0u, 0u, 0u}; return t >= 0 ? *(const GAS v4u*)(XBC + (size_t)t * CONV_DIM + col) : z; }

#define SSD_OPQ(x) asm volatile("" : "+v"(x))
__device__ __forceinline__ unsigned short bf1(float v) { return (unsigned short)(pg8::cvt_pk_bf16(v, 0.f) & 0xffffu); }
template <bool FULL, int VAR = 0>
__device__ __forceinline__ void ssd_unit(Frame& F, int h, int sg, const bf16* XBC, const float* DT, bf16* YB, float* SSEG, float* DSEG, float* ssm_out,
                                         const float* conv_w, const float* conv_b, const float* a_log, const float* dskip, const int nck = 32) {
    (void)conv_w; (void)conv_b;
    LAS unsigned char* L = F.lds + RING_OFF;
    const int lane = F.lane, wave = F.wave, g = h >> 3, l15 = lane & 15, quad = lane >> 4, tb = wave >> 1, hb = wave & 1;
    const float a = -__expf(a_log[h]), dsk = dskip[h];
    LAS float* AT = (LAS float*)(L + L_AT); LAS float* DTT = (LAS float*)(L + L_DT);
    int fPC = (l15 * PC + 8 * quad) * 2, fPS = (l15 * PS + 8 * quad) * 2;
    int fPCt = fPC + 16 * tb * PC * 2, fPSt = fPS + 16 * tb * PS * 2;
    int fPCh = fPC + 32 * hb * PC * 2;
    const int h3 = l15 >> 3;
    int xfo[2][2], xwo[4][2], bto[2], xe[2];
#pragma unroll
    for (int j = 0; j < 2; ++j) { const int p = 32 * hb + 16 * j + l15, f = (4 * hb + 2 * j + h3) & 7;
#pragma unroll
        for (int k = 0; k < 2; ++k) xfo[j][k] = p * PS * 2 + (((4 * k + quad) ^ f) << 4);
        xe[j] = p * PS * 2 + (((2 * tb + (quad >> 1)) ^ f) << 4) + 8 * (quad & 1); }
#pragma unroll
    for (int pb = 0; pb < 4; ++pb)
#pragma unroll
        for (int k = 0; k < 2; ++k) xwo[pb][k] = (16 * pb + l15) * PS * 2 + (((4 * k + quad) ^ ((2 * pb + h3) & 7)) << 4);
#pragma unroll
    for (int k = 0; k < 2; ++k) bto[k] = (16 * wave + l15) * PS * 2 + (((4 * k + quad) ^ ((2 * wave + h3) & 7)) << 4);
    int wTP = ((16 * tb + 4 * quad) * PS + 32 * hb + l15) * 2;
    int wHS = ((4 * quad) * PC + 16 * wave + l15) * 2;
    int sT = (16 * tb + 4 * quad) * 4, sS = (32 * hb + l15) * 4;
    const int cgx = lane & 7, rx = 8 * wave + (lane >> 3);
    int sXT = (8 * cgx * PS + (((wave ^ cgx) << 3) | (lane >> 3))) * 2;
    const int cgb = lane & 15, rb = 8 * wave + 2 * (lane >> 4);
    int sBR = (rb * PC + 8 * cgb) * 2, sBT = (8 * cgb * PS + (((wave ^ (cgb & 7)) << 3) | (2 * (lane >> 4)))) * 2;
    int yRD = ((lane >> 3) * PS + 8 * (lane & 7)) * 2 + (8 * wave) * PS * 2;
    SSD_OPQ(fPCt); SSD_OPQ(fPSt); SSD_OPQ(fPCh); SSD_OPQ(wTP); SSD_OPQ(wHS); SSD_OPQ(xfo[0][0]); SSD_OPQ(xfo[0][1]); SSD_OPQ(xfo[1][0]); SSD_OPQ(xfo[1][1]); SSD_OPQ(xe[0]); SSD_OPQ(xe[1]); SSD_OPQ(bto[0]); SSD_OPQ(bto[1]);
    SSD_OPQ(xwo[0][0]); SSD_OPQ(xwo[0][1]); SSD_OPQ(xwo[1][0]); SSD_OPQ(xwo[1][1]); SSD_OPQ(xwo[2][0]); SSD_OPQ(xwo[2][1]); SSD_OPQ(xwo[3][0]); SSD_OPQ(xwo[3][1]); SSD_OPQ(sT); SSD_OPQ(sS); SSD_OPQ(sXT); SSD_OPQ(sBR); SSD_OPQ(sBT); SSD_OPQ(yRD);
    const int ncol = 16 * wave + l15;
    {
        const int tid = wave * 64 + lane; const float* dp = DT + (size_t)(sg * 2048 + 4 * tid) * 32 + h;
        const float d0 = dp[0], d1 = dp[32], d2 = dp[64], d3 = dp[96]; const float s4 = (d0 + d1 + d2 + d3) * a; float v = s4;
#pragma unroll
        for (int o = 1; o < 64; o <<= 1) { const float nn = __shfl_up(v, o); if (lane >= o) v += nn; }
        LAS float* WT = (LAS float*)(L + L_WT); if (lane == 63) WT[wave] = v;
        __syncthreads();
        float run = v - s4;
#pragma unroll
        for (int w = 0; w < 8; ++w) run += (w < wave) ? WT[w] : 0.f;
        run += d0 * a; AT[4 * tid] = run; run += d1 * a; AT[4 * tid + 1] = run; run += d2 * a; AT[4 * tid + 2] = run; run += d3 * a; AT[4 * tid + 3] = run;
        DTT[4 * tid] = d0; DTT[4 * tid + 1] = d1; DTT[4 * tid + 2] = d2; DTT[4 * tid + 3] = d3;
        __syncthreads();
    }
    const float aend = AT[2047];
    f32x4 hacc[4];
#pragma unroll
    for (int pb = 0; pb < 4; ++pb) hacc[pb] = (f32x4){0.f, 0.f, 0.f, 0.f};
    if (FULL) {
#pragma unroll 1
        for (int s2 = 0; s2 < sg; ++s2) { const float dg = DSEG[s2 * SSD_H + h]; const float* sp = SSEG + (((size_t)s2 * SSD_H + h) * SSD_P) * SSD_N + ncol;
#pragma unroll
            for (int pb = 0; pb < 4; ++pb)
#pragma unroll
                for (int r = 0; r < 4; ++r) hacc[pb][r] = dg * hacc[pb][r] + sp[(size_t)(16 * pb + 4 * quad + r) * SSD_N]; }
#pragma unroll
        for (int pb = 0; pb < 4; ++pb)
#pragma unroll
            for (int r = 0; r < 4; ++r) *(LAS unsigned short*)(L + L_HS + wHS + ((16 * pb + r) * PC) * 2) = bf1(hacc[pb][r]);
    }
    const bf16* gx = XBC + (size_t)(sg * 2048 + rx) * CONV_DIM + 64 * h + 8 * cgx;
    const bf16* gb = XBC + (size_t)(sg * 2048 + rb) * CONV_DIM + 2048 + 128 * g + 8 * cgb;
    constexpr int PD = FULL ? 2 : 4;
    v4u xq[PD], bq[PD][2], cq[PD][2];
#pragma unroll
    for (int i = 0; i < PD; ++i) { const bf16* gx2 = gx + (size_t)i * 64 * CONV_DIM; const bf16* gb2 = gb + (size_t)i * 64 * CONV_DIM;
        xq[i] = *(const GAS v4u*)gx2; bq[i][0] = *(const GAS v4u*)gb2; bq[i][1] = *(const GAS v4u*)(gb2 + CONV_DIM); cq[i][0] = bq[i][0]; cq[i][1] = bq[i][1];
        if (FULL) { cq[i][0] = *(const GAS v4u*)(gb2 + 512); cq[i][1] = *(const GAS v4u*)(gb2 + CONV_DIM + 512); } }
    auto chunk = [&](const int ck, v4u& xn, v4u (&bn)[2], v4u (&cn)[2]) __attribute__((always_inline)) {
        const v4u xr = xn, br0 = bn[0], br1 = bn[1], cr0 = cn[0], cr1 = cn[1];
        const int oXW = (!FULL && (ck & 1)) ? L_CS : L_XW, oBT = (!FULL && (ck & 1)) ? L_GS : L_BT;
        const int cb4 = 256 * ck;
        const float abase = ck ? AT[64 * ck - 1] : 0.f, acend = AT[64 * ck + 63];
        {   const unsigned* xw_ = (const unsigned*)&xr; const float wr_ = DTT[64 * ck + rx] * __expf((FULL ? acend : aend) - AT[64 * ck + rx]);
#pragma unroll
            for (int j = 0; j < 8; ++j) { const unsigned short xb = (unsigned short)((j & 1) ? (xw_[j >> 1] >> 16) : (xw_[j >> 1] & 0xffffu));
                if (FULL) *(LAS unsigned short*)(L + L_XT + sXT + j * PS * 2) = xb;
                *(LAS unsigned short*)(L + oXW + sXT + j * PS * 2) = bf1(wr_ * pg8::bf2f(xb)); }
        }
        {   const unsigned* b0 = (const unsigned*)&br0; const unsigned* b1 = (const unsigned*)&br1;
            if (FULL) { *(LAS v4u*)(L + L_BS + sBR) = br0; *(LAS v4u*)(L + L_BS + sBR + PC * 2) = br1; }
#pragma unroll
            for (int j = 0; j < 8; ++j) { const unsigned lo = (j & 1) ? (b0[j >> 1] >> 16) : (b0[j >> 1] & 0xffffu), hi_ = (j & 1) ? (b1[j >> 1] & 0xffff0000u) : (b1[j >> 1] << 16);
                *(LAS unsigned*)(L + oBT + sBT + j * PS * 2) = lo | hi_; }
        }
        if (FULL) { *(LAS v4u*)(L + L_CS + sBR) = cr0; *(LAS v4u*)(L + L_CS + sBR + PC * 2) = cr1; }
        __syncthreads();
        if (ck + PD < 32) {
            const bf16* gx2 = gx + (size_t)(ck + PD) * 64 * CONV_DIM; const bf16* gb2 = gb + (size_t)(ck + PD) * 64 * CONV_DIM;
            xn = *(const GAS v4u*)gx2; bn[0] = *(const GAS v4u*)gb2; bn[1] = *(const GAS v4u*)(gb2 + CONV_DIM);
            if (FULL) { cn[0] = *(const GAS v4u*)(gb2 + 512); cn[1] = *(const GAS v4u*)(gb2 + CONV_DIM + 512); }
        }
        const float etot = FULL ? __expf(acend - abase) : 1.0f;
        if (FULL && VAR != 2) {
            const f32x4 cst = *(const LAS f32x4*)(L + L_AT + cb4 + sT);
            bf16x8 ca[4];
#pragma unroll
            for (int k = 0; k < 4; ++k) ca[k] = *(const LAS bf16x8*)(L + L_CS + fPCt + 64 * k);
            {
                bf16x8 bb[2][4];
#pragma unroll
                for (int k = 0; k < 4; ++k) { bb[0][k] = *(const LAS bf16x8*)(L + L_BS + fPCh + 64 * k); bb[1][k] = *(const LAS bf16x8*)(L + L_BS + fPCh + (16 * PC) * 2 + 64 * k); }
                const float css0 = *(const LAS float*)(L + L_AT + cb4 + sS), css1 = *(const LAS float*)(L + L_AT + cb4 + sS + 64), dts0 = *(const LAS float*)(L + L_DT + cb4 + sS), dts1 = *(const LAS float*)(L + L_DT + cb4 + sS + 64);
                f32x4 g0 = (f32x4){0.f, 0.f, 0.f, 0.f}, g1 = g0;
#pragma unroll
                for (int k = 0; k < 4; ++k) { g0 = __builtin_amdgcn_mfma_f32_16x16x32_bf16(ca[k], bb[0][k], g0, 0, 0, 0); g1 = __builtin_amdgcn_mfma_f32_16x16x32_bf16(ca[k], bb[1][k], g1, 0, 0, 0); }
                const int s0 = 32 * hb + l15, t0 = 16 * tb + 4 * quad;
#pragma unroll
                for (int r = 0; r < 4; ++r) {
                    const float v0 = (s0 <= t0 + r) ? g0[r] * __expf(cst[r] - css0) * dts0 : 0.f, v1 = (s0 + 16 <= t0 + r) ? g1[r] * __expf(cst[r] - css1) * dts1 : 0.f;
                    *(LAS unsigned short*)(L + L_GS + wTP + (r * PS) * 2) = bf1(v0); *(LAS unsigned short*)(L + L_GS + wTP + (r * PS + 16) * 2) = bf1(v1); }
            }
            if (VAR != 1) __syncthreads();
            {
                bf16x8 hs[2][4], ga[2], xa[2][2]; v2u xv[2];
#pragma unroll
                for (int k = 0; k < 4; ++k) { hs[0][k] = *(const LAS bf16x8*)(L + L_HS + fPCh + 64 * k); hs[1][k] = *(const LAS bf16x8*)(L + L_HS + fPCh + (16 * PC) * 2 + 64 * k); }
#pragma unroll
                for (int k = 0; k < 2; ++k) { ga[k] = *(const LAS bf16x8*)(L + L_GS + fPSt + 64 * k); xa[0][k] = *(const LAS bf16x8*)(L + L_XT + xfo[0][k]); xa[1][k] = *(const LAS bf16x8*)(L + L_XT + xfo[1][k]); }
                xv[0] = *(const LAS v2u*)(L + L_XT + xe[0]); xv[1] = *(const LAS v2u*)(L + L_XT + xe[1]);
                f32x4 y0 = (f32x4){0.f, 0.f, 0.f, 0.f}, y1 = y0;
#pragma unroll
                for (int k = 0; k < 4; ++k) { y0 = __builtin_amdgcn_mfma_f32_16x16x32_bf16(ca[k], hs[0][k], y0, 0, 0, 0); y1 = __builtin_amdgcn_mfma_f32_16x16x32_bf16(ca[k], hs[1][k], y1, 0, 0, 0); }
#pragma unroll
                for (int r = 0; r < 4; ++r) { const float e = __expf(cst[r] - abase); y0[r] *= e; y1[r] *= e; }
#pragma unroll
                for (int k = 0; k < 2; ++k) { y0 = __builtin_amdgcn_mfma_f32_16x16x32_bf16(ga[k], xa[0][k], y0, 0, 0, 0); y1 = __builtin_amdgcn_mfma_f32_16x16x32_bf16(ga[k], xa[1][k], y1, 0, 0, 0); }
#pragma unroll
                for (int r = 0; r < 4; ++r) {
                    const unsigned w0 = (r & 2) ? xv[0].y : xv[0].x, w1 = (r & 2) ? xv[1].y : xv[1].x;
                    const float x0 = (r & 1) ? pg8::bfhi(w0) : pg8::bflo(w0), x1 = (r & 1) ? pg8::bfhi(w1) : pg8::bflo(w1);
                    *(LAS unsigned short*)(L + L_YS + wTP + (r * PS) * 2) = bf1(y0[r] + dsk * x0); *(LAS unsigned short*)(L + L_YS + wTP + (r * PS + 16) * 2) = bf1(y1[r] + dsk * x1); }
            }
        }
        {
            bf16x8 xw[4][2], bt[2];
#pragma unroll
            for (int k = 0; k < 2; ++k) { bt[k] = *(const LAS bf16x8*)(L + oBT + bto[k]);
#pragma unroll
                for (int pb = 0; pb < 4; ++pb) xw[pb][k] = *(const LAS bf16x8*)(L + oXW + xwo[pb][k]); }
#pragma unroll
            for (int pb = 0; pb < 4; ++pb)
#pragma unroll
                for (int r = 0; r < 4; ++r) hacc[pb][r] *= etot;
#pragma unroll
            for (int k = 0; k < 2; ++k)
#pragma unroll
                for (int pb = 0; pb < 4; ++pb) hacc[pb] = __builtin_amdgcn_mfma_f32_16x16x32_bf16(xw[pb][k], bt[k], hacc[pb], 0, 0, 0);
        }
        if (FULL && VAR != 1) __syncthreads();
        if (FULL) {
            { const v4u v = *(const LAS v4u*)(L + L_YS + yRD); *(GAS v4u*)(YB + (size_t)(sg * 2048 + 64 * ck + 8 * wave + (lane >> 3)) * D_INNER + 64 * h + 8 * (lane & 7)) = v; }
#pragma unroll
            for (int pb = 0; pb < 4; ++pb)
#pragma unroll
                for (int r = 0; r < 4; ++r) *(LAS unsigned short*)(L + L_HS + wHS + ((16 * pb + r) * PC) * 2) = bf1(hacc[pb][r]);
        }
    };
#pragma unroll 1
    for (int ck2 = 0; ck2 < nck; ck2 += PD) { chunk(ck2, xq[0], bq[0], cq[0]); chunk(ck2 + 1, xq[1], bq[1], cq[1]); if (PD == 4) { chunk(ck2 + 2, xq[PD - 2], bq[PD - 2], cq[PD - 2]); chunk(ck2 + 3, xq[PD - 1], bq[PD - 1], cq[PD - 1]); } }
    if (!FULL) {
        float* sp = SSEG + (((size_t)sg * SSD_H + h) * SSD_P) * SSD_N + ncol;
#pragma unroll
        for (int pb = 0; pb < 4; ++pb)
#pragma unroll
            for (int r = 0; r < 4; ++r) sp[(size_t)(16 * pb + 4 * quad + r) * SSD_N] = hacc[pb][r];
        if (wave == 0 && lane == 0) DSEG[sg * SSD_H + h] = __expf(aend);
    } else if (sg == 7) {
        float* sp = ssm_out + ((size_t)h * SSD_P) * SSD_N + ncol;
#pragma unroll
        for (int pb = 0; pb < 4; ++pb)
#pragma unroll
            for (int r = 0; r < 4; ++r) sp[(size_t)(16 * pb + 4 * quad + r) * SSD_N] = hacc[pb][r];
    }
    __syncthreads();
}
}
__device__ __forceinline__ void ssd_passA_phase(Frame& F) {
    REFRESH(F);
    ssd_sample_rec(F);
    __syncthreads();
#ifdef MK_PROBE_SREC
    ssd_sample_rec(F);
    __syncthreads();
#endif
    for (int un = F.vcu; un < SSD_H * 7; un += F.G) {
        ssd::ssd_unit<false>(F, un & 31, un >> 5, (const bf16*)(kws() + WS_XBC), (const float*)(kws() + WS_DT), (bf16*)(kws() + WS_YB), (float*)(kws() + WS_SSEG), (float*)(kws() + WS_DSEG), kout() + O_SP, kin(18), kin(19), kin(21), kin(22));
    }
}
__device__ __forceinline__ void ssd_passB_phase(Frame& F) {
    REFRESH(F);
#ifdef MK_PROBE_LOOP
    int reps_ = MK_PROBE_LOOP; asm volatile("" : "+s"(reps_));
#pragma unroll 1
    for (int rep_ = 0; rep_ < reps_; ++rep_)
    for (int un = F.vcu; un < SSD_H * 8; un += F.G)
        ssd::ssd_unit<true>(F, un & 31, un >> 5, (const bf16*)(kws() + WS_XBC), (const float*)(kws() + WS_DT), (bf16*)(kws() + WS_YB), (float*)(kws() + WS_SSEG), (float*)(kws() + WS_DSEG), kout() + O_SP, kin(18), kin(19), kin(21), kin(22), rep_ == reps_ - 1 ? 32 : 0);
#else
    for (int un = F.vcu; un < SSD_H * 8; un += F.G)
        ssd::ssd_unit<true>(F, un & 31, un >> 5, (const bf16*)(kws() + WS_XBC), (const float*)(kws() + WS_DT), (bf16*)(kws() + WS_YB), (float*)(kws() + WS_SSEG), (float*)(kws() + WS_DSEG), kout() + O_SP, kin(18), kin(19), kin(21), kin(22));
#endif
}

namespace pg8 {
struct PanelStats {
    unsigned* xbuf;
    unsigned* cnt;
    unsigned* tmo;
    int ntn; float eps;
    unsigned code;
    __device__ __forceinline__ bool run(const f32x4 (&v)[2][2][4][2], const Unit& u, int wr, int wc, int fr, int fq, PG8_LAS unsigned char* lds, int wid, int lane) const {
        typedef float f32x2v __attribute__((ext_vector_type(2)));
        PG8_LAS f32x2v* P = (PG8_LAS f32x2v*)lds;
        PG8_LAS f32x2v* S = (PG8_LAS f32x2v*)(lds + 8192);
        PG8_LAS unsigned* flag = (PG8_LAS unsigned*)(lds + 8192 + 2048);
#pragma unroll
        for (int ai = 0; ai < 2; ++ai)
#pragma unroll
            for (int m = 0; m < 4; ++m) {
                float s = 0.f;
#pragma unroll
                for (int bj = 0; bj < 2; ++bj)
#pragma unroll
                    for (int n = 0; n < 2; ++n) { const f32x4 x = v[ai][bj][m][n]; s += (x[0] + x[1]) + (x[2] + x[3]); }
                s += __shfl_xor(s, 16); s += __shfl_xor(s, 32);
                const float mw = s * (1.0f / 64.0f); float q = 0.f;
#pragma unroll
                for (int bj = 0; bj < 2; ++bj)
#pragma unroll
                    for (int n = 0; n < 2; ++n) { const f32x4 d = v[ai][bj][m][n] - mw; q += (d[0] * d[0] + d[1] * d[1]) + (d[2] * d[2] + d[3] * d[3]); }
                q += __shfl_xor(q, 16); q += __shfl_xor(q, 32);
                if (fq == 0) P[(ai * HALF + wr * 64 + m * 16 + fr) * 4 + wc] = (f32x2v){mw, q};
            }
        asm volatile("s_waitcnt lgkmcnt(0)" ::: "memory"); __builtin_amdgcn_s_barrier(); asm volatile("" ::: "memory");
        const int row = wid * 32 + (lane & 31);
        if (lane < 32) {
            const f32x2v a = P[row * 4 + 0], b = P[row * 4 + 1], c = P[row * 4 + 2], d = P[row * 4 + 3];
            const float mt = (a.x + b.x + c.x + d.x) * 0.25f;
            const float da = a.x - mt, db = b.x - mt, dc = c.x - mt, dd = d.x - mt;
            const float m2 = (a.y + b.y) + (c.y + d.y) + 64.0f * ((da * da + db * db) + (dc * dc + dd * dd));
            unsigned long long* slot = (unsigned long long*)xbuf + ((size_t)(u.pm * BM + row) * 4 + u.pn);
            __hip_atomic_store(slot, ((unsigned long long)__float_as_uint(m2) << 32) | __float_as_uint(mt), __ATOMIC_RELAXED, __HIP_MEMORY_SCOPE_AGENT);
        }
        asm volatile("s_waitcnt vmcnt(0)" ::: "memory");
        if (lane == 0) __hip_atomic_fetch_add(cnt + 64 * u.pm, 1u, __ATOMIC_RELAXED, __HIP_MEMORY_SCOPE_AGENT);
        if (wid == 0) {
            const unsigned want = 8u * (unsigned)ntn;
            while ((unsigned)__builtin_amdgcn_readfirstlane(__hip_atomic_load(cnt + 64 * u.pm, __ATOMIC_RELAXED, __HIP_MEMORY_SCOPE_AGENT)) < want) __builtin_amdgcn_s_sleep(2);
            __builtin_amdgcn_fence(__ATOMIC_ACQUIRE, "agent");
        }
        asm volatile("s_waitcnt vmcnt(0) lgkmcnt(0)" ::: "memory"); __builtin_amdgcn_s_barrier(); asm volatile("" ::: "memory");
        if (lane < 32) {
            const unsigned long long* slot = (const unsigned long long*)xbuf + (size_t)(u.pm * BM + row) * 4; float mt[4], m2[4]; float ms = 0.f;
#pragma unroll
            for (int t = 0; t < 4; ++t) { if (t < ntn) { const unsigned long long w = __hip_atomic_load(slot + t, __ATOMIC_RELAXED, __HIP_MEMORY_SCOPE_AGENT); mt[t] = __uint_as_float((unsigned)w); m2[t] = __uint_as_float((unsigned)(w >> 32)); } else { mt[t] = 0.f; m2[t] = 0.f; } ms += mt[t]; }
            const float mean = ms / (float)ntn; float q = 0.f;
#pragma unroll
            for (int t = 0; t < 4; ++t) if (t < ntn) { const float dm = mt[t] - mean; q += m2[t] + 256.0f * dm * dm; }
            S[row] = (f32x2v){mean, 1.0f / sqrtf(q / (256.0f * (float)ntn) + mean * mean + eps)};
        }
        asm volatile("s_waitcnt lgkmcnt(0)" ::: "memory"); __builtin_amdgcn_s_barrier(); asm volatile("" ::: "memory");
        return false;
    }
};

template <int WHICH> struct EpiResGateNorm {
    static constexpr bool PERM = false, AFTER_DRAIN = true;
    static constexpr int CHUNK = WHICH == 0 ? 2 : (WHICH == 1 ? 5 : 8), CSH = WHICH == 0 ? 3 : 6; static constexpr bool FINAL = WHICH == 2;
    __device__ __forceinline__ void fused(f32x4 (&acc)[2][2][4][2], const Unit& u, int wr, int wc, int fr_in, int fq_in, PG8_LAS unsigned char* lds, int wid, int lane_in) const {
        const int ln_ = lane_now(); const int fr = ln_ & 15, fq = ln_ >> 4; (void)fr_in; (void)fq_in; (void)lane_in;
        typedef float f32x2v __attribute__((ext_vector_type(2))); typedef unsigned u32x2v __attribute__((ext_vector_type(2)));
        const float gsc = WHICH == 1 ? 1.0f : 0.5f;
        const int col0 = u.pn * BM + wc * 32 + 4 * fq;
        {
            const float* xp = ::kin(0); float* X = ::kout() + ::O_Y; bf16_t* XB = (bf16_t*)(::kws() + ::WS_XB); const float* gp = (const float*)(::kws() + ::WS_MOD) + CHUNK * 1024;
            f32x4 gt[2][2];
#pragma unroll
            for (int bj = 0; bj < 2; ++bj)
#pragma unroll
                for (int n = 0; n < 2; ++n) gt[bj][n] = (*(const f32x4*)(gp + col0 + bj * HALF + n * 16) + 1.0f) * gsc;
            typedef typename std::conditional<WHICH == 0, f32x4, u32x2v>::type RawT;
            RawT bs[3][2][2];
#pragma unroll
            for (int p = 0; p < 2; ++p) { const size_t off = (size_t)(u.pm * BM + (p >> 2) * HALF + wr * 64 + (p & 3) * 16 + fr) * DM_ + col0;
#pragma unroll
                for (int bj = 0; bj < 2; ++bj)
#pragma unroll
                    for (int n = 0; n < 2; ++n) { if constexpr (WHICH == 0) bs[p][bj][n] = *(const f32x4*)(xp + off + bj * HALF + n * 16); else bs[p][bj][n] = *(const u32x2v*)(XB + off + bj * HALF + n * 16); } }
#pragma unroll
            for (int grp = 0; grp < 8; ++grp) {
                const int ai = grp >> 2, m = grp & 3;
                if (grp + 2 < 8) { const int g2 = grp + 2; const size_t off2 = (size_t)(u.pm * BM + (g2 >> 2) * HALF + wr * 64 + (g2 & 3) * 16 + fr) * DM_ + col0;
#pragma unroll
                    for (int bj = 0; bj < 2; ++bj)
#pragma unroll
                        for (int n = 0; n < 2; ++n) { if constexpr (WHICH == 0) bs[g2 % 3][bj][n] = *(const f32x4*)(xp + off2 + bj * HALF + n * 16); else bs[g2 % 3][bj][n] = *(const u32x2v*)(XB + off2 + bj * HALF + n * 16); } }
                const size_t off = (size_t)(u.pm * BM + ai * HALF + wr * 64 + m * 16 + fr) * DM_ + col0;
#pragma unroll
                for (int bj = 0; bj < 2; ++bj)
#pragma unroll
                    for (int n = 0; n < 2; ++n) { f32x4 b_; if constexpr (WHICH == 0) b_ = bs[grp % 3][bj][n]; else { const u32x2v r_ = bs[grp % 3][bj][n]; b_ = (f32x4){bflo(r_.x), bfhi(r_.x), bflo(r_.y), bfhi(r_.y)}; }
                        acc[ai][bj][m][n] = b_ + gt[bj][n] * acc[ai][bj][m][n];
                        if (!FINAL) { const f32x4 o_ = acc[ai][bj][m][n]; u32x2v w_; w_.x = cvt_pk_bf16(o_[0], o_[1]); w_.y = cvt_pk_bf16(o_[2], o_[3]); *(u32x2v*)(XB + off + bj * HALF + n * 16) = w_; } }
                if (FINAL) asm volatile("" : "+v"(acc[ai][0][m][0]), "+v"(acc[ai][0][m][1]), "+v"(acc[ai][1][m][0]), "+v"(acc[ai][1][m][1]));
                __builtin_amdgcn_sched_barrier(0);
            }
        }
        { PanelStats st{(unsigned*)(::kws() + ::WS_XCH + (size_t)WHICH * 512 * 1024), (unsigned*)(::kws() + ::WS_CTL) + ::CW_SEAM + WHICH * ::SEAM_BANK, (unsigned*)(::kws() + ::WS_CTL), 4, ::EPS, 0x700u + 0x40u * WHICH};
          (void)st.run(acc, u, wr, wc, fr, fq, lds, wid, ln_); }
        const PG8_LAS f32x2v* S = (const PG8_LAS f32x2v*)(lds + 8192);
        {
            const int l2_ = lane_now(); const int fr = l2_ & 15, fq = l2_ >> 4; const int col0 = u.pn * BM + wc * 32 + 4 * fq;
            const float* gvec = ::kin(WHICH == 0 ? 15 : (WHICH == 1 ? 27 : 31)); const float* sh = (const float*)(::kws() + ::WS_MOD) + CSH * 1024; const float* scl = sh + 1024;
            float* X = ::kout() + ::O_Y; bf16_t* HN = (bf16_t*)(::kws() + ::WS_HN);
            f32x4 ca_[2][2], cb_[2][2];
#pragma unroll
            for (int bj = 0; bj < 2; ++bj)
#pragma unroll
                for (int n = 0; n < 2; ++n) { const int c = col0 + bj * HALF + n * 16; ca_[bj][n] = *(const f32x4*)(gvec + c); cb_[bj][n] = (f32x4){0.f, 0.f, 0.f, 0.f};
                    if (!FINAL) { ca_[bj][n] = ca_[bj][n] * (*(const f32x4*)(scl + c) + 1.0f); cb_[bj][n] = *(const f32x4*)(sh + c); } }
#pragma unroll
            for (int ai = 0; ai < 2; ++ai)
#pragma unroll
                for (int m = 0; m < 4; ++m) {
                    const int r = ai * HALF + wr * 64 + m * 16 + fr; const float rstd = S[r].y; const size_t off = (size_t)(u.pm * BM + r) * DM_ + col0;
#pragma unroll
                    for (int bj = 0; bj < 2; ++bj)
#pragma unroll
                        for (int n = 0; n < 2; ++n) { const int c = bj * HALF + n * 16; const f32x4 o = acc[ai][bj][m][n] * rstd * ca_[bj][n] + cb_[bj][n];
                            if (!FINAL) { u32x2v w; w.x = cvt_pk_bf16(o[0], o[1]); w.y = cvt_pk_bf16(o[2], o[3]); *(u32x2v*)(HN + off + c) = w; }
                            else *(f32x4*)(X + off + c) = o; }
                    __builtin_amdgcn_sched_barrier(0);
                }
        }
    }
};
}
constexpr int N_PHASES = 18;
#ifndef MK_N_LAUNCHES
#define MK_N_LAUNCHES 1
#endif
constexpr int N_LAUNCHES = MK_N_LAUNCHES;
struct Args { const float* in[32]; float* out; unsigned char* ws; int ph_lo, ph_hi, li, pad; };
__global__ void __launch_bounds__(NWAVES * 64, 2) mk_fwd(Args args) {
    extern __shared__ __attribute__((aligned(16))) unsigned char lds[];
    Frame F;
    F.lds = (LAS unsigned char*)lds; F.MISC = (volatile LAS unsigned*)(F.lds + MISC_OFF);
    F.wave = __builtin_amdgcn_readfirstlane((int)threadIdx.x >> 6); REFRESH(F);
#ifdef MK_FENCES
    __builtin_amdgcn_fence(__ATOMIC_ACQUIRE, "agent"); asm volatile("s_waitcnt vmcnt(0)" ::: "memory");
#endif
    F.G = gridDim.x; { const int bx = blockIdx.x; F.vcu = (F.G % 8 == 0) ? (bx % 8) * (F.G / 8) + bx / 8 : bx; }
    F.ctl = (gu32*)(args.ws + WS_CTL);
    for (int u = F.tid; u < (LDS_BYTES - LDSCTL_OFF) / 4; u += NWAVES * 64) ((LAS unsigned*)(F.lds + LDSCTL_OFF))[u] = 0u;
    __syncthreads();
    XcdBarrier bar; bar.wave = F.wave; bar.bar = (unsigned*)(F.ctl + CW_BAR); bar.x = 0; bar.st = nullptr;
    if (N_LAUNCHES == 1) bar = xcd_barrier_post((unsigned*)(F.ctl + CW_BAR), F.MISC + 8, F.wave);
    const int lo = args.ph_lo, hi = args.ph_hi;
#ifndef PH_MASK
#define PH_MASK 0xFFFFFFFFu
#endif
#define IN(k) (((PH_MASK >> (k)) & 1u) && lo <= (k) && (k) < hi)
#define SEAM(k) do { if (IN(k) && IN((k) + 1)) xcd_barrier(bar); } while (0)
#ifndef MK_DOUBLE_MASK
#define MK_DOUBLE_MASK 0u
#endif
#define REPS(k) (1 + (int)((MK_DOUBLE_MASK >> (k)) & 1u))
#define PHASE(k) for (int rp_ = 0, nreps_ = (IN(k) ? REPS(k) : 0); rp_ < nreps_; ++rp_, (rp_ < nreps_ ? xcd_barrier(bar) : (void)0))
#define WSP(T, off) ((T*)(kws() + (off)))
#define ACT1P ((bf16*)(kout() + O_KP))
#define XP (kout() + O_Y)
#ifdef MK_PROBE_NOSK
#define SKINNY_ON (rp_ + 1 == nreps_)
#else
#define SKINNY_ON true
#endif
#define GEMM_RUN_P(EPI, g, E) do { pg8::Gemm gp_ = g; gp_.M = MP; pg8::StaticOrder S; S.init(MP, D, F.G, (int)blockIdx.x); pg8::gemm_phase<EPI, pg8::StaticOrder, true, true>(F.lds + RING_OFF, gp_, S, E, F.wave); \
        if (SKINNY_ON) skinny_gemm<EPI>(F, g.A, g.lda, g.Bt, g.K, E); } while (0)
#define GEMM_RUN_PN(g, W_, ES) do { pg8::Gemm gp_ = g; gp_.M = MP; pg8::StaticOrder S; S.init(MP, D, F.G, (int)blockIdx.x); pg8::EpiResGateNorm<W_> EN; pg8::gemm_phase<pg8::EpiResGateNorm<W_>, pg8::StaticOrder, false, true>(F.lds + RING_OFF, gp_, S, EN, F.wave); __syncthreads();     \
        skinny_gemm<pg8::EpiResGate>(F, g.A, g.lda, g.Bt, g.K, ES); } while (0)
#define GEMM_RUN(EPI, g, N_, E) do { pg8::StaticOrder65 S; S.init((N_), F.G, (int)blockIdx.x); pg8::gemm_phase<EPI, pg8::StaticOrder65, true, true>(F.lds + RING_OFF, g, S, E, F.wave); } while (0)
    PHASE(0) { if (F.G != 256) p0_prologue<1>(F); p0_prologue<0>(F); } SEAM(0);
    PHASE(1) { norm_phase(F, kin(0), kin(1), kin(11), 0, WSP(bf16, WS_HN)); } SEAM(1);
    PHASE(2) { pg8::Gemm g{WSP(bf16, WS_HN), WSP(const bf16, WS_W13A), MT, 2 * FF, D, D}; pg8::EpiSwiGLU E{ACT1P, FF}; GEMM_RUN(pg8::EpiSwiGLU, g, 2 * FF, E);
        if (F.G == 256 && (int)blockIdx.x >= 150) { const int v0_ = F.vcu; F.vcu = (int)blockIdx.x - 150; F.G = 106; p0_prologue<1>(F); F.vcu = v0_; F.G = 256; } } SEAM(2);
    PHASE(3) { pg8::Gemm g{ACT1P, WSP(const bf16, WS_W2A), MT, D, FF, FF}; pg8::EpiResGate E{kin(0), kin(1), XP, WSP(float, WS_MOD), 2, 0.5f}; if (F.G == 256) GEMM_RUN_PN(g, 0, E); else GEMM_RUN_P(pg8::EpiResGate, g, E); } SEAM(3);
    PHASE(4) { norm_phase(F, XP, XP + (size_t)MP * D, kin(15), 3, WSP(bf16, WS_HN), F.G == 256 ? MP : 0); } SEAM(4);
    PHASE(5) { pg8::Gemm g{WSP(bf16, WS_HN), WSP(const bf16, WS_WIN1), MT, N_I1, D, D};
        static_assert(WS_KB - WS_QO == WS_VB - WS_KB, "Q | K | V copies equally spaced");
        pg8::EpiI1 E{WSP(bf16, WS_QO), (size_t)(WS_KB - WS_QO) / 2, WSP(bf16, WS_XBC), kout(), WSP(float, WS_DT), kin(17), kin(20), 0.125f * LOG2E, WSP(bf16, WS_HALO), O_KP, O_LP, O_CP, O_KS, O_VP - O_KP, O_VS - O_KS, O_LS, O_CS};
        GEMM_RUN(pg8::EpiI1, g, N_I1, E);
        if (F.G == 256 && (int)blockIdx.x >= 89) { const int v0_ = F.vcu; F.vcu = (int)blockIdx.x - 89; F.G = 167; p0_prologue<2>(F); F.vcu = v0_; F.G = 256; } } SEAM(5);
    PHASE(6) { fcum_halo_phase(F); conv_phase(F); qknorm_phase(F); if (F.G != 256) p0_prologue<2>(F); } SEAM(6);
    PHASE(7) {
        const attn_body::AttnTensors AT{WSP(const attn_body::bf16, WS_QO), WSP(const attn_body::bf16, WS_KB), WSP(const attn_body::bf16, WS_VB), WSP(attn_body::bf16, WS_QO), WSP(const float, WS_F2)};
        const attn_body::StaticOrder S((int)F.G, (int)blockIdx.x);
#ifdef MK_PROBE_ATTN
        { const attn_body::AttnTensors AT2{AT.Q, AT.K, AT.V, (attn_body::bf16*)(kws() + 9 * MiB), AT.F2}; attn_body::attn_phase<attn_body::StaticOrder>((char*)lds + RING_OFF, AT2, S, F.wave); xcd_barrier(bar); }
#endif
        (void)S; { const attn_body::AttnQueue AQ{(const float*)(kws() + WS_CTL) + CW_KQ, (unsigned*)(kws() + WS_CTL) + CW_TICKET}; attn_body::attn_phase_queue<8>((char*)lds + RING_OFF, AT, AQ, F.wave); }
        __syncthreads();
#ifdef MK_PROBE_SATTN
        attn_sample_phase(F, (bf16*)(kws() + WS_W13A) - (size_t)MP * D);
#endif
        attn_sample_phase(F);
    } SEAM(7);
    PHASE(8) { ssd_passA_phase(F); } SEAM(8);
    PHASE(9) { ssd_passB_phase(F); } SEAM(9);
    PHASE(10) { pg8::Gemm g{WSP(bf16, WS_HN), WSP(const bf16, WS_WIN2), MT, N_I2, D, D}; pg8::EpiI2 E{WSP(bf16, WS_YB), WSP(bf16, WS_GATE), WSP(float, WS_SSQ)}; { pg8::StaticOrder S; S.init(MP, N_I2, F.G, (int)blockIdx.x); pg8::gemm_phase<pg8::EpiI2, pg8::StaticOrder, true, true>(F.lds + RING_OFF, g, S, E, F.wave); } skinny_gemm<pg8::EpiI2>(F, g.A, g.lda, g.Bt, g.K, E, N_I2 / 32);     } SEAM(10);
    PHASE(11) { ssq_sample_pass(F); pg8::Gemm g{WSP(bf16, WS_QO), WSP(const bf16, WS_WA), MT, D, D, D}; pg8::EpiOA E{WSP(bf16, WS_MA), WSP(const bf16, WS_GATE)}; GEMM_RUN_P(pg8::EpiOA, g, E); } SEAM(11);
    PHASE(12) { pg8::Gemm g{WSP(bf16, WS_YB), WSP(const bf16, WS_WS), MT, D, D_INNER, D_INNER}; pg8::EpiOS E{WSP(bf16, WS_MERGED), WSP(const bf16, WS_MA), WSP(const bf16, WS_GATE), WSP(const float, WS_RSTD)}; GEMM_RUN_P(pg8::EpiOS, g, E); } SEAM(12);
    PHASE(13) { pg8::Gemm g{WSP(bf16, WS_MERGED), WSP(const bf16, WS_WO), MT, D, D, D}; pg8::EpiResGate E{XP, XP + (size_t)MP * D, XP, WSP(float, WS_MOD), 5, 1.0f}; if (F.G == 256) GEMM_RUN_PN(g, 1, E); else GEMM_RUN_P(pg8::EpiResGate, g, E); } SEAM(13);
    PHASE(14) { norm_phase(F, XP, XP + (size_t)MP * D, kin(27), 6, WSP(bf16, WS_HN), F.G == 256 ? MP : 0); } SEAM(14);
    PHASE(15) { pg8::Gemm g{WSP(bf16, WS_HN), WSP(const bf16, WS_W13B), MT, 2 * FF, D, D}; pg8::EpiSwiGLU E{WSP(bf16, WS_ACT2), FF}; GEMM_RUN(pg8::EpiSwiGLU, g, 2 * FF, E); } SEAM(15);
    PHASE(16) { pg8::Gemm g{WSP(bf16, WS_ACT2), WSP(const bf16, WS_W2B), MT, D, FF, FF}; pg8::EpiResGate E{XP, XP + (size_t)MP * D, XP, WSP(float, WS_MOD), 8, 0.5f}; if (F.G == 256) GEMM_RUN_PN(g, 2, E); else GEMM_RUN_P(pg8::EpiResGate, g, E); } SEAM(16);
    PHASE(17) { final_norm_phase(F, XP, kin(31), F.G == 256 ? MP : 0); }
#ifdef MK_DUMP_OFF
    if (lo == 99) {
        REFRESH(F); const bf16* s = (const bf16*)(kws() + (size_t)(MK_DUMP_OFF)); float* d = kout();
        for (size_t i = (size_t)blockIdx.x * 512 + F.tid; i < (size_t)(MK_DUMP_ROWS) * (MK_DUMP_COLS); i += (size_t)gridDim.x * 512) { const size_t r = i / (MK_DUMP_COLS), c = i % (MK_DUMP_COLS); d[i] = pg8::bf2f(s[r * (MK_DUMP_PITCH) + c]); }
    }
#endif
#ifdef MK_FENCES
    asm volatile("s_waitcnt vmcnt(0)" ::: "memory"); __builtin_amdgcn_fence(__ATOMIC_RELEASE, "agent"); asm volatile("s_waitcnt vmcnt(0)" ::: "memory");
#endif
#undef IN
#undef SEAM
}

extern "C" void kernel_launch(void* const* d_in, const int* in_sizes, int n_in, void* d_out, int out_size, void* d_ws, size_t ws_size, hipStream_t stream) {
    static int grid = 0;
    if (grid == 0) {
        if (n_in != 32 || out_size != (int)O_END || ws_size < WS_END) { fprintf(stderr, "kernel_launch: unexpected shapes (n_in %d, out %d, ws %zu); nothing launched\n", n_in, out_size, ws_size); grid = -1; return; }
        int dev = 0, cus = 0, per_cu = 0;
        if (hipGetDevice(&dev) != hipSuccess || hipDeviceGetAttribute(&cus, hipDeviceAttributeMultiprocessorCount, dev) != hipSuccess) { grid = -1; return; }
        if (hipFuncSetAttribute((const void*)mk_fwd, hipFuncAttributeMaxDynamicSharedMemorySize, LDS_BYTES) != hipSuccess) { fprintf(stderr, "kernel_launch: hipFuncSetAttribute failed\n"); grid = -1; return; }
        if (hipOccupancyMaxActiveBlocksPerMultiprocessor(&per_cu, (const void*)mk_fwd, NWAVES * 64, LDS_BYTES) != hipSuccess || per_cu < 1)
            fprintf(stderr, "kernel_launch: note: occupancy query reports %d workgroups per CU\n", per_cu);
        (void)hipGetLastError();
        grid = cus;
        if (grid % 16 != 0) { fprintf(stderr, "kernel_launch: %d CUs: the attention deal needs a multiple of 16\n", grid); }
    }
    if (grid < 0) return;
    if (hipMemsetAsync((char*)d_ws + WS_CTL, 0, CTL_ZERO_BYTES, stream) != hipSuccess) return;
    Args a{};
    for (int i = 0; i < 32; ++i) a.in[i] = (const float*)d_in[i];
    a.out = (float*)d_out; a.ws = (unsigned char*)d_ws;
#ifndef MK_LAST_PHASE
#define MK_LAST_PHASE N_PHASES
#endif
    for (int li = 0; li < N_LAUNCHES && li < MK_LAST_PHASE; ++li) {
        a.ph_lo = (N_LAUNCHES == 1) ? 0 : li; a.ph_hi = (N_LAUNCHES == 1) ? N_PHASES : li + 1; a.li = li;
        hipLaunchKernelGGL(mk_fwd, dim3(grid), dim3(NWAVES * 64), LDS_BYTES, stream, a);
        const hipError_t le = hipPeekAtLastError();
        if (le != hipSuccess) { fprintf(stderr, "kernel_launch: launch %d failed: %s\n", li, hipGetErrorName(le)); break; }
    }
#ifdef MK_DUMP_OFF
    a.ph_lo = 99; a.ph_hi = 100; a.li = 99;
    hipLaunchKernelGGL(mk_fwd, dim3(grid), dim3(NWAVES * 64), LDS_BYTES, stream, a);
#endif
}
```
